# Optimizing an MI355X kernel written in HIP

```python
import jax, jax.numpy as jnp
from jax import lax
import numpy as np

D_MODEL = 2048
BATCH = 4
SEQ = 2048
DEPTH = 2

GRID_W = 64
CTX_LEN = 256

NA_HEADS = 16
NA_HEAD_DIM = 64
NA_WIN_ROWS = 8
NA_WIN_COLS = 16
GLA_HEADS = 4
GLA_DK = 128
GLA_DV = 256
GLA_GATE_RANK = 16
GLA_TAU = 16.0
GLA_CHUNK = 64
GQA_HEADS = 8
GQA_KV_HEADS = 2
GQA_HEAD_DIM = 128
ROPE_THETA = 10000.0
Q_BLOCK = 128
D_FF = 5632
N_EXPERTS = 8
TOP_K = 2
MOE_BLOCK = 256
NORM_EPS = 1e-6

NA_W = NA_HEADS * NA_HEAD_DIM
GLA_KW = GLA_HEADS * GLA_DK
GLA_VW = GLA_HEADS * GLA_DV
GQA_QW = GQA_HEADS * GQA_HEAD_DIM
GQA_KVW = GQA_KV_HEADS * GQA_HEAD_DIM
BRANCH_W = 1024

IN_SPLITS = (
    ("na_q", NA_W), ("na_k", NA_W), ("na_v", NA_W),
    ("gla_q", GLA_KW), ("gla_k", GLA_KW), ("gla_v", GLA_VW), ("gla_og", GLA_VW),
    ("gla_af", GLA_GATE_RANK), ("gla_ab", GLA_GATE_RANK),
    ("gqa_q", GQA_QW), ("gqa_k", GQA_KVW), ("gqa_v", GQA_KVW),
    ("gate_a", D_MODEL), ("gate_b", D_MODEL), ("gate_c", D_MODEL),
)
D_IN = 3 * NA_W + 2 * GLA_KW + 2 * GLA_VW + 2 * GLA_GATE_RANK + GQA_QW + 2 * GQA_KVW + 3 * D_MODEL
CTX_KV_SPLITS = ("na_k", "na_v", "gla_k", "gla_v", "gla_af", "gla_ab", "gqa_k", "gqa_v")

kernel_name = "hybrid_diffusion_parallel_mixer_block"


def rmsnorm(x, g):
    xf = x.astype(jnp.float32)
    y = xf * lax.rsqrt(jnp.mean(xf * xf, axis=-1, keepdims=True) + NORM_EPS)
    return (y * g.astype(jnp.float32)).astype(x.dtype)


def swiglu(h, w_gate, w_up, w_down):
    return (jax.nn.silu(h @ w_gate) * (h @ w_up)) @ w_down


def in_proj(h, w_in, names=None):
    out, o = {}, 0
    p = h @ w_in if names is None else None
    for name, n in IN_SPLITS:
        if names is None:
            out[name] = p[..., o:o + n]
        elif name in names:
            out[name] = h @ w_in[:, o:o + n]
        o += n
    return out


def axial_rope_tables(n_tok):
    half = GQA_HEAD_DIM // 2
    freqs = ROPE_THETA ** (-jnp.arange(0, half, 2, dtype=jnp.float32) / half)
    t = jnp.arange(n_tok)
    row = (t // GRID_W).astype(jnp.float32)
    col = (t % GRID_W).astype(jnp.float32)
    ang = jnp.concatenate([row[:, None] * freqs, col[:, None] * freqs], axis=-1)
    return jnp.cos(ang), jnp.sin(ang)


def apply_rope(x, cos, sin):
    xf = x.astype(jnp.float32)
    x1, x2 = xf[..., 0::2], xf[..., 1::2]
    c, s = cos[None, :, None, :], sin[None, :, None, :]
    out = jnp.stack([x1 * c - x2 * s, x1 * s + x2 * c], axis=-1).reshape(x.shape)
    return out.astype(x.dtype)


def _attend(q5, k, v):
    s = jnp.einsum('bqkgd,bnkd->bkgqn', q5, k).astype(jnp.float32) * (q5.shape[-1] ** -0.5)
    p = jax.nn.softmax(s, axis=-1).astype(v.dtype)
    return jnp.einsum('bkgqn,bnkd->bqkgd', p, v)


def gqa_dense(q, k, v):
    b, t, hq, dh = q.shape
    hkv = k.shape[2]
    return _attend(q.reshape(b, t, hkv, hq // hkv, dh), k, v).reshape(b, t, hq * dh)


def gqa_blocked(q, k, v, kc, vc):
    b, s, hq, dh = q.shape
    hkv = k.shape[2]
    k_all = jnp.concatenate([k, kc], axis=1)
    v_all = jnp.concatenate([v, vc], axis=1)
    qb = q.reshape(b, s // Q_BLOCK, Q_BLOCK, hkv, hq // hkv, dh).swapaxes(0, 1)
    o = lax.map(lambda qi: _attend(qi, k_all, v_all), qb)
    return o.swapaxes(0, 1).reshape(b, s, hq * dh)


def na_latent(q, k, v, kc, vc, rpb):
    b, s, h, dh = q.shape
    rows_n = s // GRID_W
    kr = min(NA_WIN_ROWS, rows_n)
    rows = jnp.arange(rows_n)
    row_idx = jnp.clip(rows - kr // 2, 0, rows_n - kr)[:, None] + jnp.arange(kr)[None, :]
    cols = jnp.arange(GRID_W)
    col_start = jnp.clip(cols - NA_WIN_COLS // 2, 0, GRID_W - NA_WIN_COLS)
    in_win = (cols[None, :] >= col_start[:, None]) & (cols[None, :] < col_start[:, None] + NA_WIN_COLS)
    dr = row_idx - rows[:, None]
    dc = jnp.clip(cols[None, :] - cols[:, None] + NA_WIN_COLS - 1, 0, 2 * NA_WIN_COLS - 2)
    bias = rpb[:, (dr + NA_WIN_ROWS - 1)[:, :, None, None], dc[None, None]]
    bias = bias.astype(jnp.float32).transpose(0, 1, 3, 2, 4)
    bias = jnp.where(in_win[:, None, :], bias, -jnp.inf)
    qg = q.reshape(b, rows_n, GRID_W, h, dh) * (dh ** -0.5)
    kg = k.reshape(b, rows_n, GRID_W, h, dh)[:, row_idx]
    vg = v.reshape(b, rows_n, GRID_W, h, dh)[:, row_idx]
    s_loc = jnp.einsum('brqhd,brkwhd->bhrqkw', qg, kg).astype(jnp.float32) + bias[None]
    s_ctx = jnp.einsum('brqhd,blhd->bhrql', qg, kc).astype(jnp.float32)
    n_loc = kr * GRID_W
    p = jax.nn.softmax(jnp.concatenate([s_loc.reshape(b, h, rows_n, GRID_W, n_loc), s_ctx], axis=-1), axis=-1)
    p = p.astype(v.dtype)
    p_loc = p[..., :n_loc].reshape(b, h, rows_n, GRID_W, kr, GRID_W)
    o = jnp.einsum('bhrqkw,brkwhd->brqhd', p_loc, vg) + jnp.einsum('bhrql,blhd->brqhd', p[..., n_loc:], vc)
    return o.reshape(b, s, h * dh)


def gla_scan(q, k, v, log_a, s0):
    b, t, h, dk = k.shape
    n = t // GLA_CHUNK

    def chunks(a):
        return a.astype(jnp.float32).reshape(b, n, GLA_CHUNK, h, a.shape[-1]).transpose(1, 0, 3, 2, 4)

    mask = jnp.tril(jnp.ones((GLA_CHUNK, GLA_CHUNK), bool))[..., None]
    with_out = q is not None
    xs = (chunks(k), chunks(v), chunks(log_a)) + ((chunks(q),) if with_out else ())

    def step(state, inp):
        kc, vc, gc = inp[0], inp[1], inp[2]
        bcum = jnp.cumsum(gc, axis=-2)
        b_last = bcum[..., -1:, :]
        new_state = jnp.exp(b_last)[..., 0, :, None] * state + jnp.einsum(
            'bhjd,bhje->bhde', kc * jnp.exp(b_last - bcum), vc)
        if not with_out:
            return new_state, None
        qc = inp[3]
        diff = bcum[..., :, None, :] - bcum[..., None, :, :]
        decay = jnp.exp(jnp.where(mask, diff, -jnp.inf))
        attn = jnp.einsum('bhid,bhjd,bhijd->bhij', qc, kc, decay)
        o = attn @ vc + jnp.einsum('bhid,bhde->bhie', qc * jnp.exp(bcum), state)
        return new_state, o

    s_fin, o = lax.scan(step, s0, xs)
    if with_out:
        o = o.transpose(1, 0, 3, 2, 4).reshape(b, t, h, v.shape[-1])
    return o, s_fin


def na_branch(pl, pc, rpb, with_ctx):
    def heads(a):
        return a.reshape(a.shape[0], a.shape[1], NA_HEADS, NA_HEAD_DIM)
    kc, vc = heads(pc['na_k']), heads(pc['na_v'])
    yl = na_latent(heads(pl['na_q']), heads(pl['na_k']), heads(pl['na_v']), kc, vc, rpb)
    yc = gqa_dense(heads(pc['na_q']), kc, vc) if with_ctx else None
    return yl, yc


def gla_branch(pl, pc, w_a2, b_a, norm_g, with_ctx):
    def heads(a, d):
        return a.reshape(a.shape[0], a.shape[1], GLA_HEADS, d)

    def log_decay(low, dirn):
        z = (low @ w_a2[dirn]).astype(jnp.float32) + b_a[dirn].astype(jnp.float32)
        return heads(jax.nn.log_sigmoid(z) / GLA_TAU, GLA_DK)

    def flip(a):
        return None if a is None else a[:, ::-1]

    def finish(o, og):
        o = rmsnorm(o.astype(og.dtype), norm_g)
        return o.reshape(og.shape) * jax.nn.silu(og)

    scale = GLA_DK ** -0.5
    bsz = pl['gla_k'].shape[0]
    s0 = jnp.zeros((bsz, GLA_HEADS, GLA_DK, GLA_DV), jnp.float32)
    qc = heads(pc['gla_q'], GLA_DK) * scale if with_ctx else None
    kc, vc = heads(pc['gla_k'], GLA_DK), heads(pc['gla_v'], GLA_DV)
    oc_f, s_f = gla_scan(qc, kc, vc, log_decay(pc['gla_af'], 0), s0)
    oc_b, s_b = gla_scan(flip(qc), flip(kc), flip(vc), flip(log_decay(pc['gla_ab'], 1)), s0)
    ql = heads(pl['gla_q'], GLA_DK) * scale
    kl, vl = heads(pl['gla_k'], GLA_DK), heads(pl['gla_v'], GLA_DV)
    ol_f, _ = gla_scan(ql, kl, vl, log_decay(pl['gla_af'], 0), s_f)
    ol_b, _ = gla_scan(flip(ql), flip(kl), flip(vl), flip(log_decay(pl['gla_ab'], 1)), s_b)
    yl = finish(ol_f + flip(ol_b), pl['gla_og'])
    yc = finish(oc_f + flip(oc_b), pc['gla_og']) if with_ctx else None
    return yl, yc


def gqa_branch(pl, pc, qn_g, kn_g, cos, sin, with_ctx):
    def heads(a, n):
        return a.reshape(a.shape[0], a.shape[1], n, GQA_HEAD_DIM)
    kc = rmsnorm(heads(pc['gqa_k'], GQA_KV_HEADS), kn_g)
    vc = heads(pc['gqa_v'], GQA_KV_HEADS)
    ql = apply_rope(rmsnorm(heads(pl['gqa_q'], GQA_HEADS), qn_g), cos, sin)
    kl = apply_rope(rmsnorm(heads(pl['gqa_k'], GQA_KV_HEADS), kn_g), cos, sin)
    vl = heads(pl['gqa_v'], GQA_KV_HEADS)
    yl = gqa_blocked(ql, kl, vl, kc, vc)
    yc = gqa_dense(rmsnorm(heads(pc['gqa_q'], GQA_HEADS), qn_g), kc, vc) if with_ctx else None
    return yl, yc


def mixer(hl, hc, w_in, rpb, gla_w_a2, gla_b_a, gla_norm_g, qn_g, kn_g,
          w_pa, w_pb, w_pc, w_out, cos, sin, with_ctx):
    pl = in_proj(hl, w_in)
    pc = in_proj(hc, w_in, None if with_ctx else CTX_KV_SPLITS)
    a_l, a_c = na_branch(pl, pc, rpb, with_ctx)
    b_l, b_c = gla_branch(pl, pc, gla_w_a2, gla_b_a, gla_norm_g, with_ctx)
    c_l, c_c = gqa_branch(pl, pc, qn_g, kn_g, cos, sin, with_ctx)

    def merge(p, a, b, c):
        m = (jax.nn.sigmoid(p['gate_a']) * (a @ w_pa) + jax.nn.sigmoid(p['gate_b']) * (b @ w_pb)
             + jax.nn.sigmoid(p['gate_c']) * (c @ w_pc))
        return m @ w_out

    yl = merge(pl, a_l, b_l, c_l)
    yc = merge(pc, a_c, b_c, c_c) if with_ctx else None
    return yl, yc


def moe_ffn(h, router_w, router_b, w_gate, w_up, w_down):
    x = h.reshape(-1, D_MODEL)
    t = x.shape[0]
    n_assign = t * TOP_K
    logits = (x @ router_w).astype(jnp.float32) + router_b.astype(jnp.float32)
    top_v, top_i = lax.top_k(logits, TOP_K)
    wts = jax.nn.softmax(top_v, axis=-1)
    flat_e = top_i.reshape(-1)
    flat_t = jnp.repeat(jnp.arange(t, dtype=jnp.int32), TOP_K)
    flat_w = wts.reshape(-1)
    order = jnp.argsort(flat_e)
    se = flat_e[order]
    counts = jnp.bincount(flat_e, length=N_EXPERTS)
    starts = jnp.cumsum(counts) - counts
    padded = (counts + MOE_BLOCK - 1) // MOE_BLOCK * MOE_BLOCK
    pends = jnp.cumsum(padded)
    pstarts = pends - padded
    dest = pstarts[se] + jnp.arange(n_assign) - starts[se]
    n_blk = -(-n_assign // MOE_BLOCK) + N_EXPERTS
    slot_t = jnp.full((n_blk * MOE_BLOCK,), t, jnp.int32).at[dest].set(flat_t[order])
    slot_w = jnp.zeros((n_blk * MOE_BLOCK,), jnp.float32).at[dest].set(flat_w[order])
    block_e = jnp.minimum(jnp.searchsorted(pends, jnp.arange(n_blk) * MOE_BLOCK, side='right'), N_EXPERTS - 1)
    xp = jnp.concatenate([x, jnp.zeros((1, D_MODEL), x.dtype)], axis=0)
    xb = xp[slot_t].reshape(n_blk, MOE_BLOCK, D_MODEL)
    yb = lax.map(lambda a: swiglu(a[0], w_gate[a[1]], w_up[a[1]], w_down[a[1]]), (xb, block_e))
    y = jnp.zeros((t + 1, D_MODEL), x.dtype).at[slot_t].add(
        yb.reshape(-1, D_MODEL) * slot_w[:, None].astype(x.dtype))
    return y[:t].reshape(h.shape)


def setup_inputs(seed: int = 0) -> dict:
    key = jax.random.key(seed)
    k = jax.random.split(key, 28)
    n_dense = (DEPTH + 1) // 2
    n_moe = DEPTH // 2
    d = D_MODEL

    def nrm(i, shape, scale):
        return jax.random.normal(k[i], shape, jnp.float32) * scale

    return {
        "x": nrm(0, (BATCH, SEQ, d), 1.0),
        "c": nrm(1, (BATCH, d), 1.0),
        "ctx": nrm(2, (BATCH, CTX_LEN, d), 1.0),
        "c_ctx": nrm(3, (d,), 1.0),
        "w_ada": nrm(4, (DEPTH, d, 6 * d), 0.5 * d ** -0.5),
        "b_ada": nrm(5, (DEPTH, 6 * d), 0.01),
        "norm1_g": 1.0 + nrm(6, (DEPTH, d), 0.05),
        "norm2_g": 1.0 + nrm(7, (DEPTH, d), 0.05),
        "w_in": nrm(8, (DEPTH, d, D_IN), d ** -0.5),
        "na_rpb": nrm(9, (DEPTH, NA_HEADS, 2 * NA_WIN_ROWS - 1, 2 * NA_WIN_COLS - 1), 0.1),
        "gla_w_a2": nrm(10, (DEPTH, 2, GLA_GATE_RANK, GLA_KW), GLA_GATE_RANK ** -0.5),
        "gla_b_a": nrm(11, (DEPTH, 2, GLA_KW), 0.1),
        "gla_norm_g": 1.0 + nrm(12, (DEPTH, GLA_DV), 0.05),
        "gqa_qn_g": 1.0 + nrm(13, (DEPTH, GQA_HEAD_DIM), 0.05),
        "gqa_kn_g": 1.0 + nrm(14, (DEPTH, GQA_HEAD_DIM), 0.05),
        "w_pa": nrm(15, (DEPTH, BRANCH_W, d), BRANCH_W ** -0.5),
        "w_pb": nrm(16, (DEPTH, BRANCH_W, d), BRANCH_W ** -0.5),
        "w_pc": nrm(17, (DEPTH, BRANCH_W, d), BRANCH_W ** -0.5),
        "w_out": nrm(18, (DEPTH, d, d), d ** -0.5),
        "dense_w_gate": nrm(19, (n_dense, d, D_FF), d ** -0.5),
        "dense_w_up": nrm(20, (n_dense, d, D_FF), d ** -0.5),
        "dense_w_down": nrm(21, (n_dense, D_FF, d), D_FF ** -0.5),
        "router_w": nrm(22, (n_moe, d, N_EXPERTS), d ** -0.5),
        "router_b": nrm(23, (n_moe, N_EXPERTS), 0.01),
        "moe_w_gate": nrm(24, (n_moe, N_EXPERTS, d, D_FF), d ** -0.5),
        "moe_w_up": nrm(25, (n_moe, N_EXPERTS, d, D_FF), d ** -0.5),
        "moe_w_down": nrm(26, (n_moe, N_EXPERTS, D_FF, d), D_FF ** -0.5),
        "final_norm_g": 1.0 + nrm(27, (d,), 0.05),
    }


def reference(x, c, ctx, c_ctx, w_ada, b_ada, norm1_g, norm2_g, w_in, na_rpb, gla_w_a2, gla_b_a,
              gla_norm_g, gqa_qn_g, gqa_kn_g, w_pa, w_pb, w_pc, w_out, dense_w_gate, dense_w_up,
              dense_w_down, router_w, router_b, moe_w_gate, moe_w_up, moe_w_down, final_norm_g):
    cos, sin = axial_rope_tables(x.shape[1])
    xl, xc = x, ctx
    c_act = jax.nn.silu(c)
    cc_act = jax.nn.silu(c_ctx)
    for i in range(DEPTH):
        last = i == DEPTH - 1
        mod_l = (c_act @ w_ada[i] + b_ada[i])[:, None, :]
        mod_c = cc_act @ w_ada[i] + b_ada[i]
        sh1, sc1, g1, sh2, sc2, g2 = jnp.split(mod_l, 6, axis=-1)
        csh1, csc1, cg1, csh2, csc2, cg2 = jnp.split(mod_c, 6, axis=-1)
        hl = rmsnorm(xl, norm1_g[i]) * (1.0 + sc1) + sh1
        hc = rmsnorm(xc, norm1_g[i]) * (1.0 + csc1) + csh1
        yl, yc = mixer(hl, hc, w_in[i], na_rpb[i], gla_w_a2[i], gla_b_a[i], gla_norm_g[i],
                       gqa_qn_g[i], gqa_kn_g[i], w_pa[i], w_pb[i], w_pc[i], w_out[i], cos, sin,
                       not last)
        xl = xl + g1 * yl
        j = i // 2
        if i % 2 == 0:
            ffn = lambda h: swiglu(h, dense_w_gate[j], dense_w_up[j], dense_w_down[j])
        else:
            ffn = lambda h: moe_ffn(h, router_w[j], router_b[j], moe_w_gate[j], moe_w_up[j], moe_w_down[j])
        xl = xl + g2 * ffn(rmsnorm(xl, norm2_g[i]) * (1.0 + sc2) + sh2)
        if not last:
            xc = xc + cg1 * yc
            xc = xc + cg2 * ffn(rmsnorm(xc, norm2_g[i]) * (1.0 + csc2) + csh2)
    return rmsnorm(xl, final_norm_g)
```

```cpp
#include <hip/hip_runtime.h>
#include <cstdio>
#include <cstdint>

#ifndef MK_SPLIT
#define MK_SPLIT 0
#endif

constexpr int D = 2048, NB = 4, S = 2048, LC = 256, NL = NB * S, NC = NB * LC, NR = NL + NC;
constexpr int DIN = 13856, DFF = 5632, NE = 8, GW = 64;
constexpr int S_AF = 6144;
constexpr int PW = 13824;
constexpr int O_NAQ = 0, O_NAK = 1024, O_NAV = 2048, O_GLQ = 3072, O_GLK = 3584, O_GLV = 4096, O_GLOG = 5120,
              O_GQQ = 6144, O_GQK = 7168, O_GQV = 7424, O_GA = 7680, O_GB = 9728, O_GC = 11776;
constexpr int NIN = 14080;
constexpr int MOD_W = 6 * D;
constexpr int NSLOT = 18432;
constexpr float EPS = 1e-6f;
constexpr int NWAVES = 8, NTHR = 512;

#define GAS __attribute__((address_space(1)))
#define LAS __attribute__((address_space(3)))
typedef unsigned short bf16_t;
typedef short bf16x8 __attribute__((ext_vector_type(8)));
typedef float f32x4 __attribute__((ext_vector_type(4)));
typedef unsigned u32x4 __attribute__((ext_vector_type(4)));
typedef unsigned u32x2 __attribute__((ext_vector_type(2)));

__device__ __forceinline__ int batch_of(int r) { return r < NL ? (r >> 11) : 4; }
__device__ __forceinline__ float bf2f(bf16_t v) { return __uint_as_float((unsigned)v << 16); }
__device__ __forceinline__ unsigned f2bf(float f) { unsigned u = __float_as_uint(f); return (u + 0x7fffu + ((u >> 16) & 1u)) >> 16; }
__device__ __forceinline__ unsigned pk2(float lo, float hi) { return f2bf(lo) | (f2bf(hi) << 16); }
__device__ __forceinline__ unsigned cvt_pk_bf16(float lo, float hi) { unsigned r; asm volatile("v_cvt_pk_bf16_f32 %0, %1, %2" : "=v"(r) : "v"(lo), "v"(hi)); return r; }
__device__ __forceinline__ float sigmoidf_(float x) { return 1.f / (1.f + expf(-x)); }
__device__ __forceinline__ float siluf_(float x) { return x / (1.f + expf(-x)); }
__device__ __forceinline__ float fast_sigmoid(float x) { return __builtin_amdgcn_rcpf(1.f + __builtin_amdgcn_exp2f(-1.4426950408889634f * x)); }
__device__ __forceinline__ float wave_sum(float v) {
#pragma unroll
    for (int o = 1; o < 64; o <<= 1) v += __shfl_xor(v, o);
    return v;
}
__device__ __forceinline__ float wave_max(float v) {
#pragma unroll
    for (int o = 1; o < 64; o <<= 1) v = fmaxf(v, __shfl_xor(v, o));
    return v;
}

#define XB_TMO      128
#define XB_XCNT(j)  (256  + 64 * (j))
#define XB_XSUB(j)  (1280 + 64 * (j))
#define XB_XGEN(j)  (2304 + 64 * (j))
#define XB_TOP      3328
#define XB_TOPGEN   3392
#define XCD_BAR_WORDS 3456
#define XB_SPIN_CAP (1u << 18)
__device__ __forceinline__ unsigned xb_ld(unsigned* p)              { return __hip_atomic_load(p, __ATOMIC_RELAXED, __HIP_MEMORY_SCOPE_AGENT); }
__device__ __forceinline__ unsigned xb_add(unsigned* p, unsigned v) { return __hip_atomic_fetch_add(p, v, __ATOMIC_RELAXED, __HIP_MEMORY_SCOPE_AGENT); }
__device__ __forceinline__ unsigned xb_xcc_id() { return (unsigned)__builtin_amdgcn_s_getreg((3 << 11) | 20) & 0xFu; }
#define XB_SPIN(cond, bar) do { unsigned _sp = 0; while (cond) { __builtin_amdgcn_s_sleep(1); \
    if ((++_sp & 255u) == 0u) { if (xb_ld(&(bar)[XB_TMO])) break; if (_sp > XB_SPIN_CAP) { atomicAdd(&(bar)[XB_TMO], 1u); break; } } } } while (0)
struct XcdBarrier { unsigned* bar; unsigned x; volatile LAS unsigned* st; };
__device__ __forceinline__ XcdBarrier xcd_barrier_post(unsigned* bar, volatile LAS unsigned* st) {
    XcdBarrier b; b.bar = bar; b.x = xb_xcc_id(); b.st = st;
    if (threadIdx.x == 0) (void)xb_add(&bar[XB_XCNT(b.x)], 1u);
    return b;
}
__device__ __forceinline__ void xcd_barrier_complete(unsigned* bar, unsigned x, unsigned& nloc, unsigned& nx) {
    const unsigned G = gridDim.x * gridDim.y * gridDim.z;
    unsigned sum, cnt, mine, sp = 0u;
    for (;;) {
        sum = 0u; cnt = 0u; mine = 0u;
#pragma unroll
        for (unsigned j = 0; j < 16; ++j) { const unsigned c = xb_ld(&bar[XB_XCNT(j)]); sum += c; cnt += (c > 0u) ? 1u : 0u; mine = (j == x) ? c : mine; }
        if (sum == G) break;
        __builtin_amdgcn_s_sleep(1);
        if ((++sp & 255u) == 0u) { if (xb_ld(&bar[XB_TMO])) break; if (sp > XB_SPIN_CAP) { atomicAdd(&bar[XB_TMO], 1u); break; } }
    }
    nloc = mine > 0u ? mine : 1u; nx = cnt > 0u ? cnt : 1u;
}
__device__ __forceinline__ void xcd_barrier(const XcdBarrier& b) {
    asm volatile("s_waitcnt vmcnt(0)" ::: "memory");
    __syncthreads();
    if (threadIdx.x == 0) {
        unsigned* bar = b.bar;
        __builtin_amdgcn_s_waitcnt(0);
        unsigned nloc = b.st[0], nx = b.st[1];
        if (nloc == 0u) { xcd_barrier_complete(bar, b.x, nloc, nx); b.st[0] = nloc; b.st[1] = nx; }
        const unsigned old = xb_add(&bar[XB_XSUB(b.x)], 1u);
        const unsigned gen = old / nloc;
        if (old + 1u == (gen + 1u) * nloc) {
            __builtin_amdgcn_fence(__ATOMIC_RELEASE, "agent");
            asm volatile("s_waitcnt vmcnt(0)" ::: "memory");
            const unsigned og = xb_add(&bar[XB_TOP], 1u);
            const unsigned tg = og / nx;
            if (og + 1u == (tg + 1u) * nx) xb_add(&bar[XB_TOPGEN], 1u);
            else XB_SPIN(xb_ld(&bar[XB_TOPGEN]) == tg, bar);
            __builtin_amdgcn_fence(__ATOMIC_ACQUIRE, "agent");
            xb_add(&bar[XB_XGEN(b.x)], 1u);
            asm volatile("s_waitcnt vmcnt(0)" ::: "memory");
        } else {
            XB_SPIN(xb_ld(&bar[XB_XGEN(b.x)]) == gen, bar);
            __builtin_amdgcn_fence(__ATOMIC_ACQUIRE, "agent");
            asm volatile("s_waitcnt vmcnt(0)" ::: "memory");
        }
    }
    __syncthreads();
}

namespace pg8 {
constexpr int BM = 256, BK = 64, HALF = 128, HTB = HALF * BK * 2, STAGE_BYTES = 8 * HTB, NXCD = 8, WGM = 8;
__host__ __device__ __forceinline__ int lds_byte(int r, int c) { const int st = (r >> 4) * 2 + (c >> 5), rr = r & 15, cc = c & 31, ob = rr * 64 + cc * 2; return st * 1024 + (ob ^ (((ob >> 9) & 1) << 5)); }
__host__ __device__ __forceinline__ void stage_rc(int b, int& R, int& C) { const int st = b / 1024, sb = b % 1024, swz = sb ^ (((sb >> 9) & 1) << 5); R = (st >> 1) * 16 + swz / 64; C = (st & 1) * 32 + (swz % 64) / 2; }
__host__ __device__ __forceinline__ int perm32(int rho) { const int n = rho >> 4, i = rho & 15; return 8 * (i >> 2) + 4 * n + (i & 3); }

struct Unit { const char* a; const char* b; int pm, pn, sub, aux; };

__device__ __forceinline__ void tile_of(int wgid, int nM, int nN, int& pm, int& pn) {
    const int nwg = nM * nN; { const int q = nwg / NXCD, r = nwg % NXCD, xcd = wgid % NXCD, off = wgid / NXCD; wgid = (xcd < r ? xcd * (q + 1) : r * (q + 1) + (xcd - r) * q) + off; }
    const int nig = WGM * nN, gid = wgid / nig, fm = gid * WGM, gsz = (nM - fm) < WGM ? (nM - fm) : WGM;
    pm = fm + ((wgid % nig) % gsz); pn = (wgid % nig) / gsz;
}

struct UnitRec { unsigned a_lo, a_hi, b_lo, b_hi; int pm, pn, sub, aux; };
struct TableOrder {
    const LAS UnitRec* tab; int n;
    __device__ __forceinline__ bool next(int i, Unit& u) const {
        if (i >= n) return false;
        const LAS unsigned* r = (const LAS unsigned*)(tab + i);
        const unsigned alo = __builtin_amdgcn_readfirstlane(r[0]), ahi = __builtin_amdgcn_readfirstlane(r[1]), blo = __builtin_amdgcn_readfirstlane(r[2]), bhi = __builtin_amdgcn_readfirstlane(r[3]);
        u.a = (const char*)(((unsigned long long)ahi << 32) | alo); u.b = (const char*)(((unsigned long long)bhi << 32) | blo);
        u.pm = __builtin_amdgcn_readfirstlane(r[4]); u.pn = __builtin_amdgcn_readfirstlane(r[5]); u.sub = __builtin_amdgcn_readfirstlane(r[6]); u.aux = __builtin_amdgcn_readfirstlane(r[7]);
        return true;
    }
};
template <class Epi, class Sched>
__device__ __forceinline__ void gemm_phase(LAS unsigned char* lds, const int K, const Sched& S, const Epi& E) {
    int tid = threadIdx.x; asm volatile("" : "+v"(tid));
    const int wid = __builtin_amdgcn_readfirstlane(tid >> 6), lane = tid & 63, wr = wid >> 2, wc = wid & 3, fr = lane & 15, fq = lane >> 4;
    const int nt = K / BK;
    unsigned voffA[2], voffB[2];
#pragma unroll
    for (int i = 0; i < 2; ++i) { int R, C; stage_rc(tid * 16 + i * 8192, R, C); const int Rb = Epi::PERM ? ((R & ~31) + perm32(R & 31)) : R;
        voffA[i] = (unsigned)(R * K + C) * 2u; voffB[i] = (unsigned)(Rb * K + C) * 2u; }
    const size_t kstep = (size_t)(BK * 2);
    const size_t hstep = (size_t)HALF * K * 2;
    const unsigned ldsw = (unsigned)wid * 1024u;
    const int aoff = lds_byte(wr * 64 + fr, fq * 8), boff = lds_byte(wc * 32 + fr, fq * 8);
#define PG8_SA(b, h) (((b) * 2 + (h)) * HTB)
#define PG8_SB(b, h) ((4 + (b) * 2 + (h)) * HTB)
#define PG8_STAGE(bufoff, gbase, voff) do { _Pragma("unroll") for (int _i = 0; _i < 2; ++_i) \
        __builtin_amdgcn_global_load_lds((const unsigned*)((const char*)(gbase) + (voff)[_i]), (LAS unsigned*)(lds + (bufoff) + ldsw + _i * 8192), 16, 0, 0); } while (0)
#define PG8_LDA(dst, b, h) do { _Pragma("unroll") for (int m = 0; m < 4; ++m) _Pragma("unroll") for (int k = 0; k < 2; ++k) dst[m][k] = *(const LAS bf16x8*)(lds + PG8_SA(b, h) + aoff + m * 2048 + k * 1024); } while (0)
#define PG8_LDB(dst, b, h) do { _Pragma("unroll") for (int n = 0; n < 2; ++n) _Pragma("unroll") for (int k = 0; k < 2; ++k) dst[n][k] = *(const LAS bf16x8*)(lds + PG8_SB(b, h) + boff + n * 2048 + k * 1024); } while (0)
#define PG8_MMA(ai, bj, At, Bt) do { __builtin_amdgcn_s_setprio(1); _Pragma("unroll") for (int m = 0; m < 4; ++m) _Pragma("unroll") for (int n = 0; n < 2; ++n) _Pragma("unroll") for (int k = 0; k < 2; ++k) \
        acc[ai][bj][m][n] = __builtin_amdgcn_mfma_f32_16x16x32_bf16(Bt[n][k], At[m][k], acc[ai][bj][m][n], 0, 0, 0); __builtin_amdgcn_s_setprio(0); } while (0)
#define PG8_WAIT_V(n) asm volatile("s_waitcnt vmcnt(" #n ")" ::: "memory")
#define PG8_WAIT_L(n) asm volatile("s_waitcnt lgkmcnt(" #n ")" ::: "memory")
#define PG8_BAR __builtin_amdgcn_s_barrier()
#define PG8_SCHED __builtin_amdgcn_sched_barrier(0)
    Unit cur, nxt; int ui = 0;
    if (!S.next(0, cur)) return;
    f32x4 acc[2][2][4][2];
#pragma unroll
    for (int a = 0; a < 2; ++a)
#pragma unroll
        for (int b = 0; b < 2; ++b)
#pragma unroll
            for (int m = 0; m < 4; ++m)
#pragma unroll
                for (int n = 0; n < 2; ++n) acc[a][b][m][n] = (f32x4){0.f, 0.f, 0.f, 0.f};
    bf16x8 At[4][2], B0[2][2], B1[2][2];
    const char* cA = cur.a; const char* cB = cur.b;
    PG8_STAGE(PG8_SB(0, 0), cB, voffB); PG8_STAGE(PG8_SB(0, 1), cB + hstep, voffB); PG8_STAGE(PG8_SA(0, 0), cA, voffA); PG8_STAGE(PG8_SA(0, 1), cA + hstep, voffA);
    if (wr == 1) PG8_BAR;
    PG8_WAIT_V(2); PG8_BAR;
    PG8_STAGE(PG8_SB(1, 0), cB + kstep, voffB); PG8_STAGE(PG8_SA(1, 0), cA + kstep, voffA); PG8_STAGE(PG8_SB(1, 1), cB + hstep + kstep, voffB);
    PG8_WAIT_V(6); PG8_BAR;
    for (;;) {
        const bool has_next = S.next(ui + 1, nxt);
        const char* nA = has_next ? nxt.a : cA; const char* nB = has_next ? nxt.b : cB;
        for (int t = 0; t < nt; t += 2) {
            const bool last = (t == nt - 2);
            const char* a1 = cA + (size_t)(t + 1) * kstep;
            const char* a2 = last ? nA : cA + (size_t)(t + 2) * kstep; const char* b2 = last ? nB : cB + (size_t)(t + 2) * kstep;
            const char* a3 = a2 + kstep; const char* b3 = b2 + kstep;
            PG8_LDB(B0, 0, 0); PG8_LDB(B1, 0, 1); PG8_SCHED; PG8_LDA(At, 0, 0); PG8_STAGE(PG8_SA(1, 1), a1 + hstep, voffA);
            PG8_WAIT_V(8); PG8_WAIT_L(0); PG8_BAR; PG8_MMA(0, 0, At, B0); PG8_MMA(0, 1, At, B1); PG8_BAR; PG8_SCHED;
            PG8_LDA(At, 0, 1); PG8_STAGE(PG8_SB(0, 0), b2, voffB); PG8_STAGE(PG8_SB(0, 1), b2 + hstep, voffB); PG8_STAGE(PG8_SA(0, 0), a2, voffA);
            PG8_WAIT_V(8); PG8_WAIT_L(0); PG8_BAR; PG8_MMA(1, 0, At, B0); PG8_MMA(1, 1, At, B1); PG8_BAR; PG8_SCHED;
            PG8_LDB(B0, 1, 0); PG8_LDB(B1, 1, 1); PG8_SCHED; PG8_LDA(At, 1, 0); PG8_STAGE(PG8_SA(0, 1), a2 + hstep, voffA);
            PG8_WAIT_V(8); PG8_WAIT_L(0); PG8_BAR; PG8_MMA(0, 0, At, B0); PG8_MMA(0, 1, At, B1); PG8_BAR; PG8_SCHED;
            PG8_LDA(At, 1, 1); PG8_STAGE(PG8_SB(1, 0), b3, voffB); PG8_STAGE(PG8_SB(1, 1), b3 + hstep, voffB); PG8_STAGE(PG8_SA(1, 0), a3, voffA);
            PG8_WAIT_V(8); PG8_WAIT_L(0); PG8_BAR; PG8_MMA(1, 0, At, B0); PG8_MMA(1, 1, At, B1); PG8_BAR; PG8_SCHED;
        }
        if (wr == 0) PG8_BAR;
        E(acc, cur, wr, wc, fr, fq);
        if (!has_next) break;
        cur = nxt; cA = nA; cB = nB; ++ui;
        if (wr == 1) PG8_BAR;
    }
    PG8_WAIT_V(0);
    PG8_BAR;
#undef PG8_SA
#undef PG8_SB
#undef PG8_STAGE
#undef PG8_LDA
#undef PG8_LDB
#undef PG8_MMA
#undef PG8_WAIT_V
#undef PG8_WAIT_L
#undef PG8_BAR
#undef PG8_SCHED
}
#define ACC_T f32x4 (&acc)[2][2][4][2]
#define ZERO_ACC() do { _Pragma("unroll") for (int a_ = 0; a_ < 2; ++a_) _Pragma("unroll") for (int b_ = 0; b_ < 2; ++b_) _Pragma("unroll") for (int m_ = 0; m_ < 4; ++m_) \
    _Pragma("unroll") for (int n_ = 0; n_ < 2; ++n_) acc[a_][b_][m_][n_] = (f32x4){0.f, 0.f, 0.f, 0.f}; } while (0)

struct EpiInproj {
    static constexpr bool PERM = true;
    bf16_t* P; float* ABF;
    __device__ __forceinline__ void operator()(ACC_T, const Unit& u, int wr, int wc, int fr, int fq) const {
        const int row0 = u.pm * BM + wr * 64 + fr;
        if (u.pn < 54) {
            const bool gate = u.pn >= 30;
#pragma unroll
            for (int ai = 0; ai < 2; ++ai)
#pragma unroll
                for (int m = 0; m < 4; ++m) { bf16_t* rowp = P + (size_t)(row0 + ai * HALF + m * 16) * PW + u.pn * BM + wc * 32 + 8 * fq;
#pragma unroll
                    for (int bj = 0; bj < 2; ++bj) { f32x4 v0 = acc[ai][bj][m][0], v1 = acc[ai][bj][m][1];
                        if (gate) {
#pragma unroll
                            for (int j = 0; j < 4; ++j) { v0[j] = fast_sigmoid(v0[j]); v1[j] = fast_sigmoid(v1[j]); } }
                        u32x4 w; w.x = cvt_pk_bf16(v0[0], v0[1]); w.y = cvt_pk_bf16(v0[2], v0[3]); w.z = cvt_pk_bf16(v1[0], v1[1]); w.w = cvt_pk_bf16(v1[2], v1[3]);
                        *(u32x4*)(rowp + bj * HALF) = w; } }
        } else if (wc == 0) {
#pragma unroll
            for (int ai = 0; ai < 2; ++ai)
#pragma unroll
                for (int m = 0; m < 4; ++m) { float* rp = ABF + (size_t)(row0 + ai * HALF + m * 16) * 32 + 8 * fq;
                    *(f32x4*)rp = acc[ai][0][m][0]; *(f32x4*)(rp + 4) = acc[ai][0][m][1]; }
        }
        ZERO_ACC();
    }
};
struct EpiMerge {
    static constexpr bool PERM = true;
    const bf16_t* P; bf16_t* MG;
    __device__ __forceinline__ void operator()(ACC_T, const Unit& u, int wr, int wc, int fr, int fq) const {
        const int row0 = u.pm * BM + wr * 64 + fr, col0 = u.pn * BM + wc * 32 + 8 * fq;
        const int gcur = u.sub == 0 ? O_GA : (u.sub == 1 ? O_GB : O_GC), gnext = u.sub == 0 ? O_GB : O_GC;
#pragma unroll
        for (int ai = 0; ai < 2; ++ai)
#pragma unroll
            for (int m = 0; m < 4; ++m) { const size_t r = (size_t)(row0 + ai * HALF + m * 16);
#pragma unroll
                for (int bj = 0; bj < 2; ++bj) {
                    const u32x4 gc = *(const u32x4*)(P + r * PW + gcur + col0 + bj * HALF);
                    float sc[8]; sc[0] = __uint_as_float(gc.x << 16); sc[1] = __uint_as_float(gc.x & 0xffff0000u); sc[2] = __uint_as_float(gc.y << 16); sc[3] = __uint_as_float(gc.y & 0xffff0000u);
                    sc[4] = __uint_as_float(gc.z << 16); sc[5] = __uint_as_float(gc.z & 0xffff0000u); sc[6] = __uint_as_float(gc.w << 16); sc[7] = __uint_as_float(gc.w & 0xffff0000u);
#pragma unroll
                    for (int j = 0; j < 8; ++j) sc[j] = fmaxf(sc[j], 1e-20f);
                    if (u.sub < 2) {
                        const u32x4 gn = *(const u32x4*)(P + r * PW + gnext + col0 + bj * HALF);
                        float sn[8]; sn[0] = __uint_as_float(gn.x << 16); sn[1] = __uint_as_float(gn.x & 0xffff0000u); sn[2] = __uint_as_float(gn.y << 16); sn[3] = __uint_as_float(gn.y & 0xffff0000u);
                        sn[4] = __uint_as_float(gn.z << 16); sn[5] = __uint_as_float(gn.z & 0xffff0000u); sn[6] = __uint_as_float(gn.w << 16); sn[7] = __uint_as_float(gn.w & 0xffff0000u);
#pragma unroll
                        for (int j = 0; j < 8; ++j) { const float f = sc[j] * __builtin_amdgcn_rcpf(fmaxf(sn[j], 1e-20f)); if (j < 4) acc[ai][bj][m][0][j] *= f; else acc[ai][bj][m][1][j - 4] *= f; }
                    } else {
                        f32x4 v0 = acc[ai][bj][m][0], v1 = acc[ai][bj][m][1];
#pragma unroll
                        for (int j = 0; j < 4; ++j) { v0[j] *= sc[j]; v1[j] *= sc[4 + j]; }
                        u32x4 w; w.x = cvt_pk_bf16(v0[0], v0[1]); w.y = cvt_pk_bf16(v0[2], v0[3]); w.z = cvt_pk_bf16(v1[0], v1[1]); w.w = cvt_pk_bf16(v1[2], v1[3]);
                        *(u32x4*)(MG + r * D + col0 + bj * HALF) = w;
                        acc[ai][bj][m][0] = (f32x4){0.f, 0.f, 0.f, 0.f}; acc[ai][bj][m][1] = (f32x4){0.f, 0.f, 0.f, 0.f};
                    } }
                asm volatile("" ::: "memory"); }
    }
};
struct EpiResid {
    static constexpr bool PERM = false;
    float* X; const float* modl; int goff;
    __device__ __forceinline__ void operator()(ACC_T, const Unit& u, int wr, int wc, int fr, int fq) const {
        const int row0 = u.pm * BM + wr * 64 + fr, col0 = u.pn * BM + wc * 32 + 4 * fq;
        const float* g = modl + (size_t)batch_of(u.pm * BM) * MOD_W + goff + col0;
        f32x4 gv[2][2];
#pragma unroll
        for (int bj = 0; bj < 2; ++bj)
#pragma unroll
            for (int n = 0; n < 2; ++n) gv[bj][n] = *(const f32x4*)(g + bj * HALF + n * 16);
#pragma unroll
        for (int ai = 0; ai < 2; ++ai)
#pragma unroll
            for (int m = 0; m < 4; ++m) { float* rowp = X + (size_t)(row0 + ai * HALF + m * 16) * D + col0;
#pragma unroll
                for (int bj = 0; bj < 2; ++bj)
#pragma unroll
                    for (int n = 0; n < 2; ++n) { f32x4* p = (f32x4*)(rowp + bj * HALF + n * 16); *p = *p + gv[bj][n] * acc[ai][bj][m][n]; } }
        ZERO_ACC();
    }
};
struct EpiSwiglu {
    static constexpr bool PERM = true;
    bf16_t* ACT;
    __device__ __forceinline__ void operator()(ACC_T, const Unit& u, int wr, int wc, int fr, int fq) const {
        const int row0 = u.pm * BM + wr * 64 + fr, col0 = u.pn * HALF + wc * 32 + 8 * fq;
#pragma unroll
        for (int ai = 0; ai < 2; ++ai)
#pragma unroll
            for (int m = 0; m < 4; ++m) { f32x4 o[2];
#pragma unroll
                for (int n = 0; n < 2; ++n)
#pragma unroll
                    for (int j = 0; j < 4; ++j) { const float gt = acc[ai][0][m][n][j]; o[n][j] = gt * fast_sigmoid(gt) * acc[ai][1][m][n][j]; }
                u32x4 w; w.x = cvt_pk_bf16(o[0][0], o[0][1]); w.y = cvt_pk_bf16(o[0][2], o[0][3]); w.z = cvt_pk_bf16(o[1][0], o[1][1]); w.w = cvt_pk_bf16(o[1][2], o[1][3]);
                *(u32x4*)(ACT + (size_t)(row0 + ai * HALF + m * 16) * DFF + col0) = w; }
        ZERO_ACC();
    }
};
struct EpiStoreF32 {
    static constexpr bool PERM = false;
    float* C;
    __device__ __forceinline__ void operator()(ACC_T, const Unit& u, int wr, int wc, int fr, int fq) const {
        const int row0 = u.pm * BM + wr * 64 + fr, col0 = u.pn * BM + wc * 32 + 4 * fq;
#pragma unroll
        for (int ai = 0; ai < 2; ++ai)
#pragma unroll
            for (int m = 0; m < 4; ++m) { float* rowp = C + (size_t)(row0 + ai * HALF + m * 16) * D + col0;
#pragma unroll
                for (int bj = 0; bj < 2; ++bj)
#pragma unroll
                    for (int n = 0; n < 2; ++n) *(f32x4*)(rowp + bj * HALF + n * 16) = acc[ai][bj][m][n]; }
        ZERO_ACC();
    }
};

struct PlainOrder {
    const char* A; const char* B; int nM, nN, G, c; size_t tstep;
    __device__ __forceinline__ bool next(int i, Unit& u) const {
        const int L = i * G + c; if (L >= nM * nN) return false;
        tile_of(L, nM, nN, u.pm, u.pn); u.sub = 0; u.aux = 0; u.a = A + (size_t)u.pm * tstep; u.b = B + (size_t)u.pn * tstep; return true;
    }
};
struct InprojOrder {
    const char* A; const char* B; int nM1, nctx, G, c; size_t tstep;
    __device__ __forceinline__ bool next(int i, Unit& u) const {
        const int L = i * G + c, n1 = nM1 * 55; u.sub = 0; u.aux = 0;
        if (L < n1) tile_of(L, nM1, 55, u.pm, u.pn);
        else { const int r = L - n1; if (r >= nctx * 17) return false; const int j = r % 17; u.pm = 32 + r / 17;
            u.pn = j < 8 ? 4 + j : (j < 10 ? 14 + (j - 8) : (j < 14 ? 16 + (j - 10) : (j < 16 ? 28 + (j - 14) : 54))); }
        u.a = A + (size_t)u.pm * tstep; u.b = B + (size_t)u.pn * tstep; return true;
    }
};
struct MergeOrder {
    const char* A0; size_t sA; const char* B0; size_t sB; int nM, G, c;
    __device__ __forceinline__ bool next(int i, Unit& u) const {
        const int T = (i / 3) * G + c; if (T >= nM * 8) return false;
        tile_of(T, nM, 8, u.pm, u.pn); u.sub = i % 3; u.aux = 0;
        const size_t ts = (size_t)256 * 1024 * 2;
        u.a = A0 + (size_t)u.sub * sA + (size_t)u.pm * ts; u.b = B0 + (size_t)u.sub * sB + (size_t)u.pn * ts; return true;
    }
};
struct MoeOrder {
    const char* A; const char* B; int nN, G, c; size_t tstep, estride; const unsigned* cnt;
    __device__ __forceinline__ bool next(int i, Unit& u) const {
        int e = 0, acc = 0, nblk = 0; const int L = i * G + c; u.pn = L % nN; u.pm = L / nN; u.sub = 0;
#pragma unroll
        for (int j = 0; j < 8; ++j) { const int cj = (int)__hip_atomic_load(cnt + j, __ATOMIC_RELAXED, __HIP_MEMORY_SCOPE_AGENT); acc += (cj + 255) / 256; if (j < 7) e += (u.pm >= acc) ? 1 : 0; }
        nblk = acc < 72 ? acc : 72;
        if (L >= nblk * nN) return false;
        u.aux = e; u.a = A + (size_t)u.pm * tstep; u.b = B + (size_t)e * estride + (size_t)u.pn * tstep; return true;
    }
};
template <class Order>
__device__ __forceinline__ int fill_table(const Order& O, LAS UnitRec* tab, LAS int* ncell) {
    __syncthreads();
    int ti = threadIdx.x; asm volatile("" : "+v"(ti));
    if (ti < 64) {
        Unit u; const bool ok = O.next(ti, u);
        if (ok) { UnitRec r; r.a_lo = (unsigned)(unsigned long long)u.a; r.a_hi = (unsigned)((unsigned long long)u.a >> 32); r.b_lo = (unsigned)(unsigned long long)u.b; r.b_hi = (unsigned)((unsigned long long)u.b >> 32);
            r.pm = u.pm; r.pn = u.pn; r.sub = u.sub; r.aux = u.aux; LAS unsigned* t = (LAS unsigned*)(tab + ti);
            t[0] = r.a_lo; t[1] = r.a_hi; t[2] = r.b_lo; t[3] = r.b_hi; t[4] = (unsigned)r.pm; t[5] = (unsigned)r.pn; t[6] = (unsigned)r.sub; t[7] = (unsigned)r.aux; }
        const unsigned long long m = __ballot(ok);
        if (ti == 0) *ncell = __popcll(m);
    }
    __syncthreads();
    return __builtin_amdgcn_readfirstlane(*ncell);
}
}

constexpr size_t MiB = 1u << 20;
constexpr size_t al(size_t x) { return (x + 4095) & ~(size_t)4095; }
constexpr size_t WS_CTL = 0, CTL_BYTES = 1 * MiB;
constexpr size_t WS_MODP = WS_CTL + CTL_BYTES;
constexpr size_t WS_MOD = WS_MODP + al((size_t)16 * 2 * 5 * MOD_W * 4);
constexpr size_t WS_XR = WS_MOD + al((size_t)2 * 5 * MOD_W * 4);
constexpr size_t WS_H = WS_XR + al((size_t)NR * D * 4);
constexpr size_t WS_HS = WS_H + al((size_t)NR * D * 2);
constexpr size_t WS_P = WS_HS + al((size_t)NSLOT * D * 2);
constexpr size_t WS_ABF = WS_P + al((size_t)NR * PW * 2);
constexpr size_t WS_LG = WS_ABF + al((size_t)NR * 32 * 4);
constexpr size_t WS_OG = WS_LG + al((size_t)2 * NR * 512 * 4);
constexpr size_t WS_AO = WS_OG + al((size_t)2 * NR * 1024 * 4);
constexpr size_t WS_BO = WS_AO + al((size_t)NR * 1024 * 2);
constexpr size_t WS_CO = WS_BO + al((size_t)NR * 1024 * 2);
constexpr size_t WS_MG = WS_CO + al((size_t)NR * 1024 * 2);
constexpr size_t WS_ACT = WS_MG + al((size_t)NR * D * 2);
constexpr size_t WS_RT = WS_ACT + al((size_t)NSLOT * DFF * 2);
constexpr size_t WS_WIN = WS_RT + al((size_t)NL * 2 * 4 * 3);
constexpr size_t WS_WP = WS_WIN + al((size_t)2 * NIN * D * 2);
constexpr size_t WS_WOUT = WS_WP + al((size_t)2 * 3 * D * 1024 * 2);
constexpr size_t WS_DGU = WS_WOUT + al((size_t)2 * D * D * 2);
constexpr size_t WS_DDN = WS_DGU + al((size_t)2 * DFF * D * 2);
constexpr size_t WS_MGU = WS_DDN + al((size_t)D * DFF * 2);
constexpr size_t WS_MDN = WS_MGU + al((size_t)NE * 2 * DFF * D * 2);
constexpr size_t WS_END = WS_MDN + al((size_t)NE * D * DFF * 2);
static_assert((size_t)NSLOT * D * 4 <= (size_t)NR * PW * 2, "Y2 fits in P");
constexpr int CW_BAR = 4096;
constexpr int CW_CNT = 16384;

constexpr int RING_BYTES = 131072, MISC_OFF = RING_BYTES + 320, UTAB_OFF = MISC_OFF + 128, LDS_BYTES = 147456;

struct Params { const float* in[28]; float* out; unsigned char* ws; int ph_lo, ph_hi; };

struct Ctx { LAS unsigned char* lds; int tid, lane, wave, bid, nb; };

__device__ __forceinline__ void ph_mod_partial(const Ctx& F, const float* c, const float* cctx, const float* w_ada, float* MODP) {
    LAS float* ca = (LAS float*)F.lds;
    for (int i = F.tid; i < 5 * D; i += NTHR) { const int r = i / D, k = i % D; const float v = r < 4 ? c[r * D + k] : cctx[k]; ca[i] = siluf_(v); }
    __syncthreads();
    for (int u = F.bid; u < 2 * 24 * 16; u += F.nb) {
        const int kc = u % 16, cb = (u / 16) % 24, layer = u / (16 * 24);
        const int j = cb * 512 + F.tid;
        const float* w = w_ada + ((size_t)layer * D + kc * 128) * MOD_W + j;
        float acc[5] = {0.f, 0.f, 0.f, 0.f, 0.f};
#pragma unroll 8
        for (int k = 0; k < 128; ++k) { const float wv = w[(size_t)k * MOD_W];
#pragma unroll
            for (int r = 0; r < 5; ++r) acc[r] += ca[r * D + kc * 128 + k] * wv; }
#pragma unroll
        for (int r = 0; r < 5; ++r) MODP[(((size_t)kc * 2 + layer) * 5 + r) * MOD_W + j] = acc[r];
    }
    __syncthreads();
}
__device__ __forceinline__ void ph_copy_x(const Ctx& F, const float* x, const float* ctx, float* XR) {
    const size_t n4l = (size_t)NL * D / 4, n4 = (size_t)NR * D / 4;
    for (size_t i = (size_t)F.bid * NTHR + F.tid; i < n4; i += (size_t)F.nb * NTHR)
        ((f32x4*)XR)[i] = i < n4l ? ((const f32x4*)x)[i] : ((const f32x4*)ctx)[i - n4l];
}
__device__ __forceinline__ void ph_mod_reduce(const Ctx& F, const float* MODP, const float* b_ada, float* MOD) {
    for (int i = F.bid * NTHR + F.tid; i < 2 * 5 * MOD_W; i += F.nb * NTHR) {
        const int j = i % MOD_W, layer = i / (5 * MOD_W);
        float s = b_ada[layer * MOD_W + j];
        for (int kc = 0; kc < 16; ++kc) s += MODP[(size_t)kc * 2 * 5 * MOD_W + i];
        MOD[i] = s;
    }
}
struct CvtJob { const float* src; bf16_t* dst; int K, Nsrc, nblk  , map  ; const float* src2; };
__device__ __forceinline__ void cvt_item(const CvtJob& J, int kb, int nbp, int tid) {
    const float* src = J.src; int c0 = nbp * 128, valid = 128;
    if (J.map == 1) { if (nbp < 48) c0 = nbp * 128; else if (nbp < 108) c0 = nbp * 128 + 32; else if (nbp == 108) { c0 = S_AF; valid = 32; } else { c0 = 0; valid = 0; } }
    else if (J.map == 2) { const int tile = nbp >> 1; c0 = tile * 128; if (nbp & 1) src = J.src2; }
    const int n4 = (tid & 31) * 4, k0 = kb * 128 + (tid >> 5) * 8;
    f32x4 v[8];
    if (n4 < valid) {
#pragma unroll
        for (int j = 0; j < 8; ++j) v[j] = *(const f32x4*)(src + (size_t)(k0 + j) * J.Nsrc + c0 + n4);
    } else {
#pragma unroll
        for (int j = 0; j < 8; ++j) v[j] = (f32x4){0.f, 0.f, 0.f, 0.f};
    }
#pragma unroll
    for (int i = 0; i < 4; ++i) {
        u32x4 w; w.x = pk2(v[0][i], v[1][i]); w.y = pk2(v[2][i], v[3][i]); w.z = pk2(v[4][i], v[5][i]); w.w = pk2(v[6][i], v[7][i]);
        *(u32x4*)(J.dst + (size_t)(nbp * 128 + n4 + i) * J.K + k0) = w;
    }
}
__device__ __forceinline__ void ph_convert(const Ctx& F, const Params& p) {
    unsigned char* ws = (unsigned char*)(GAS unsigned char*)p.ws;
    int base = 0;
#define CVT_RUN(SRC, SRC2, DST, KK, NSRC, NBLK, MAP) do { CvtJob J{SRC, DST, KK, NSRC, NBLK, MAP, SRC2}; const int nk = (KK) / 128, nit = nk * (NBLK); \
        int it = (F.bid - base % F.nb + F.nb) % F.nb; for (; it < nit; it += F.nb) cvt_item(J, it % nk, it / nk, F.tid); base += nit; } while (0)
    for (int l = 0; l < 2; ++l) {
        CVT_RUN(((const float*)(const GAS float*)p.in[8]) + (size_t)l * D * DIN, nullptr, (bf16_t*)(ws + WS_WIN) + (size_t)l * NIN * D, D, DIN, NIN / 128, 1);
        CVT_RUN(((const float*)(const GAS float*)p.in[15]) + (size_t)l * 1024 * D, nullptr, (bf16_t*)(ws + WS_WP) + (size_t)(l * 3 + 0) * D * 1024, 1024, D, D / 128, 0);
        CVT_RUN(((const float*)(const GAS float*)p.in[16]) + (size_t)l * 1024 * D, nullptr, (bf16_t*)(ws + WS_WP) + (size_t)(l * 3 + 1) * D * 1024, 1024, D, D / 128, 0);
        CVT_RUN(((const float*)(const GAS float*)p.in[17]) + (size_t)l * 1024 * D, nullptr, (bf16_t*)(ws + WS_WP) + (size_t)(l * 3 + 2) * D * 1024, 1024, D, D / 128, 0);
        CVT_RUN(((const float*)(const GAS float*)p.in[18]) + (size_t)l * D * D, nullptr, (bf16_t*)(ws + WS_WOUT) + (size_t)l * D * D, D, D, D / 128, 0);
    }
    CVT_RUN(((const float*)(const GAS float*)p.in[19]), ((const float*)(const GAS float*)p.in[20]), (bf16_t*)(ws + WS_DGU), D, DFF, 2 * DFF / 128, 2);
    CVT_RUN(((const float*)(const GAS float*)p.in[21]), nullptr, (bf16_t*)(ws + WS_DDN), DFF, D, D / 128, 0);
    for (int e = 0; e < NE; ++e) {
        CVT_RUN(((const float*)(const GAS float*)p.in[24]) + (size_t)e * D * DFF, ((const float*)(const GAS float*)p.in[25]) + (size_t)e * D * DFF, (bf16_t*)(ws + WS_MGU) + (size_t)e * 2 * DFF * D, D, DFF, 2 * DFF / 128, 2);
        CVT_RUN(((const float*)(const GAS float*)p.in[26]) + (size_t)e * DFF * D, nullptr, (bf16_t*)(ws + WS_MDN) + (size_t)e * D * DFF, DFF, D, D / 128, 0);
    }
#undef CVT_RUN
}
template <bool ROUTER>
__device__ __forceinline__ void ph_norm(const Ctx& F, const float* X, const float* g, const float* modl, int sh_off, int sc_off, bf16_t* H, int rows,
                                        const float* rw, const float* rb, int* tok_e, float* tok_w) {
    for (int row = F.bid * NWAVES + F.wave; row < rows; row += F.nb * NWAVES) {
        const f32x4* xr = (const f32x4*)(X + (size_t)row * D) + F.lane;
        f32x4 v[8]; float ss = 0.f;
#pragma unroll
        for (int j = 0; j < 8; ++j) { v[j] = xr[64 * j]; ss += v[j][0] * v[j][0] + v[j][1] * v[j][1] + v[j][2] * v[j][2] + v[j][3] * v[j][3]; }
        ss = wave_sum(ss);
        const float rs = rsqrtf(ss * (1.f / D) + EPS);
        const float* mb = modl + (size_t)batch_of(row) * MOD_W;
        float lg[8];
        if (ROUTER) {
#pragma unroll
            for (int e = 0; e < 8; ++e) lg[e] = 0.f; }
#pragma unroll
        for (int j = 0; j < 8; ++j) { const int c = 4 * F.lane + 256 * j;
            const f32x4 gg = *(const f32x4*)(g + c), sc = *(const f32x4*)(mb + sc_off + c), sh = *(const f32x4*)(mb + sh_off + c);
            f32x4 y;
#pragma unroll
            for (int i = 0; i < 4; ++i) y[i] = v[j][i] * rs * gg[i] * (1.f + sc[i]) + sh[i];
            u32x2 w; w.x = pk2(y[0], y[1]); w.y = pk2(y[2], y[3]);
            *(u32x2*)(H + (size_t)row * D + c) = w;
            if (ROUTER) {
#pragma unroll
                for (int i = 0; i < 4; ++i) { const f32x4 w0 = *(const f32x4*)(rw + (size_t)(c + i) * 8), w1 = *(const f32x4*)(rw + (size_t)(c + i) * 8 + 4);
#pragma unroll
                    for (int e = 0; e < 4; ++e) { lg[e] += y[i] * w0[e]; lg[4 + e] += y[i] * w1[e]; } } }
        }
        if (ROUTER) {
#pragma unroll
            for (int e = 0; e < 8; ++e) lg[e] = wave_sum(lg[e]) + rb[e];
            if (F.lane == 0) {
                int i0 = 0;
#pragma unroll
                for (int e = 1; e < 8; ++e) if (lg[e] > lg[i0]) i0 = e;
                int i1 = -1;
#pragma unroll
                for (int e = 0; e < 8; ++e) if (e != i0 && (i1 < 0 || lg[e] > lg[i1])) i1 = e;
                const float e1 = expf(lg[i1] - lg[i0]); const float w0 = 1.f / (1.f + e1);
                tok_e[row * 2] = i0; tok_e[row * 2 + 1] = i1; tok_w[row * 2] = w0; tok_w[row * 2 + 1] = e1 * w0;
            } }
    }
}
__device__ __forceinline__ void ph_prep(const Ctx& F, bf16_t* P, const float* ABF, const float* qn_g, const float* kn_g, const float* w_a2, const float* b_a, float* LG) {
    for (int w = F.bid * NWAVES + F.wave; w < NR * 10; w += F.nb * NWAVES) {
        const int r = w / 10, hh = w % 10;
        bf16_t* src = P + (size_t)r * PW + (hh < 8 ? O_GQQ + hh * 128 : O_GQK + (hh - 8) * 128);
        const float* g = hh < 8 ? qn_g : kn_g;
        const unsigned pr = *(const unsigned*)(src + 2 * F.lane);
        float x1 = __uint_as_float(pr << 16), x2 = __uint_as_float(pr & 0xffff0000u);
        const float ss = wave_sum(x1 * x1 + x2 * x2);
        const float rs = rsqrtf(ss * (1.f / 128.f) + EPS);
        x1 = x1 * rs * g[2 * F.lane]; x2 = x2 * rs * g[2 * F.lane + 1];
        if (r < NL) {
            const int t = r & (S - 1); const int row = t / GW, col = t % GW;
            const int j = F.lane & 31; const float pos = F.lane < 32 ? (float)row : (float)col;
            const float freq = powf(10000.f, -(float)(2 * j) / 64.f);
            const float ang = pos * freq; const float cs = cosf(ang), sn = sinf(ang);
            const float o1 = x1 * cs - x2 * sn, o2 = x1 * sn + x2 * cs; x1 = o1; x2 = o2;
        }
        *(unsigned*)(src + 2 * F.lane) = pk2(x1, x2);
    }
    for (size_t i = (size_t)F.bid * NTHR + F.tid; i < (size_t)2 * NR * 512; i += (size_t)F.nb * NTHR) {
        const int c = (int)(i % 512); const int r = (int)((i / 512) % NR); const int dir = (int)(i / ((size_t)512 * NR));
        const float* a = ABF + (size_t)r * 32 + dir * 16;
        float z = b_a[dir * 512 + c];
#pragma unroll
        for (int j = 0; j < 16; ++j) z += a[j] * w_a2[(dir * 16 + j) * 512 + c];
        const float ls = fminf(z, 0.f) - log1pf(expf(-fabsf(z)));
        LG[i] = ls * (1.f / 16.f);
    }
}
__device__ __forceinline__ void ph_attn_naive(const Ctx& F, const bf16_t* P, const float* rpb, const float* LG, bf16_t* AO, bf16_t* CO, float* OG, int MR) {
    {
        LAS float* qs = (LAS float*)F.lds + F.wave * 64;
        LAS float* ps = (LAS float*)F.lds + 8 * 64 + F.wave * 384;
        for (int w = F.bid * NWAVES + F.wave; w < MR * 16; w += F.nb * NWAVES) {
            const int r = w / 16, h = w % 16;
            const bool lat = r < NL; const int b = lat ? (r >> 11) : ((r - NL) >> 8);
            qs[F.lane] = bf2f(P[(size_t)r * PW + O_NAQ + h * 64 + F.lane]) * 0.125f;
            __builtin_amdgcn_s_waitcnt(0); __builtin_amdgcn_wave_barrier();
            const int nk = lat ? 384 : 256;
            int qrow = 0, qcol = 0, r0 = 0, c0 = 0;
            if (lat) { const int t = r & (S - 1); qrow = t / GW; qcol = t % GW; r0 = min(max(qrow - 4, 0), 24); c0 = min(max(qcol - 8, 0), 48); }
            float mx = -INFINITY;
            for (int kk = F.lane; kk < nk; kk += 64) {
                int kr; float bias = 0.f;
                if (lat && kk < 128) { const int wr_ = kk >> 4, wc_ = kk & 15; const int krow = r0 + wr_, kcol = c0 + wc_; kr = b * S + krow * GW + kcol;
                    const int dr = krow - qrow + 7; const int dc = min(max(kcol - qcol + 15, 0), 30); bias = rpb[(h * 15 + dr) * 31 + dc]; }
                else { const int l = lat ? kk - 128 : kk; kr = NL + b * LC + l; }
                const bf16_t* kp = P + (size_t)kr * PW + O_NAK + h * 64;
                float s = 0.f;
                for (int d = 0; d < 64; d += 8) { const u32x4 kv = *(const u32x4*)(kp + d);
                    s += qs[d] * __uint_as_float(kv.x << 16) + qs[d + 1] * __uint_as_float(kv.x & 0xffff0000u) + qs[d + 2] * __uint_as_float(kv.y << 16) + qs[d + 3] * __uint_as_float(kv.y & 0xffff0000u)
                       + qs[d + 4] * __uint_as_float(kv.z << 16) + qs[d + 5] * __uint_as_float(kv.z & 0xffff0000u) + qs[d + 6] * __uint_as_float(kv.w << 16) + qs[d + 7] * __uint_as_float(kv.w & 0xffff0000u); }
                s += bias; ps[kk] = s; mx = fmaxf(mx, s);
            }
            mx = wave_max(mx);
            float sum = 0.f;
            for (int kk = F.lane; kk < nk; kk += 64) { const float e = expf(ps[kk] - mx); ps[kk] = e; sum += e; }
            sum = wave_sum(sum);
            __builtin_amdgcn_s_waitcnt(0); __builtin_amdgcn_wave_barrier();
            float o = 0.f;
            for (int kk = 0; kk < nk; ++kk) {
                int kr;
                if (lat && kk < 128) { const int wr_ = kk >> 4, wc_ = kk & 15; kr = b * S + (r0 + wr_) * GW + (c0 + wc_); }
                else { const int l = lat ? kk - 128 : kk; kr = NL + b * LC + l; }
                o += ps[kk] * bf2f(P[(size_t)kr * PW + O_NAV + h * 64 + F.lane]);
            }
            AO[(size_t)r * 1024 + h * 64 + F.lane] = (bf16_t)f2bf(o / sum);
            __builtin_amdgcn_s_waitcnt(0); __builtin_amdgcn_wave_barrier();
        }
    }
    __syncthreads();
    {
        LAS float* qs = (LAS float*)F.lds + F.wave * 128;
        LAS float* ps = (LAS float*)F.lds + 8 * 128 + F.wave * 2304;
        for (int w = F.bid * NWAVES + F.wave; w < MR * 8; w += F.nb * NWAVES) {
            const int r = w / 8, hq = w % 8, kvh = hq >> 2;
            const bool lat = r < NL; const int b = lat ? (r >> 11) : ((r - NL) >> 8);
            const int nk = lat ? (S + LC) : LC;
            qs[F.lane] = bf2f(P[(size_t)r * PW + O_GQQ + hq * 128 + F.lane]); qs[F.lane + 64] = bf2f(P[(size_t)r * PW + O_GQQ + hq * 128 + F.lane + 64]);
            __builtin_amdgcn_s_waitcnt(0); __builtin_amdgcn_wave_barrier();
            const float scale = 0.08838834764831845f;
            float mx = -INFINITY;
            for (int kk = F.lane; kk < nk; kk += 64) {
                int kr; if (lat) kr = kk < S ? b * S + kk : NL + b * LC + (kk - S); else kr = NL + b * LC + kk;
                const bf16_t* kp = P + (size_t)kr * PW + O_GQK + kvh * 128;
                float s = 0.f;
                for (int d = 0; d < 128; d += 8) { const u32x4 kv = *(const u32x4*)(kp + d);
                    s += qs[d] * __uint_as_float(kv.x << 16) + qs[d + 1] * __uint_as_float(kv.x & 0xffff0000u) + qs[d + 2] * __uint_as_float(kv.y << 16) + qs[d + 3] * __uint_as_float(kv.y & 0xffff0000u)
                       + qs[d + 4] * __uint_as_float(kv.z << 16) + qs[d + 5] * __uint_as_float(kv.z & 0xffff0000u) + qs[d + 6] * __uint_as_float(kv.w << 16) + qs[d + 7] * __uint_as_float(kv.w & 0xffff0000u); }
                s *= scale; ps[kk] = s; mx = fmaxf(mx, s);
            }
            mx = wave_max(mx);
            float sum = 0.f;
            for (int kk = F.lane; kk < nk; kk += 64) { const float e = expf(ps[kk] - mx); ps[kk] = e; sum += e; }
            sum = wave_sum(sum);
            __builtin_amdgcn_s_waitcnt(0); __builtin_amdgcn_wave_barrier();
            float o0 = 0.f, o1 = 0.f;
            for (int kk = 0; kk < nk; ++kk) {
                int kr; if (lat) kr = kk < S ? b * S + kk : NL + b * LC + (kk - S); else kr = NL + b * LC + kk;
                const unsigned vv = *(const unsigned*)(P + (size_t)kr * PW + O_GQV + kvh * 128 + 2 * F.lane);
                const float pp = ps[kk];
                o0 += pp * __uint_as_float(vv << 16); o1 += pp * __uint_as_float(vv & 0xffff0000u);
            }
            const float inv = 1.f / sum;
            *(unsigned*)(CO + (size_t)r * 1024 + hq * 128 + 2 * F.lane) = pk2(o0 * inv, o1 * inv);
            __builtin_amdgcn_s_waitcnt(0); __builtin_amdgcn_wave_barrier();
        }
    }
    __syncthreads();
    {
        LAS float* sq = (LAS float*)F.lds; LAS float* sk = sq + 128; LAS float* sg = sk + 128; LAS float* sv = sg + 128; LAS float* red = sv + 64;
        for (int u = F.bid; u < 128; u += F.nb) {
            const int sl = u & 3, h = (u >> 2) & 3, b = (u >> 4) & 3, dir = u >> 6;
            const int dvi = F.tid & 63, kg = F.tid >> 6;
            float st[16];
#pragma unroll
            for (int i = 0; i < 16; ++i) st[i] = 0.f;
            const float qscale = 0.08838834764831845f;
            for (int step = 0; step < LC + S; ++step) {
                int r;
                if (step < LC) r = NL + b * LC + (dir ? (LC - 1 - step) : step);
                else { const int t = step - LC; r = b * S + (dir ? (S - 1 - t) : t); }
                const bf16_t* pr = P + (size_t)r * PW;
                if (F.tid < 128) { sq[F.tid] = bf2f(pr[O_GLQ + h * 128 + F.tid]) * qscale; sk[F.tid] = bf2f(pr[O_GLK + h * 128 + F.tid]); }
                else if (F.tid < 256) { const int d = F.tid - 128; sg[d] = expf(LG[((size_t)dir * NR + r) * 512 + h * 128 + d]); }
                else if (F.tid < 320) { const int d = F.tid - 256; sv[d] = bf2f(pr[O_GLV + h * 256 + sl * 64 + d]); }
                __syncthreads();
                const float v = sv[dvi]; float o = 0.f;
#pragma unroll
                for (int i = 0; i < 16; ++i) { const int d = kg * 16 + i; st[i] = sg[d] * st[i] + sk[d] * v; o += sq[d] * st[i]; }
                red[kg * 64 + dvi] = o;
                __syncthreads();
                if (F.tid < 64) { float s = 0.f;
#pragma unroll
                    for (int j = 0; j < 8; ++j) s += red[j * 64 + F.tid];
                    OG[((size_t)dir * NR + r) * 1024 + h * 256 + sl * 64 + F.tid] = s; }
            }
            __syncthreads();
        }
    }
}
__device__ __forceinline__ void ph_gla_finish(const Ctx& F, const float* OG, const bf16_t* P, const float* ng, bf16_t* BO, int MR) {
    for (int w = F.bid * NWAVES + F.wave; w < MR * 4; w += F.nb * NWAVES) {
        const int r = w >> 2, h = w & 3;
        const int c = h * 256 + 4 * F.lane;
        const f32x4 a = *(const f32x4*)(OG + (size_t)r * 1024 + c), b = *(const f32x4*)(OG + ((size_t)NR + r) * 1024 + c);
        const f32x4 v = a + b;
        const float ss = wave_sum(v[0] * v[0] + v[1] * v[1] + v[2] * v[2] + v[3] * v[3]);
        const float rs = rsqrtf(ss * (1.f / 256.f) + EPS);
        const u32x2 og = *(const u32x2*)(P + (size_t)r * PW + O_GLOG + c);
        const f32x4 gg = *(const f32x4*)(ng + 4 * F.lane);
        const float o0 = v[0] * rs * gg[0] * siluf_(__uint_as_float(og.x << 16)), o1 = v[1] * rs * gg[1] * siluf_(__uint_as_float(og.x & 0xffff0000u));
        const float o2 = v[2] * rs * gg[2] * siluf_(__uint_as_float(og.y << 16)), o3 = v[3] * rs * gg[3] * siluf_(__uint_as_float(og.y & 0xffff0000u));
        u32x2 wv; wv.x = pk2(o0, o1); wv.y = pk2(o2, o3);
        *(u32x2*)(BO + (size_t)r * 1024 + c) = wv;
    }
}
__device__ __forceinline__ void ph_moe_sort(const Ctx& F, const int* tok_e, int* tok_slot, const bf16_t* H, bf16_t* HS, unsigned* cnt_out) {
    if (F.bid >= 32) return;
    LAS int* tot = (LAS int*)F.lds;
    LAS int* pre = tot + 8;
    LAS int* wcnt = pre + 8;
    LAS int* slots = wcnt + 64;
    if (F.tid < 16) tot[F.tid] = 0;
    __syncthreads();
    {
        int ct[8], cp[8];
#pragma unroll
        for (int e = 0; e < 8; ++e) { ct[e] = 0; cp[e] = 0; }
        for (int i = F.tid; i < NL * 2; i += NTHR) { const int e = tok_e[i]; const bool before = i < F.bid * 512;
#pragma unroll
            for (int j = 0; j < 8; ++j) { ct[j] += (e == j); cp[j] += (e == j && before); } }
#pragma unroll
        for (int e = 0; e < 8; ++e) { const int a = (int)wave_sum((float)ct[e]), b = (int)wave_sum((float)cp[e]); if (F.lane == 0) { atomicAdd((int*)&tot[e], a); atomicAdd((int*)&pre[e], b); } }
    }
    __syncthreads();
    int pstart[8]; { int acc = 0;
#pragma unroll
        for (int e = 0; e < 8; ++e) { pstart[e] = acc; acc += (tot[e] + 255) / 256 * 256; } }
    const int ai = F.bid * 512 + F.tid; const int me = tok_e[ai];
    int rank_in_wave = 0;
#pragma unroll
    for (int e = 0; e < 8; ++e) { const unsigned long long m = __ballot(me == e); if (me == e) rank_in_wave = __popcll(m & ((1ull << F.lane) - 1ull)); if (F.lane == 0) wcnt[F.wave * 8 + e] = __popcll(m); }
    __syncthreads();
    int before_w = 0; for (int w = 0; w < F.wave; ++w) before_w += wcnt[w * 8 + me];
    int ps_me = 0, pre_me = pre[me];
#pragma unroll
    for (int e = 0; e < 8; ++e) if (me == e) ps_me = pstart[e];
    const int slot = ps_me + pre_me + before_w + rank_in_wave;
    tok_slot[ai] = slot; slots[F.tid] = slot;
    if (F.bid == 0 && F.tid < 8) cnt_out[F.tid] = (unsigned)tot[F.tid];
    __syncthreads();
    for (int a = F.wave; a < 512; a += NWAVES) { const int t = F.bid * 256 + (a >> 1); const u32x4* s = (const u32x4*)(H + (size_t)t * D); u32x4* d = (u32x4*)(HS + (size_t)slots[a] * D);
#pragma unroll
        for (int j = 0; j < 4; ++j) d[F.lane + 64 * j] = s[F.lane + 64 * j]; }
    if (F.bid < 8) {
        int lo = 0, hi = 0;
#pragma unroll
        for (int e = 0; e < 8; ++e) if (F.bid == e) { lo = pstart[e] + tot[e]; hi = pstart[e] + (tot[e] + 255) / 256 * 256; }
        for (int rr = lo + F.wave; rr < hi; rr += NWAVES) { u32x4* d = (u32x4*)(HS + (size_t)rr * D);
#pragma unroll
            for (int j = 0; j < 4; ++j) d[F.lane + 64 * j] = (u32x4){0u, 0u, 0u, 0u}; } }
}
__device__ __forceinline__ void ph_final(const Ctx& F, const float* XR, const float* Y2, const int* tok_slot, const float* tok_w, const float* modl, const float* fg, float* out) {
    for (int row = F.bid * NWAVES + F.wave; row < NL; row += F.nb * NWAVES) {
        const f32x4* xr = (const f32x4*)(XR + (size_t)row * D) + F.lane;
        const f32x4* y0 = (const f32x4*)(Y2 + (size_t)tok_slot[row * 2] * D) + F.lane; const f32x4* y1 = (const f32x4*)(Y2 + (size_t)tok_slot[row * 2 + 1] * D) + F.lane;
        const float w0 = tok_w[row * 2], w1 = tok_w[row * 2 + 1];
        const float* g2 = modl + (size_t)batch_of(row) * MOD_W + 5 * D;
        f32x4 v[8]; float ss = 0.f;
#pragma unroll
        for (int j = 0; j < 8; ++j) { const f32x4 gg = *(const f32x4*)(g2 + 4 * F.lane + 256 * j); v[j] = xr[64 * j] + gg * (w0 * y0[64 * j] + w1 * y1[64 * j]);
            ss += v[j][0] * v[j][0] + v[j][1] * v[j][1] + v[j][2] * v[j][2] + v[j][3] * v[j][3]; }
        ss = wave_sum(ss);
        const float rs = rsqrtf(ss * (1.f / D) + EPS);
#pragma unroll
        for (int j = 0; j < 8; ++j) { const f32x4 gg = *(const f32x4*)(fg + 4 * F.lane + 256 * j); ((f32x4*)(out + (size_t)row * D))[F.lane + 64 * j] = v[j] * rs * gg; }
    }
}

constexpr int PH_PER_LAYER = 11, PH_FINAL = 2 + 2 * PH_PER_LAYER, N_PHASES = PH_FINAL + 1;
__global__ void __launch_bounds__(NTHR, 2) mega(Params p) {
    extern __shared__ __attribute__((aligned(16))) unsigned char lds_raw[];
    LAS unsigned char* lds = (LAS unsigned char*)lds_raw;
    volatile LAS unsigned* MISC = (volatile LAS unsigned*)(lds + MISC_OFF);
    Ctx F; F.lds = lds; F.tid = threadIdx.x; F.lane = F.tid & 63; F.wave = __builtin_amdgcn_readfirstlane(F.tid >> 6); F.bid = blockIdx.x; F.nb = gridDim.x;
#define FRESH() do { int t_ = threadIdx.x; asm volatile("" : "+v"(t_)); F.tid = t_; F.lane = t_ & 63; F.wave = __builtin_amdgcn_readfirstlane(t_ >> 6); \
        int b_ = blockIdx.x; asm volatile("" : "+s"(b_)); F.bid = b_; unsigned long long w_ = (unsigned long long)ws; asm volatile("" : "+s"(w_)); ws = (unsigned char*)(GAS unsigned char*)w_; } while (0)
    unsigned char* ws = (unsigned char*)(GAS unsigned char*)p.ws;
    for (int u = F.tid; u < (LDS_BYTES - RING_BYTES) / 4; u += NTHR) ((LAS unsigned*)(lds + RING_BYTES))[u] = 0u;
    __syncthreads();
    XcdBarrier bar; bar.bar = (unsigned*)(ws + WS_CTL) + CW_BAR; bar.x = 0; bar.st = nullptr;
    if (!MK_SPLIT) bar = xcd_barrier_post((unsigned*)(ws + WS_CTL) + CW_BAR, MISC + 8);
    const int lo = p.ph_lo, hi = p.ph_hi;
#define GIN(k) ((const float*)(const GAS float*)p.in[k])
    LAS pg8::UnitRec* UTAB = (LAS pg8::UnitRec*)(lds + UTAB_OFF); LAS int* NCELL = (LAS int*)(lds + MISC_OFF + 64);
#ifndef PH_MASK
#define PH_MASK 0xffffffffu
#endif
#define IN(k) (((PH_MASK >> (((k) - 2) % PH_PER_LAYER + 2 < 2 ? (k) : (((k) < 2) ? (k) : (((k) == PH_FINAL) ? 13 : ((k) - 2) % PH_PER_LAYER + 2)))) & 1u) && lo <= (k) && (k) < hi)
#define SEAM(k) do { if (IN(k) && IN((k) + 1)) xcd_barrier(bar); FRESH(); } while (0)
#define MODP ((float*)(ws + WS_MODP))
#define MOD ((float*)(ws + WS_MOD))
#define XR ((float*)(ws + WS_XR))
#define H ((bf16_t*)(ws + WS_H))
#define HS ((bf16_t*)(ws + WS_HS))
#define P ((bf16_t*)(ws + WS_P))
#define Y2 ((float*)(ws + WS_P))
#define ABF ((float*)(ws + WS_ABF))
#define LG ((float*)(ws + WS_LG))
#define OG ((float*)(ws + WS_OG))
#define AO ((bf16_t*)(ws + WS_AO))
#define BO ((bf16_t*)(ws + WS_BO))
#define CO ((bf16_t*)(ws + WS_CO))
#define MG ((bf16_t*)(ws + WS_MG))
#define ACT ((bf16_t*)(ws + WS_ACT))
#define tok_e ((int*)(ws + WS_RT))
#define tok_w ((float*)(ws + WS_RT + (size_t)NL * 2 * 4))
#define tok_slot ((int*)(ws + WS_RT + (size_t)NL * 2 * 8))
#define ctl ((unsigned*)(ws + WS_CTL))

    if (IN(0)) { ph_mod_partial(F, GIN(1), GIN(3), GIN(4), MODP); ph_copy_x(F, GIN(0), GIN(2), XR); }
    SEAM(0);
    if (IN(1)) { ph_mod_reduce(F, MODP, GIN(5), MOD); ph_convert(F, p); }
    SEAM(1);
    for (int layer = 0; layer < 2; ++layer) {
        const int pb = 2 + layer * PH_PER_LAYER;
        const bool last = layer == 1;
        const float* modl = MOD + (size_t)layer * 5 * MOD_W;
        const int MR = last ? NL : NR;
        if (IN(pb + 0)) ph_norm<false>(F, XR, GIN(6) + layer * D, modl, 0, D, H, NR, nullptr, nullptr, nullptr, nullptr);
        SEAM(pb + 0);
        if (IN(pb + 1)) {
            pg8::InprojOrder So{(const char*)H, (const char*)((bf16_t*)(ws + WS_WIN) + (size_t)layer * NIN * D), last ? 32 : 36, last ? 4 : 0, F.nb, F.bid, (size_t)256 * D * 2};
            pg8::EpiInproj E{P, ABF};
            { const int nu = pg8::fill_table(So, UTAB, NCELL); const pg8::TableOrder T{UTAB, nu}; pg8::gemm_phase(lds, D, T, E); }
        }
        SEAM(pb + 1);
        if (IN(pb + 2)) ph_prep(F, P, ABF, GIN(13) + layer * 128, GIN(14) + layer * 128, GIN(10) + (size_t)layer * 2 * 16 * 512, GIN(11) + layer * 2 * 512, LG);
        SEAM(pb + 2);
        if (IN(pb + 3)) ph_attn_naive(F, P, GIN(9) + (size_t)layer * 16 * 15 * 31, LG, AO, CO, OG, MR);
        SEAM(pb + 3);
        if (IN(pb + 4)) ph_gla_finish(F, OG, P, GIN(12) + layer * 256, BO, MR);
        SEAM(pb + 4);
        if (IN(pb + 5)) {
            const bf16_t* wp = (const bf16_t*)(ws + WS_WP) + (size_t)layer * 3 * D * 1024;
            pg8::MergeOrder So{(const char*)AO, (size_t)(WS_BO - WS_AO), (const char*)wp, (size_t)D * 1024 * 2, MR / 256, F.nb, F.bid};
            static_assert(WS_CO - WS_BO == WS_BO - WS_AO, "branch outputs equally spaced");
            pg8::EpiMerge E{P, MG};
            { const int nu = pg8::fill_table(So, UTAB, NCELL); const pg8::TableOrder T{UTAB, nu}; pg8::gemm_phase(lds, 1024, T, E); }
        }
        SEAM(pb + 5);
        if (IN(pb + 6)) {
            pg8::PlainOrder So{(const char*)MG, (const char*)((bf16_t*)(ws + WS_WOUT) + (size_t)layer * D * D), MR / 256, 8, F.nb, F.bid, (size_t)256 * D * 2};
            pg8::EpiResid E{XR, modl, 2 * D};
            { const int nu = pg8::fill_table(So, UTAB, NCELL); const pg8::TableOrder T{UTAB, nu}; pg8::gemm_phase(lds, D, T, E); }
        }
        SEAM(pb + 6);
        if (IN(pb + 7)) {
            if (!last) ph_norm<false>(F, XR, GIN(7) + layer * D, modl, 3 * D, 4 * D, H, MR, nullptr, nullptr, nullptr, nullptr);
            else ph_norm<true>(F, XR, GIN(7) + layer * D, modl, 3 * D, 4 * D, H, MR, GIN(22), GIN(23), tok_e, tok_w);
        }
        SEAM(pb + 7);
        if (IN(pb + 8)) { if (last) ph_moe_sort(F, tok_e, tok_slot, H, HS, ctl + CW_CNT); }
        SEAM(pb + 8);
        if (!last) {
            if (IN(pb + 9)) {
                pg8::PlainOrder So{(const char*)H, (const char*)(ws + WS_DGU), MR / 256, 44, F.nb, F.bid, (size_t)256 * D * 2};
                pg8::EpiSwiglu E{ACT};
                { const int nu = pg8::fill_table(So, UTAB, NCELL); const pg8::TableOrder T{UTAB, nu}; pg8::gemm_phase(lds, D, T, E); }
            }
            SEAM(pb + 9);
            if (IN(pb + 10)) {
                pg8::PlainOrder So{(const char*)ACT, (const char*)(ws + WS_DDN), MR / 256, 8, F.nb, F.bid, (size_t)256 * DFF * 2};
                pg8::EpiResid E{XR, modl, 5 * D};
                { const int nu = pg8::fill_table(So, UTAB, NCELL); const pg8::TableOrder T{UTAB, nu}; pg8::gemm_phase(lds, DFF, T, E); }
            }
            SEAM(pb + 10);
        } else {
            if (IN(pb + 9)) {
                pg8::MoeOrder So{(const char*)HS, (const char*)(ws + WS_MGU), 44, F.nb, F.bid, (size_t)256 * D * 2, (size_t)2 * DFF * D * 2, ctl + CW_CNT};
                pg8::EpiSwiglu E{ACT};
                { const int nu = pg8::fill_table(So, UTAB, NCELL); const pg8::TableOrder T{UTAB, nu}; pg8::gemm_phase(lds, D, T, E); }
            }
            SEAM(pb + 9);
            if (IN(pb + 10)) {
                pg8::MoeOrder So{(const char*)ACT, (const char*)(ws + WS_MDN), 8, F.nb, F.bid, (size_t)256 * DFF * 2, (size_t)D * DFF * 2, ctl + CW_CNT};
                pg8::EpiStoreF32 E{Y2};
                { const int nu = pg8::fill_table(So, UTAB, NCELL); const pg8::TableOrder T{UTAB, nu}; pg8::gemm_phase(lds, DFF, T, E); }
            }
            SEAM(pb + 10);
        }
    }
    if (IN(PH_FINAL)) ph_final(F, XR, Y2, tok_slot, tok_w, MOD + (size_t)5 * MOD_W, GIN(27), (float*)(GAS float*)p.out);
#undef IN
#undef SEAM
#undef MODP
#undef MOD
#undef XR
#undef H
#undef HS
#undef P
#undef Y2
#undef ABF
#undef LG
#undef OG
#undef AO
#undef BO
#undef CO
#undef MG
#undef ACT
#undef tok_e
#undef tok_w
#undef tok_slot
#undef ctl
}

extern "C" void kernel_launch(void* const* d_in, const int* in_sizes, int n_in, void* d_out, int out_size, void* d_ws, size_t ws_size, hipStream_t stream) {
    static int grid = 0;
    if (grid == 0) {
        if (n_in != 28 || ws_size < WS_END) { fprintf(stderr, "kernel_launch: need 28 inputs and %zu bytes of workspace (got %d, %zu)\n", (size_t)WS_END, n_in, ws_size); grid = -1; return; }
        int dev = 0, cus = 0, per_cu = 0;
        if (hipGetDevice(&dev) != hipSuccess || hipDeviceGetAttribute(&cus, hipDeviceAttributeMultiprocessorCount, dev) != hipSuccess) { grid = -1; return; }
        if (hipFuncSetAttribute((const void*)mega, hipFuncAttributeMaxDynamicSharedMemorySize, LDS_BYTES) != hipSuccess) { fprintf(stderr, "kernel_launch: hipFuncSetAttribute failed\n"); grid = -1; return; }
        if (hipOccupancyMaxActiveBlocksPerMultiprocessor(&per_cu, (const void*)mega, NTHR, LDS_BYTES) != hipSuccess || per_cu < 1) { fprintf(stderr, "kernel_launch: occupancy query says %d\n", per_cu); }
        (void)hipGetLastError();
        grid = cus;
    }
    if (grid < 0) return;
    (void)hipMemsetAsync((char*)d_ws + WS_CTL, 0, CTL_BYTES, stream);
    Params p{};
    for (int i = 0; i < 28; ++i) p.in[i] = (const float*)d_in[i];
    p.out = (float*)d_out; p.ws = (unsigned char*)d_ws;
#if MK_SPLIT
    for (int k = 0; k < N_PHASES; ++k) { p.ph_lo = k; p.ph_hi = k + 1; hipLaunchKernelGGL(mega, dim3(grid), dim3(NTHR), LDS_BYTES, stream, p); }
#else
    p.ph_lo = 0; p.ph_hi = N_PHASES;
    hipLaunchKernelGGL(mega, dim3(grid), dim3(NTHR), LDS_BYTES, stream, p);
#endif
}
```

```cpp
#include <hip/hip_runtime.h>
#include <cstdio>
#include <cstdint>

#ifndef MK_SPLIT
#define MK_SPLIT 0
#endif

constexpr int D = 2048, NB = 4, S = 2048, LC = 256, NL = NB * S, NC = NB * LC, NR = NL + NC;
constexpr int DIN = 13856, DFF = 5632, NE = 8, GW = 64;
constexpr int S_AF = 6144;
constexpr int PW = 13824;
constexpr int O_NAQ = 0, O_NAK = 1024, O_NAV = 2048, O_GLQ = 3072, O_GLK = 3584, O_GLV = 4096, O_GLOG = 5120,
              O_GQQ = 6144, O_GQK = 7168, O_GQV = 7424, O_GA = 7680, O_GB = 9728, O_GC = 11776;
constexpr int NIN = 14080;
constexpr int MOD_W = 6 * D;
constexpr int NSLOT = 18432;
constexpr float EPS = 1e-6f;
constexpr int NWAVES = 8, NTHR = 512;

#define GAS __attribute__((address_space(1)))
#define LAS __attribute__((address_space(3)))
typedef unsigned short bf16_t;
typedef short bf16x8 __attribute__((ext_vector_type(8)));
typedef float f32x4 __attribute__((ext_vector_type(4)));
typedef unsigned u32x4 __attribute__((ext_vector_type(4)));
typedef unsigned u32x2 __attribute__((ext_vector_type(2)));

__device__ __forceinline__ int batch_of(int r) { return r < NL ? (r >> 11) : 4; }
__device__ __forceinline__ float bf2f(bf16_t v) { return __uint_as_float((unsigned)v << 16); }
__device__ __forceinline__ unsigned f2bf(float f) { unsigned u = __float_as_uint(f); return (u + 0x7fffu + ((u >> 16) & 1u)) >> 16; }
__device__ __forceinline__ unsigned pk2(float lo, float hi) { return f2bf(lo) | (f2bf(hi) << 16); }
__device__ __forceinline__ unsigned cvt_pk_bf16(float lo, float hi) { unsigned r; asm volatile("v_cvt_pk_bf16_f32 %0, %1, %2" : "=v"(r) : "v"(lo), "v"(hi)); return r; }
__device__ __forceinline__ float sigmoidf_(float x) { return 1.f / (1.f + expf(-x)); }
__device__ __forceinline__ float siluf_(float x) { return x / (1.f + expf(-x)); }
__device__ __forceinline__ float fast_sigmoid(float x) { return __builtin_amdgcn_rcpf(1.f + __builtin_amdgcn_exp2f(-1.4426950408889634f * x)); }
__device__ __forceinline__ float wave_sum(float v) {
#pragma unroll
    for (int o = 1; o < 64; o <<= 1) v += __shfl_xor(v, o);
    return v;
}
__device__ __forceinline__ float wave_max(float v) {
#pragma unroll
    for (int o = 1; o < 64; o <<= 1) v = fmaxf(v, __shfl_xor(v, o));
    return v;
}

#define XB_TMO      128
#define XB_XCNT(j)  (256  + 64 * (j))
#define XB_XSUB(j)  (1280 + 64 * (j))
#define XB_XGEN(j)  (2304 + 64 * (j))
#define XB_TOP      3328
#define XB_TOPGEN   3392
#define XCD_BAR_WORDS 3456
#define XB_SPIN_CAP (1u << 18)
__device__ __forceinline__ unsigned xb_ld(unsigned* p)              { return __hip_atomic_load(p, __ATOMIC_RELAXED, __HIP_MEMORY_SCOPE_AGENT); }
__device__ __forceinline__ unsigned xb_add(unsigned* p, unsigned v) { return __hip_atomic_fetch_add(p, v, __ATOMIC_RELAXED, __HIP_MEMORY_SCOPE_AGENT); }
__device__ __forceinline__ unsigned xb_xcc_id() { return (unsigned)__builtin_amdgcn_s_getreg((3 << 11) | 20) & 0xFu; }
#define XB_SPIN(cond, bar) do { unsigned _sp = 0; while (cond) { __builtin_amdgcn_s_sleep(1); \
    if ((++_sp & 255u) == 0u) { if (xb_ld(&(bar)[XB_TMO])) break; if (_sp > XB_SPIN_CAP) { atomicAdd(&(bar)[XB_TMO], 1u); break; } } } } while (0)
struct XcdBarrier { unsigned* bar; unsigned x; volatile LAS unsigned* st; };
__device__ __forceinline__ XcdBarrier xcd_barrier_post(unsigned* bar, volatile LAS unsigned* st) {
    XcdBarrier b; b.bar = bar; b.x = xb_xcc_id(); b.st = st;
    if (threadIdx.x == 0) (void)xb_add(&bar[XB_XCNT(b.x)], 1u);
    return b;
}
__device__ __forceinline__ void xcd_barrier_complete(unsigned* bar, unsigned x, unsigned& nloc, unsigned& nx) {
    const unsigned G = gridDim.x * gridDim.y * gridDim.z;
    unsigned sum, cnt, mine, sp = 0u;
    asm volatile("" : "+s"(x));
    { unsigned long long bb = (unsigned long long)bar; asm volatile("" : "+s"(bb)); bar = (unsigned*)(GAS unsigned*)bb; }
    for (;;) {
        sum = 0u; cnt = 0u; mine = 0u;
#pragma unroll
        for (unsigned j = 0; j < 16; ++j) { const unsigned c = xb_ld(&bar[XB_XCNT(j)]); sum += c; cnt += (c > 0u) ? 1u : 0u; mine = (j == x) ? c : mine; }
        if (sum == G) break;
        __builtin_amdgcn_s_sleep(1);
        if ((++sp & 255u) == 0u) { if (xb_ld(&bar[XB_TMO])) break; if (sp > XB_SPIN_CAP) { atomicAdd(&bar[XB_TMO], 1u); break; } }
    }
    nloc = mine > 0u ? mine : 1u; nx = cnt > 0u ? cnt : 1u;
}
__device__ __forceinline__ void xcd_barrier(const XcdBarrier& b) {
    asm volatile("s_waitcnt vmcnt(0)" ::: "memory");
    __syncthreads();
    if (threadIdx.x == 0) {
        unsigned* bar = b.bar;
        __builtin_amdgcn_s_waitcnt(0);
        unsigned nloc = b.st[0], nx = b.st[1];
        if (nloc == 0u) { xcd_barrier_complete(bar, b.x, nloc, nx); b.st[0] = nloc; b.st[1] = nx; }
        const unsigned old = xb_add(&bar[XB_XSUB(b.x)], 1u);
        const unsigned gen = old / nloc;
        if (old + 1u == (gen + 1u) * nloc) {
            __builtin_amdgcn_fence(__ATOMIC_RELEASE, "agent");
            asm volatile("s_waitcnt vmcnt(0)" ::: "memory");
            const unsigned og = xb_add(&bar[XB_TOP], 1u);
            const unsigned tg = og / nx;
            if (og + 1u == (tg + 1u) * nx) xb_add(&bar[XB_TOPGEN], 1u);
            else XB_SPIN(xb_ld(&bar[XB_TOPGEN]) == tg, bar);
            __builtin_amdgcn_fence(__ATOMIC_ACQUIRE, "agent");
            xb_add(&bar[XB_XGEN(b.x)], 1u);
            asm volatile("s_waitcnt vmcnt(0)" ::: "memory");
        } else {
            XB_SPIN(xb_ld(&bar[XB_XGEN(b.x)]) == gen, bar);
            __builtin_amdgcn_fence(__ATOMIC_ACQUIRE, "agent");
            asm volatile("s_waitcnt vmcnt(0)" ::: "memory");
        }
    }
    __syncthreads();
}

namespace pg8 {
constexpr int BM = 256, BK = 64, HALF = 128, HTB = HALF * BK * 2, STAGE_BYTES = 8 * HTB, NXCD = 8, WGM = 8;
__host__ __device__ __forceinline__ int lds_byte(int r, int c) { const int st = (r >> 4) * 2 + (c >> 5), rr = r & 15, cc = c & 31, ob = rr * 64 + cc * 2; return st * 1024 + (ob ^ (((ob >> 9) & 1) << 5)); }
__host__ __device__ __forceinline__ void stage_rc(int b, int& R, int& C) { const int st = b / 1024, sb = b % 1024, swz = sb ^ (((sb >> 9) & 1) << 5); R = (st >> 1) * 16 + swz / 64; C = (st & 1) * 32 + (swz % 64) / 2; }
__host__ __device__ __forceinline__ int perm32(int rho) { const int n = rho >> 4, i = rho & 15; return 8 * (i >> 2) + 4 * n + (i & 3); }

struct Unit { const char* a; const char* b; int pm, pn, sub, aux; };

__device__ __forceinline__ void tile_of(int wgid, int nM, int nN, int& pm, int& pn) {
    const int nwg = nM * nN; { const int q = nwg / NXCD, r = nwg % NXCD, xcd = wgid % NXCD, off = wgid / NXCD; wgid = (xcd < r ? xcd * (q + 1) : r * (q + 1) + (xcd - r) * q) + off; }
    const int nig = WGM * nN, gid = wgid / nig, fm = gid * WGM, gsz = (nM - fm) < WGM ? (nM - fm) : WGM;
    pm = fm + ((wgid % nig) % gsz); pn = (wgid % nig) / gsz;
}

struct UnitRec { unsigned a_lo, a_hi, b_lo, b_hi; int pm, pn, sub, aux; };
struct TableOrder {
    const LAS UnitRec* tab; int n;
    __device__ __forceinline__ bool next(int i, Unit& u) const {
        if (i >= n) return false;
        const LAS unsigned* r = (const LAS unsigned*)(tab + i);
        const unsigned alo = __builtin_amdgcn_readfirstlane(r[0]), ahi = __builtin_amdgcn_readfirstlane(r[1]), blo = __builtin_amdgcn_readfirstlane(r[2]), bhi = __builtin_amdgcn_readfirstlane(r[3]);
        u.a = (const char*)(((unsigned long long)ahi << 32) | alo); u.b = (const char*)(((unsigned long long)bhi << 32) | blo);
        u.pm = __builtin_amdgcn_readfirstlane(r[4]); u.pn = __builtin_amdgcn_readfirstlane(r[5]); u.sub = __builtin_amdgcn_readfirstlane(r[6]); u.aux = __builtin_amdgcn_readfirstlane(r[7]);
        return true;
    }
};
template <class Epi, class Sched>
__device__ __forceinline__ void gemm_phase(LAS unsigned char* lds, const int K, const Sched& S, const Epi& E) {
    int tid = threadIdx.x; asm volatile("" : "+v"(tid));
    const int wid = __builtin_amdgcn_readfirstlane(tid >> 6), lane = tid & 63, wr = wid >> 2, wc = wid & 3, fr = lane & 15, fq = lane >> 4;
    const int nt = K / BK;
    unsigned voffA[2], voffB[2];
#pragma unroll
    for (int i = 0; i < 2; ++i) { int R, C; stage_rc(tid * 16 + i * 8192, R, C); const int Rb = Epi::PERM ? ((R & ~31) + perm32(R & 31)) : R;
        voffA[i] = (unsigned)(R * K + C) * 2u; voffB[i] = (unsigned)(Rb * K + C) * 2u; }
    const size_t kstep = (size_t)(BK * 2);
    const size_t hstep = (size_t)HALF * K * 2;
    const unsigned ldsw = (unsigned)wid * 1024u;
    const int aoff = lds_byte(wr * 64 + fr, fq * 8), boff = lds_byte(wc * 32 + fr, fq * 8);
#define PG8_SA(b, h) (((b) * 2 + (h)) * HTB)
#define PG8_SB(b, h) ((4 + (b) * 2 + (h)) * HTB)
#define PG8_STAGE(bufoff, gbase, voff) do { _Pragma("unroll") for (int _i = 0; _i < 2; ++_i) \
        __builtin_amdgcn_global_load_lds((const unsigned*)((const char*)(gbase) + (voff)[_i]), (LAS unsigned*)(lds + (bufoff) + ldsw + _i * 8192), 16, 0, 0); } while (0)
#define PG8_LDA(dst, b, h) do { _Pragma("unroll") for (int m = 0; m < 4; ++m) _Pragma("unroll") for (int k = 0; k < 2; ++k) dst[m][k] = *(const LAS bf16x8*)(lds + PG8_SA(b, h) + aoff + m * 2048 + k * 1024); } while (0)
#define PG8_LDB(dst, b, h) do { _Pragma("unroll") for (int n = 0; n < 2; ++n) _Pragma("unroll") for (int k = 0; k < 2; ++k) dst[n][k] = *(const LAS bf16x8*)(lds + PG8_SB(b, h) + boff + n * 2048 + k * 1024); } while (0)
#define PG8_MMA(ai, bj, At, Bt) do { __builtin_amdgcn_s_setprio(1); _Pragma("unroll") for (int m = 0; m < 4; ++m) _Pragma("unroll") for (int n = 0; n < 2; ++n) _Pragma("unroll") for (int k = 0; k < 2; ++k) \
        acc[ai][bj][m][n] = __builtin_amdgcn_mfma_f32_16x16x32_bf16(Bt[n][k], At[m][k], acc[ai][bj][m][n], 0, 0, 0); __builtin_amdgcn_s_setprio(0); } while (0)
#define PG8_WAIT_V(n) asm volatile("s_waitcnt vmcnt(" #n ")" ::: "memory")
#define PG8_WAIT_L(n) asm volatile("s_waitcnt lgkmcnt(" #n ")" ::: "memory")
#define PG8_BAR __builtin_amdgcn_s_barrier()
#define PG8_SCHED __builtin_amdgcn_sched_barrier(0)
    Unit cur, nxt; int ui = 0;
    if (!S.next(0, cur)) return;
    f32x4 acc[2][2][4][2];
#pragma unroll
    for (int a = 0; a < 2; ++a)
#pragma unroll
        for (int b = 0; b < 2; ++b)
#pragma unroll
            for (int m = 0; m < 4; ++m)
#pragma unroll
                for (int n = 0; n < 2; ++n) acc[a][b][m][n] = (f32x4){0.f, 0.f, 0.f, 0.f};
    bf16x8 At[4][2], B0[2][2], B1[2][2];
    const char* cA = cur.a; const char* cB = cur.b;
    PG8_STAGE(PG8_SB(0, 0), cB, voffB); PG8_STAGE(PG8_SB(0, 1), cB + hstep, voffB); PG8_STAGE(PG8_SA(0, 0), cA, voffA); PG8_STAGE(PG8_SA(0, 1), cA + hstep, voffA);
    if (wr == 1) PG8_BAR;
    PG8_WAIT_V(2); PG8_BAR;
    PG8_STAGE(PG8_SB(1, 0), cB + kstep, voffB); PG8_STAGE(PG8_SA(1, 0), cA + kstep, voffA); PG8_STAGE(PG8_SB(1, 1), cB + hstep + kstep, voffB);
    PG8_WAIT_V(6); PG8_BAR;
    for (;;) {
        const bool has_next = S.next(ui + 1, nxt);
        const char* nA = has_next ? nxt.a : cA; const char* nB = has_next ? nxt.b : cB;
        for (int t = 0; t < nt; t += 2) {
            const bool last = (t == nt - 2);
            const char* a1 = cA + (size_t)(t + 1) * kstep;
            const char* a2 = last ? nA : cA + (size_t)(t + 2) * kstep; const char* b2 = last ? nB : cB + (size_t)(t + 2) * kstep;
            const char* a3 = a2 + kstep; const char* b3 = b2 + kstep;
            PG8_LDB(B0, 0, 0); PG8_LDB(B1, 0, 1); PG8_SCHED; PG8_LDA(At, 0, 0); PG8_STAGE(PG8_SA(1, 1), a1 + hstep, voffA);
            PG8_WAIT_V(8); PG8_WAIT_L(0); PG8_BAR; PG8_MMA(0, 0, At, B0); PG8_MMA(0, 1, At, B1); PG8_BAR; PG8_SCHED;
            PG8_LDA(At, 0, 1); PG8_STAGE(PG8_SB(0, 0), b2, voffB); PG8_STAGE(PG8_SB(0, 1), b2 + hstep, voffB); PG8_STAGE(PG8_SA(0, 0), a2, voffA);
            PG8_WAIT_V(8); PG8_WAIT_L(0); PG8_BAR; PG8_MMA(1, 0, At, B0); PG8_MMA(1, 1, At, B1); PG8_BAR; PG8_SCHED;
            PG8_LDB(B0, 1, 0); PG8_LDB(B1, 1, 1); PG8_SCHED; PG8_LDA(At, 1, 0); PG8_STAGE(PG8_SA(0, 1), a2 + hstep, voffA);
            PG8_WAIT_V(8); PG8_WAIT_L(0); PG8_BAR; PG8_MMA(0, 0, At, B0); PG8_MMA(0, 1, At, B1); PG8_BAR; PG8_SCHED;
            PG8_LDA(At, 1, 1); PG8_STAGE(PG8_SB(1, 0), b3, voffB); PG8_STAGE(PG8_SB(1, 1), b3 + hstep, voffB); PG8_STAGE(PG8_SA(1, 0), a3, voffA);
            PG8_WAIT_V(8); PG8_WAIT_L(0); PG8_BAR; PG8_MMA(1, 0, At, B0); PG8_MMA(1, 1, At, B1); PG8_BAR; PG8_SCHED;
        }
        if (wr == 0) PG8_BAR;
        E(acc, cur, wr, wc, fr, fq);
        if (!has_next) break;
        cur = nxt; cA = nA; cB = nB; ++ui;
        if (wr == 1) PG8_BAR;
    }
    PG8_WAIT_V(0);
    PG8_BAR;
#undef PG8_SA
#undef PG8_SB
#undef PG8_STAGE
#undef PG8_LDA
#undef PG8_LDB
#undef PG8_MMA
#undef PG8_WAIT_V
#undef PG8_WAIT_L
#undef PG8_BAR
#undef PG8_SCHED
}
#define ACC_T f32x4 (&acc)[2][2][4][2]
#define ZERO_ACC() do { _Pragma("unroll") for (int a_ = 0; a_ < 2; ++a_) _Pragma("unroll") for (int b_ = 0; b_ < 2; ++b_) _Pragma("unroll") for (int m_ = 0; m_ < 4; ++m_) \
    _Pragma("unroll") for (int n_ = 0; n_ < 2; ++n_) acc[a_][b_][m_][n_] = (f32x4){0.f, 0.f, 0.f, 0.f}; } while (0)

struct EpiInproj {
    static constexpr bool PERM = true;
    bf16_t* P; float* ABF;
    __device__ __forceinline__ void operator()(ACC_T, const Unit& u, int wr, int wc, int fr, int fq) const {
        const int row0 = u.pm * BM + wr * 64 + fr;
        if (u.pn < 54) {
            const bool gate = u.pn >= 30;
#pragma unroll
            for (int ai = 0; ai < 2; ++ai)
#pragma unroll
                for (int m = 0; m < 4; ++m) { bf16_t* rowp = P + (size_t)(row0 + ai * HALF + m * 16) * PW + u.pn * BM + wc * 32 + 8 * fq;
#pragma unroll
                    for (int bj = 0; bj < 2; ++bj) { f32x4 v0 = acc[ai][bj][m][0], v1 = acc[ai][bj][m][1];
                        if (gate) {
#pragma unroll
                            for (int j = 0; j < 4; ++j) { v0[j] = fast_sigmoid(v0[j]); v1[j] = fast_sigmoid(v1[j]); } }
                        u32x4 w; w.x = cvt_pk_bf16(v0[0], v0[1]); w.y = cvt_pk_bf16(v0[2], v0[3]); w.z = cvt_pk_bf16(v1[0], v1[1]); w.w = cvt_pk_bf16(v1[2], v1[3]);
                        *(u32x4*)(rowp + bj * HALF) = w; } }
        } else if (wc == 0) {
#pragma unroll
            for (int ai = 0; ai < 2; ++ai)
#pragma unroll
                for (int m = 0; m < 4; ++m) { float* rp = ABF + (size_t)(row0 + ai * HALF + m * 16) * 32 + 8 * fq;
                    *(f32x4*)rp = acc[ai][0][m][0]; *(f32x4*)(rp + 4) = acc[ai][0][m][1]; }
        }
        ZERO_ACC();
    }
};
struct EpiMerge {
    static constexpr bool PERM = true;
    const bf16_t* P; bf16_t* MG;
    __device__ __forceinline__ void operator()(ACC_T, const Unit& u, int wr, int wc, int fr, int fq) const {
        const int row0 = u.pm * BM + wr * 64 + fr, col0 = u.pn * BM + wc * 32 + 8 * fq;
        const int gcur = u.sub == 0 ? O_GA : (u.sub == 1 ? O_GB : O_GC), gnext = u.sub == 0 ? O_GB : O_GC;
#pragma unroll
        for (int ai = 0; ai < 2; ++ai)
#pragma unroll
            for (int m = 0; m < 4; ++m) { const size_t r = (size_t)(row0 + ai * HALF + m * 16);
#pragma unroll
                for (int bj = 0; bj < 2; ++bj) {
                    const u32x4 gc = *(const u32x4*)(P + r * PW + gcur + col0 + bj * HALF);
                    float sc[8]; sc[0] = __uint_as_float(gc.x << 16); sc[1] = __uint_as_float(gc.x & 0xffff0000u); sc[2] = __uint_as_float(gc.y << 16); sc[3] = __uint_as_float(gc.y & 0xffff0000u);
                    sc[4] = __uint_as_float(gc.z << 16); sc[5] = __uint_as_float(gc.z & 0xffff0000u); sc[6] = __uint_as_float(gc.w << 16); sc[7] = __uint_as_float(gc.w & 0xffff0000u);
#pragma unroll
                    for (int j = 0; j < 8; ++j) sc[j] = fmaxf(sc[j], 1e-20f);
                    if (u.sub < 2) {
                        const u32x4 gn = *(const u32x4*)(P + r * PW + gnext + col0 + bj * HALF);
                        float sn[8]; sn[0] = __uint_as_float(gn.x << 16); sn[1] = __uint_as_float(gn.x & 0xffff0000u); sn[2] = __uint_as_float(gn.y << 16); sn[3] = __uint_as_float(gn.y & 0xffff0000u);
                        sn[4] = __uint_as_float(gn.z << 16); sn[5] = __uint_as_float(gn.z & 0xffff0000u); sn[6] = __uint_as_float(gn.w << 16); sn[7] = __uint_as_float(gn.w & 0xffff0000u);
#pragma unroll
                        for (int j = 0; j < 8; ++j) { const float f = sc[j] * __builtin_amdgcn_rcpf(fmaxf(sn[j], 1e-20f)); if (j < 4) acc[ai][bj][m][0][j] *= f; else acc[ai][bj][m][1][j - 4] *= f; }
                    } else {
                        f32x4 v0 = acc[ai][bj][m][0], v1 = acc[ai][bj][m][1];
#pragma unroll
                        for (int j = 0; j < 4; ++j) { v0[j] *= sc[j]; v1[j] *= sc[4 + j]; }
                        u32x4 w; w.x = cvt_pk_bf16(v0[0], v0[1]); w.y = cvt_pk_bf16(v0[2], v0[3]); w.z = cvt_pk_bf16(v1[0], v1[1]); w.w = cvt_pk_bf16(v1[2], v1[3]);
                        *(u32x4*)(MG + r * D + col0 + bj * HALF) = w;
                        acc[ai][bj][m][0] = (f32x4){0.f, 0.f, 0.f, 0.f}; acc[ai][bj][m][1] = (f32x4){0.f, 0.f, 0.f, 0.f};
                    } }
                asm volatile("" ::: "memory"); }
    }
};
struct EpiResid {
    static constexpr bool PERM = false;
    float* X; const float* modl; int goff;
    __device__ __forceinline__ void operator()(ACC_T, const Unit& u, int wr, int wc, int fr, int fq) const {
        const int row0 = u.pm * BM + wr * 64 + fr, col0 = u.pn * BM + wc * 32 + 4 * fq;
        const float* g = modl + (size_t)batch_of(u.pm * BM) * MOD_W + goff + col0;
        f32x4 gv[2][2];
#pragma unroll
        for (int bj = 0; bj < 2; ++bj)
#pragma unroll
            for (int n = 0; n < 2; ++n) gv[bj][n] = *(const f32x4*)(g + bj * HALF + n * 16);
#pragma unroll
        for (int ai = 0; ai < 2; ++ai)
#pragma unroll
            for (int m = 0; m < 4; ++m) { float* rowp = X + (size_t)(row0 + ai * HALF + m * 16) * D + col0;
#pragma unroll
                for (int bj = 0; bj < 2; ++bj)
#pragma unroll
                    for (int n = 0; n < 2; ++n) { f32x4* p = (f32x4*)(rowp + bj * HALF + n * 16); *p = *p + gv[bj][n] * acc[ai][bj][m][n]; } }
        ZERO_ACC();
    }
};
struct EpiSwiglu {
    static constexpr bool PERM = true;
    bf16_t* ACT;
    __device__ __forceinline__ void operator()(ACC_T, const Unit& u, int wr, int wc, int fr, int fq) const {
        const int row0 = u.pm * BM + wr * 64 + fr, col0 = u.pn * HALF + wc * 32 + 8 * fq;
#pragma unroll
        for (int ai = 0; ai < 2; ++ai)
#pragma unroll
            for (int m = 0; m < 4; ++m) { f32x4 o[2];
#pragma unroll
                for (int n = 0; n < 2; ++n)
#pragma unroll
                    for (int j = 0; j < 4; ++j) { const float gt = acc[ai][0][m][n][j]; o[n][j] = gt * fast_sigmoid(gt) * acc[ai][1][m][n][j]; }
                u32x4 w; w.x = cvt_pk_bf16(o[0][0], o[0][1]); w.y = cvt_pk_bf16(o[0][2], o[0][3]); w.z = cvt_pk_bf16(o[1][0], o[1][1]); w.w = cvt_pk_bf16(o[1][2], o[1][3]);
                *(u32x4*)(ACT + (size_t)(row0 + ai * HALF + m * 16) * DFF + col0) = w; }
        ZERO_ACC();
    }
};
struct EpiStoreF32 {
    static constexpr bool PERM = false;
    float* C;
    __device__ __forceinline__ void operator()(ACC_T, const Unit& u, int wr, int wc, int fr, int fq) const {
        const int row0 = u.pm * BM + wr * 64 + fr, col0 = u.pn * BM + wc * 32 + 4 * fq;
#pragma unroll
        for (int ai = 0; ai < 2; ++ai)
#pragma unroll
            for (int m = 0; m < 4; ++m) { float* rowp = C + (size_t)(row0 + ai * HALF + m * 16) * D + col0;
#pragma unroll
                for (int bj = 0; bj < 2; ++bj)
#pragma unroll
                    for (int n = 0; n < 2; ++n) *(f32x4*)(rowp + bj * HALF + n * 16) = acc[ai][bj][m][n]; }
        ZERO_ACC();
    }
};

struct PlainOrder {
    const char* A; const char* B; int nM, nN, G, c; size_t tstep;
    __device__ __forceinline__ bool next(int i, Unit& u) const {
        const int L = i * G + c; if (L >= nM * nN) return false;
        tile_of(L, nM, nN, u.pm, u.pn); u.sub = 0; u.aux = 0; u.a = A + (size_t)u.pm * tstep; u.b = B + (size_t)u.pn * tstep; return true;
    }
};
struct InprojOrder {
    const char* A; const char* B; int nM1, nctx, G, c; size_t tstep;
    __device__ __forceinline__ bool next(int i, Unit& u) const {
        const int L = i * G + c, n1 = nM1 * 55; u.sub = 0; u.aux = 0;
        if (L < n1) tile_of(L, nM1, 55, u.pm, u.pn);
        else { const int r = L - n1; if (r >= nctx * 17) return false; const int j = r % 17; u.pm = 32 + r / 17;
            u.pn = j < 8 ? 4 + j : (j < 10 ? 14 + (j - 8) : (j < 14 ? 16 + (j - 10) : (j < 16 ? 28 + (j - 14) : 54))); }
        u.a = A + (size_t)u.pm * tstep; u.b = B + (size_t)u.pn * tstep; return true;
    }
};
struct MergeOrder {
    const char* A0; size_t sA; const char* B0; size_t sB; int nM, G, c;
    __device__ __forceinline__ bool next(int i, Unit& u) const {
        const int T = (i / 3) * G + c; if (T >= nM * 8) return false;
        tile_of(T, nM, 8, u.pm, u.pn); u.sub = i % 3; u.aux = 0;
        const size_t ts = (size_t)256 * 1024 * 2;
        u.a = A0 + (size_t)u.sub * sA + (size_t)u.pm * ts; u.b = B0 + (size_t)u.sub * sB + (size_t)u.pn * ts; return true;
    }
};
struct MoeOrder {
    const char* A; const char* B; int nN, G, c; size_t tstep, estride; const unsigned* cnt;
    __device__ __forceinline__ bool next(int i, Unit& u) const {
        int e = 0, acc = 0, nblk = 0; const int L = i * G + c; u.pn = L % nN; u.pm = L / nN; u.sub = 0;
#pragma unroll
        for (int j = 0; j < 8; ++j) { const int cj = (int)__hip_atomic_load(cnt + j, __ATOMIC_RELAXED, __HIP_MEMORY_SCOPE_AGENT); acc += (cj + 255) / 256; if (j < 7) e += (u.pm >= acc) ? 1 : 0; }
        nblk = acc < 72 ? acc : 72;
        if (L >= nblk * nN) return false;
        u.aux = e; u.a = A + (size_t)u.pm * tstep; u.b = B + (size_t)e * estride + (size_t)u.pn * tstep; return true;
    }
};
template <class Order>
__device__ __forceinline__ int fill_table(const Order& O, LAS UnitRec* tab, LAS int* ncell) {
    __syncthreads();
    int ti = threadIdx.x; asm volatile("" : "+v"(ti));
    if (ti < 64) {
        Unit u; const bool ok = O.next(ti, u);
        if (ok) { UnitRec r; r.a_lo = (unsigned)(unsigned long long)u.a; r.a_hi = (unsigned)((unsigned long long)u.a >> 32); r.b_lo = (unsigned)(unsigned long long)u.b; r.b_hi = (unsigned)((unsigned long long)u.b >> 32);
            r.pm = u.pm; r.pn = u.pn; r.sub = u.sub; r.aux = u.aux; LAS unsigned* t = (LAS unsigned*)(tab + ti);
            t[0] = r.a_lo; t[1] = r.a_hi; t[2] = r.b_lo; t[3] = r.b_hi; t[4] = (unsigned)r.pm; t[5] = (unsigned)r.pn; t[6] = (unsigned)r.sub; t[7] = (unsigned)r.aux; }
        const unsigned long long m = __ballot(ok);
        if (ti == 0) *ncell = __popcll(m);
    }
    __syncthreads();
    return __builtin_amdgcn_readfirstlane(*ncell);
}
}

constexpr size_t MiB = 1u << 20;
constexpr size_t al(size_t x) { return (x + 4095) & ~(size_t)4095; }
constexpr size_t WS_CTL = 0, CTL_BYTES = 1 * MiB;
constexpr size_t WS_MODP = WS_CTL + CTL_BYTES;
constexpr size_t WS_MOD = WS_MODP + al((size_t)16 * 2 * 5 * MOD_W * 4);
constexpr size_t WS_XR = WS_MOD + al((size_t)2 * 5 * MOD_W * 4);
constexpr size_t WS_H = WS_XR + al((size_t)NR * D * 4);
constexpr size_t WS_HS = WS_H + al((size_t)NR * D * 2);
constexpr size_t WS_P = WS_HS + al((size_t)NSLOT * D * 2);
constexpr size_t WS_ABF = WS_P + al((size_t)NR * PW * 2);
constexpr size_t WS_LG = WS_ABF + al((size_t)NR * 32 * 4);
constexpr size_t WS_OG = WS_LG + al((size_t)2 * NR * 512 * 4);
constexpr size_t WS_AO = WS_OG + al((size_t)2 * NR * 1024 * 4);
constexpr size_t WS_BO = WS_AO + al((size_t)NR * 1024 * 2);
constexpr size_t WS_CO = WS_BO + al((size_t)NR * 1024 * 2);
constexpr size_t WS_MG = WS_CO + al((size_t)NR * 1024 * 2);
constexpr size_t WS_ACT = WS_MG + al((size_t)NR * D * 2);
constexpr size_t WS_RT = WS_ACT + al((size_t)NSLOT * DFF * 2);
constexpr size_t WS_WIN = WS_RT + al((size_t)NL * 2 * 4 * 3);
constexpr size_t WS_WP = WS_WIN + al((size_t)2 * NIN * D * 2);
constexpr size_t WS_WOUT = WS_WP + al((size_t)2 * 3 * D * 1024 * 2);
constexpr size_t WS_DGU = WS_WOUT + al((size_t)2 * D * D * 2);
constexpr size_t WS_DDN = WS_DGU + al((size_t)2 * DFF * D * 2);
constexpr size_t WS_MGU = WS_DDN + al((size_t)D * DFF * 2);
constexpr size_t WS_MDN = WS_MGU + al((size_t)NE * 2 * DFF * D * 2);
constexpr size_t WS_VT = WS_MDN + al((size_t)NE * D * DFF * 2);
constexpr size_t WS_QT = WS_VT + al((size_t)NB * 2304 * 2304 * 2);
constexpr size_t WS_KV = WS_QT + al((size_t)2 * NR * 512 * 2);
constexpr size_t WS_DEC = WS_KV + al((size_t)1152 * 256 * 128 * 2);
constexpr size_t WS_END = WS_DEC + al((size_t)1152 * 128 * 4);
static_assert((size_t)NSLOT * D * 4 <= (size_t)NR * PW * 2, "Y2 fits in P");
constexpr int CW_BAR = 4096;
constexpr int CW_CNT = 16384;

constexpr int RING_BYTES = 131072, MISC_OFF = RING_BYTES + 320, UTAB_OFF = MISC_OFF + 128, LDS_BYTES = 147456;

struct Params { const float* in[28]; float* out; unsigned char* ws; int ph_lo, ph_hi; };

struct Ctx { LAS unsigned char* lds; int tid, lane, wave, bid, nb; };

__device__ __forceinline__ void ph_mod_partial(const Ctx& F, const float* c, const float* cctx, const float* w_ada, float* MODP) {
    LAS float* ca = (LAS float*)F.lds;
    for (int i = F.tid; i < 5 * D; i += NTHR) { const int r = i / D, k = i % D; const float v = r < 4 ? c[r * D + k] : cctx[k]; ca[i] = siluf_(v); }
    __syncthreads();
    for (int u = F.bid; u < 2 * 24 * 16; u += F.nb) {
        const int kc = u % 16, cb = (u / 16) % 24, layer = u / (16 * 24);
        const int j = cb * 512 + F.tid;
        const float* w = w_ada + ((size_t)layer * D + kc * 128) * MOD_W + j;
        float acc[5] = {0.f, 0.f, 0.f, 0.f, 0.f};
#pragma unroll 8
        for (int k = 0; k < 128; ++k) { const float wv = w[(size_t)k * MOD_W];
#pragma unroll
            for (int r = 0; r < 5; ++r) acc[r] += ca[r * D + kc * 128 + k] * wv; }
#pragma unroll
        for (int r = 0; r < 5; ++r) MODP[(((size_t)kc * 2 + layer) * 5 + r) * MOD_W + j] = acc[r];
    }
    __syncthreads();
}
__device__ __forceinline__ void ph_copy_x(const Ctx& F, const float* x, const float* ctx, float* XR) {
    const size_t n4l = (size_t)NL * D / 4, n4 = (size_t)NR * D / 4;
    for (size_t i = (size_t)F.bid * NTHR + F.tid; i < n4; i += (size_t)F.nb * NTHR)
        ((f32x4*)XR)[i] = i < n4l ? ((const f32x4*)x)[i] : ((const f32x4*)ctx)[i - n4l];
}
__device__ __forceinline__ void ph_mod_reduce(const Ctx& F, const float* MODP, const float* b_ada, float* MOD) {
    for (int i = F.bid * NTHR + F.tid; i < 2 * 5 * MOD_W; i += F.nb * NTHR) {
        const int j = i % MOD_W, layer = i / (5 * MOD_W);
        float s = b_ada[layer * MOD_W + j];
        for (int kc = 0; kc < 16; ++kc) s += MODP[(size_t)kc * 2 * 5 * MOD_W + i];
        MOD[i] = s;
    }
}
struct CvtJob { const float* src; bf16_t* dst; int K, Nsrc, nblk  , map  ; const float* src2; };
__device__ __forceinline__ void cvt_item(const CvtJob& J, int kb, int nbp, int tid) {
    const float* src = J.src; int c0 = nbp * 128, valid = 128;
    if (J.map == 1) { if (nbp < 48) c0 = nbp * 128; else if (nbp < 108) c0 = nbp * 128 + 32; else if (nbp == 108) { c0 = S_AF; valid = 32; } else { c0 = 0; valid = 0; } }
    else if (J.map == 2) { const int tile = nbp >> 1; c0 = tile * 128; if (nbp & 1) src = J.src2; }
    const int n4 = (tid & 31) * 4, k0 = kb * 128 + (tid >> 5) * 8;
    f32x4 v[8];
    if (n4 < valid) {
#pragma unroll
        for (int j = 0; j < 8; ++j) v[j] = *(const f32x4*)(src + (size_t)(k0 + j) * J.Nsrc + c0 + n4);
    } else {
#pragma unroll
        for (int j = 0; j < 8; ++j) v[j] = (f32x4){0.f, 0.f, 0.f, 0.f};
    }
#pragma unroll
    for (int i = 0; i < 4; ++i) {
        u32x4 w; w.x = pk2(v[0][i], v[1][i]); w.y = pk2(v[2][i], v[3][i]); w.z = pk2(v[4][i], v[5][i]); w.w = pk2(v[6][i], v[7][i]);
        *(u32x4*)(J.dst + (size_t)(nbp * 128 + n4 + i) * J.K + k0) = w;
    }
}
__device__ __forceinline__ void ph_convert(const Ctx& F, const Params& p) {
    unsigned char* ws = (unsigned char*)(GAS unsigned char*)p.ws;
    int base = 0;
#define CVT_RUN(SRC, SRC2, DST, KK, NSRC, NBLK, MAP) do { CvtJob J{SRC, DST, KK, NSRC, NBLK, MAP, SRC2}; const int nk = (KK) / 128, nit = nk * (NBLK); \
        int it = (F.bid - base % F.nb + F.nb) % F.nb; for (; it < nit; it += F.nb) cvt_item(J, it % nk, it / nk, F.tid); base += nit; } while (0)
    for (int l = 0; l < 2; ++l) {
        CVT_RUN(((const float*)(const GAS float*)p.in[8]) + (size_t)l * D * DIN, nullptr, (bf16_t*)(ws + WS_WIN) + (size_t)l * NIN * D, D, DIN, NIN / 128, 1);
        CVT_RUN(((const float*)(const GAS float*)p.in[15]) + (size_t)l * 1024 * D, nullptr, (bf16_t*)(ws + WS_WP) + (size_t)(l * 3 + 0) * D * 1024, 1024, D, D / 128, 0);
        CVT_RUN(((const float*)(const GAS float*)p.in[16]) + (size_t)l * 1024 * D, nullptr, (bf16_t*)(ws + WS_WP) + (size_t)(l * 3 + 1) * D * 1024, 1024, D, D / 128, 0);
        CVT_RUN(((const float*)(const GAS float*)p.in[17]) + (size_t)l * 1024 * D, nullptr, (bf16_t*)(ws + WS_WP) + (size_t)(l * 3 + 2) * D * 1024, 1024, D, D / 128, 0);
        CVT_RUN(((const float*)(const GAS float*)p.in[18]) + (size_t)l * D * D, nullptr, (bf16_t*)(ws + WS_WOUT) + (size_t)l * D * D, D, D, D / 128, 0);
    }
    CVT_RUN(((const float*)(const GAS float*)p.in[19]), ((const float*)(const GAS float*)p.in[20]), (bf16_t*)(ws + WS_DGU), D, DFF, 2 * DFF / 128, 2);
    CVT_RUN(((const float*)(const GAS float*)p.in[21]), nullptr, (bf16_t*)(ws + WS_DDN), DFF, D, D / 128, 0);
    for (int e = 0; e < NE; ++e) {
        CVT_RUN(((const float*)(const GAS float*)p.in[24]) + (size_t)e * D * DFF, ((const float*)(const GAS float*)p.in[25]) + (size_t)e * D * DFF, (bf16_t*)(ws + WS_MGU) + (size_t)e * 2 * DFF * D, D, DFF, 2 * DFF / 128, 2);
        CVT_RUN(((const float*)(const GAS float*)p.in[26]) + (size_t)e * DFF * D, nullptr, (bf16_t*)(ws + WS_MDN) + (size_t)e * D * DFF, DFF, D, D / 128, 0);
    }
#undef CVT_RUN
}
template <bool ROUTER>
__device__ __forceinline__ void ph_norm(const Ctx& F, const float* X, const float* g, const float* modl, int sh_off, int sc_off, bf16_t* H, int rows,
                                        const float* rw, const float* rb, int* tok_e, float* tok_w) {
    for (int row = F.bid * NWAVES + F.wave; row < rows; row += F.nb * NWAVES) {
        const f32x4* xr = (const f32x4*)(X + (size_t)row * D) + F.lane;
        f32x4 v[8]; float ss = 0.f;
#pragma unroll
        for (int j = 0; j < 8; ++j) { v[j] = xr[64 * j]; ss += v[j][0] * v[j][0] + v[j][1] * v[j][1] + v[j][2] * v[j][2] + v[j][3] * v[j][3]; }
        ss = wave_sum(ss);
        const float rs = rsqrtf(ss * (1.f / D) + EPS);
        const float* mb = modl + (size_t)batch_of(row) * MOD_W;
        float lg[8];
        if (ROUTER) {
#pragma unroll
            for (int e = 0; e < 8; ++e) lg[e] = 0.f; }
#pragma unroll
        for (int j = 0; j < 8; ++j) { const int c = 4 * F.lane + 256 * j;
            const f32x4 gg = *(const f32x4*)(g + c), sc = *(const f32x4*)(mb + sc_off + c), sh = *(const f32x4*)(mb + sh_off + c);
            f32x4 y;
#pragma unroll
            for (int i = 0; i < 4; ++i) y[i] = v[j][i] * rs * gg[i] * (1.f + sc[i]) + sh[i];
            u32x2 w; w.x = pk2(y[0], y[1]); w.y = pk2(y[2], y[3]);
            *(u32x2*)(H + (size_t)row * D + c) = w;
            if (ROUTER) {
#pragma unroll
                for (int i = 0; i < 4; ++i) { const f32x4 w0 = *(const f32x4*)(rw + (size_t)(c + i) * 8), w1 = *(const f32x4*)(rw + (size_t)(c + i) * 8 + 4);
#pragma unroll
                    for (int e = 0; e < 4; ++e) { lg[e] += y[i] * w0[e]; lg[4 + e] += y[i] * w1[e]; } } }
        }
        if (ROUTER) {
#pragma unroll
            for (int e = 0; e < 8; ++e) lg[e] = wave_sum(lg[e]) + rb[e];
            if (F.lane == 0) {
                int i0 = 0;
#pragma unroll
                for (int e = 1; e < 8; ++e) if (lg[e] > lg[i0]) i0 = e;
                int i1 = -1;
#pragma unroll
                for (int e = 0; e < 8; ++e) if (e != i0 && (i1 < 0 || lg[e] > lg[i1])) i1 = e;
                const float e1 = expf(lg[i1] - lg[i0]); const float w0 = 1.f / (1.f + e1);
                tok_e[row * 2] = i0; tok_e[row * 2 + 1] = i1; tok_w[row * 2] = w0; tok_w[row * 2 + 1] = e1 * w0;
            } }
    }
}
__device__ __forceinline__ void ph_prep(const Ctx& F, bf16_t* P, const float* ABF, const float* qn_g, const float* kn_g, const float* w_a2, const float* b_a, float* LG) {
    for (int w = F.bid * NWAVES + F.wave; w < NR * 10; w += F.nb * NWAVES) {
        const int r = w / 10, hh = w % 10;
        bf16_t* src = P + (size_t)r * PW + (hh < 8 ? O_GQQ + hh * 128 : O_GQK + (hh - 8) * 128);
        const float* g = hh < 8 ? qn_g : kn_g;
        const unsigned pr = *(const unsigned*)(src + 2 * F.lane);
        float x1 = __uint_as_float(pr << 16), x2 = __uint_as_float(pr & 0xffff0000u);
        const float ss = wave_sum(x1 * x1 + x2 * x2);
        const float rs = rsqrtf(ss * (1.f / 128.f) + EPS);
        x1 = x1 * rs * g[2 * F.lane]; x2 = x2 * rs * g[2 * F.lane + 1];
        if (r < NL) {
            const int t = r & (S - 1); const int row = t / GW, col = t % GW;
            const int j = F.lane & 31; const float pos = F.lane < 32 ? (float)row : (float)col;
            const float freq = powf(10000.f, -(float)(2 * j) / 64.f);
            const float ang = pos * freq; const float cs = cosf(ang), sn = sinf(ang);
            const float o1 = x1 * cs - x2 * sn, o2 = x1 * sn + x2 * cs; x1 = o1; x2 = o2;
        }
        *(unsigned*)(src + 2 * F.lane) = pk2(x1, x2);
    }
    for (size_t i = (size_t)F.bid * NTHR + F.tid; i < (size_t)2 * NR * 512; i += (size_t)F.nb * NTHR) {
        const int c = (int)(i % 512); const int r = (int)((i / 512) % NR); const int dir = (int)(i / ((size_t)512 * NR));
        const float* a = ABF + (size_t)r * 32 + dir * 16;
        float z = b_a[dir * 512 + c];
#pragma unroll
        for (int j = 0; j < 16; ++j) z += a[j] * w_a2[(dir * 16 + j) * 512 + c];
        const float ls = fminf(z, 0.f) - log1pf(expf(-fabsf(z)));
        LG[i] = ls * (1.f / 16.f);
    }
}

__device__ __forceinline__ void ph_vt(const Ctx& F, const bf16_t* P, bf16_t* VT) {
    LAS bf16_t* T = (LAS bf16_t*)F.lds;
    for (int it = F.bid; it < NB * 36 * 36; it += F.nb) {
        const int b = it / (36 * 36), ct = (it / 36) % 36, tt = it % 36;
        const int c0 = ct * 64, pc = c0 < 1024 ? O_NAV + c0 : (c0 < 2048 ? O_GLV + (c0 - 1024) : O_GQV + (c0 - 2048));
        const int tok0 = tt * 64, row0 = tok0 < S ? b * S + tok0 : NL + b * LC + (tok0 - S);
        __syncthreads();
        { const int r = F.tid >> 3, ch = F.tid & 7; const u32x4 v = *(const u32x4*)(P + (size_t)(row0 + r) * PW + pc + ch * 8); *(LAS u32x4*)(T + r * 72 + ch * 8) = v; }
        __syncthreads();
        { const int c = F.tid >> 3, tc = F.tid & 7; unsigned w[4];
#pragma unroll
          for (int j = 0; j < 4; ++j) w[j] = (unsigned)T[(8 * tc + 2 * j) * 72 + c] | ((unsigned)T[(8 * tc + 2 * j + 1) * 72 + c] << 16);
          *(u32x4*)(VT + ((size_t)b * 2304 + c0 + c) * 2304 + tok0 + 8 * tc) = (u32x4){w[0], w[1], w[2], w[3]}; }
    }
    __syncthreads();
}
#define MFMA16(a, b, c) __builtin_amdgcn_mfma_f32_16x16x32_bf16((a), (b), (c), 0, 0, 0)
constexpr float LOG2E = 1.4426950408889634f;
__device__ __forceinline__ void ph_na(const Ctx& F, const bf16_t* P, const bf16_t* VT, const float* rpb, bf16_t* AO, bool with_ctx) {
    const int lane = F.lane, fr = lane & 15, g = lane >> 4;
    LAS float* bias_s = (LAS float*)F.lds + F.wave * 512;
    const int nunits = 2048 + (with_ctx ? 256 : 0);
    const int kperm = 8 * (fr >> 2) + (fr & 3);
    for (int u = F.bid * NWAVES + F.wave; u < nunits; u += F.nb * NWAVES) {
        const bool lat = u < 2048;
        int b, h, r = 0, qrow0;
        if (lat) { b = u >> 9; r = (u >> 4) & 31; h = u & 15; qrow0 = b * S + r * GW; }
        else { const int v = u - 2048; b = v >> 6; h = v & 15; qrow0 = NL + b * LC + ((v >> 4) & 3) * 64; }
        if (lat) { for (int i = lane; i < 465; i += 64) bias_s[i] = rpb[h * 465 + i] * LOG2E; }
        bf16x8 Qf[4][2];
#pragma unroll
        for (int nq = 0; nq < 4; ++nq)
#pragma unroll
            for (int ks = 0; ks < 2; ++ks) Qf[nq][ks] = *(const bf16x8*)(P + (size_t)(qrow0 + 16 * nq + fr) * PW + O_NAQ + h * 64 + 32 * ks + 8 * g);
        f32x4 O[4][4]; float m[4], l[4];
#pragma unroll
        for (int nq = 0; nq < 4; ++nq) { m[nq] = -1e30f; l[nq] = 0.f;
#pragma unroll
            for (int db = 0; db < 4; ++db) O[nq][db] = (f32x4){0.f, 0.f, 0.f, 0.f}; }
        const int r0 = min(max(r - 4, 0), 24);
        const int ntile = lat ? 12 : 4;
        __builtin_amdgcn_s_waitcnt(0); __builtin_amdgcn_wave_barrier();
        for (int ti = 0; ti < ntile; ++ti) {
            const bool ctile = ti < 4; const int w = ti - 4;
            const int krow_t = ctile ? NL + b * LC + ti * 64 : b * S + (r0 + w) * GW;
            const int vtok_t = ctile ? S + ti * 64 : (r0 + w) * GW;
#pragma unroll 1
            for (int kb = 0; kb < 2; ++kb) {
                bf16x8 Kf[2][2];
#pragma unroll
                for (int t = 0; t < 2; ++t)
#pragma unroll
                    for (int ks = 0; ks < 2; ++ks) Kf[t][ks] = *(const bf16x8*)(P + (size_t)(krow_t + 32 * kb + kperm + 4 * t) * PW + O_NAK + h * 64 + 32 * ks + 8 * g);
                bf16x8 Vf[4];
#pragma unroll
                for (int db = 0; db < 4; ++db) Vf[db] = *(const bf16x8*)(VT + ((size_t)b * 2304 + h * 64 + 16 * db + fr) * 2304 + vtok_t + 32 * kb + 8 * g);
                bf16x8 Pf[4];
#pragma unroll
                for (int nq = 0; nq < 4; ++nq) {
                    f32x4 s0 = (f32x4){0.f, 0.f, 0.f, 0.f}, s1 = (f32x4){0.f, 0.f, 0.f, 0.f};
                    s0 = MFMA16(Kf[0][0], Qf[nq][0], s0); s0 = MFMA16(Kf[0][1], Qf[nq][1], s0);
                    s1 = MFMA16(Kf[1][0], Qf[nq][0], s1); s1 = MFMA16(Kf[1][1], Qf[nq][1], s1);
                    float x[8];
#pragma unroll
                    for (int i = 0; i < 4; ++i) { x[i] = s0[i] * (0.125f * LOG2E); x[4 + i] = s1[i] * (0.125f * LOG2E); }
                    if (!ctile) {
                        const int qcol = 16 * nq + fr, c0 = min(max(qcol - 8, 0), 48), kc0 = 32 * kb + 8 * g;
                        const int bidx = 31 * (r0 + w - r + 7) + (kc0 - qcol + 15);
#pragma unroll
                        for (int j = 0; j < 8; ++j) { const int kc = kc0 + j; const bool ok = kc >= c0 && kc < c0 + 16;
                            const int bi = min(max(bidx + j, 0), 464); x[j] = ok ? x[j] + bias_s[bi] : -1e30f; }
                    }
                    float mx = fmaxf(fmaxf(fmaxf(x[0], x[1]), fmaxf(x[2], x[3])), fmaxf(fmaxf(x[4], x[5]), fmaxf(x[6], x[7])));
                    mx = fmaxf(mx, __shfl_xor(mx, 16)); mx = fmaxf(mx, __shfl_xor(mx, 32));
                    const float mn = fmaxf(m[nq], mx), alpha = __builtin_amdgcn_exp2f(m[nq] - mn);
                    float ps = 0.f;
#pragma unroll
                    for (int j = 0; j < 8; ++j) { x[j] = __builtin_amdgcn_exp2f(x[j] - mn); ps += x[j]; }
                    l[nq] = l[nq] * alpha + ps; m[nq] = mn;
#pragma unroll
                    for (int db = 0; db < 4; ++db) O[nq][db] = O[nq][db] * alpha;
                    u32x4 pw; pw.x = cvt_pk_bf16(x[0], x[1]); pw.y = cvt_pk_bf16(x[2], x[3]); pw.z = cvt_pk_bf16(x[4], x[5]); pw.w = cvt_pk_bf16(x[6], x[7]);
                    Pf[nq] = __builtin_bit_cast(bf16x8, pw);
                }
#pragma unroll
                for (int nq = 0; nq < 4; ++nq)
#pragma unroll
                    for (int db = 0; db < 4; ++db) O[nq][db] = MFMA16(Vf[db], Pf[nq], O[nq][db]);
            }
        }
#pragma unroll
        for (int nq = 0; nq < 4; ++nq) { float lt = l[nq]; lt += __shfl_xor(lt, 16); lt += __shfl_xor(lt, 32); const float inv = 1.f / lt;
#pragma unroll
            for (int db = 0; db < 4; ++db) { const f32x4 o = O[nq][db] * inv; u32x2 wv; wv.x = cvt_pk_bf16(o[0], o[1]); wv.y = cvt_pk_bf16(o[2], o[3]);
                *(u32x2*)(AO + (size_t)(qrow0 + 16 * nq + fr) * 1024 + h * 64 + 16 * db + 4 * g) = wv; } }
        __builtin_amdgcn_s_waitcnt(0); __builtin_amdgcn_wave_barrier();
    }
}
constexpr int GQ_KP = 272, GQ_VP = 144, GQ_KT = 64 * GQ_KP, GQ_VTB = 128 * GQ_VP, GQ_BUF = GQ_KT + GQ_VTB;
__device__ __forceinline__ void ph_gqa(const Ctx& F, const bf16_t* P, const bf16_t* VT, bf16_t* CO, bool with_ctx) {
    const int lane = F.lane, fr = lane & 15, g = lane >> 4, tid = F.tid;
    const int nunits = 256 + (with_ctx ? 32 : 0);
    const float SC = 0.08838834764831845f * LOG2E;
    for (int u = F.bid; u < nunits; u += F.nb) {
        const bool lat = u < 256;
        int b, hq, qrow0, j0, j1;
        if (lat) { b = u >> 6; hq = (u >> 3) & 7; qrow0 = b * S + (u & 7) * 256 + 32 * F.wave; j0 = 0; j1 = 36; }
        else { const int v = u - 256; b = v >> 3; hq = v & 7; qrow0 = NL + b * LC + 32 * F.wave; j0 = 32; j1 = 36; }
        const int kvh = hq >> 2;
        bf16x8 Qf[2][4];
#pragma unroll
        for (int nq = 0; nq < 2; ++nq)
#pragma unroll
            for (int ks = 0; ks < 4; ++ks) Qf[nq][ks] = *(const bf16x8*)(P + (size_t)(qrow0 + 16 * nq + fr) * PW + O_GQQ + hq * 128 + 32 * ks + 8 * g);
        f32x4 O[2][8]; float m[2], l[2];
#pragma unroll
        for (int nq = 0; nq < 2; ++nq) { m[nq] = -1e30f; l[nq] = 0.f;
#pragma unroll
            for (int db = 0; db < 8; ++db) O[nq][db] = (f32x4){0.f, 0.f, 0.f, 0.f}; }
        u32x4 kst[2], vst[2];
#define GQ_LOAD(j) do { const int tok = (j) * 64; const int krow = tok < S ? b * S + tok : NL + b * LC + (tok - S); \
            _Pragma("unroll") for (int i = 0; i < 2; ++i) { const int id = tid + 512 * i; \
                kst[i] = *(const u32x4*)(P + (size_t)(krow + (id >> 4)) * PW + O_GQK + kvh * 128 + (id & 15) * 8); \
                vst[i] = *(const u32x4*)(VT + ((size_t)b * 2304 + 2048 + kvh * 128 + (id >> 3)) * 2304 + tok + (id & 7) * 8); } } while (0)
#define GQ_STORE(buf) do { LAS unsigned char* base = F.lds + (buf) * GQ_BUF; \
            _Pragma("unroll") for (int i = 0; i < 2; ++i) { const int id = tid + 512 * i; \
                *(LAS u32x4*)(base + (id >> 4) * GQ_KP + (id & 15) * 16) = kst[i]; \
                const int d = id >> 3, kc = id & 7, kbk = kc >> 2, cp = kc & 3, t = cp >> 1, a = 2 * (cp & 1); \
                LAS unsigned char* vb = base + GQ_KT + d * GQ_VP + (32 * kbk + 4 * t) * 2; \
                *(LAS u32x2*)(vb + (8 * a) * 2) = (u32x2){vst[i].x, vst[i].y}; *(LAS u32x2*)(vb + (8 * (a + 1)) * 2) = (u32x2){vst[i].z, vst[i].w}; } } while (0)
        __syncthreads();
        GQ_LOAD(j0); GQ_STORE(0);
        __syncthreads();
        for (int j = j0; j < j1; ++j) {
            const int cur = (j - j0) & 1;
            if (j + 1 < j1) GQ_LOAD(j + 1);
            LAS unsigned char* base = F.lds + cur * GQ_BUF;
#pragma unroll 1
            for (int kb = 0; kb < 2; ++kb) {
                bf16x8 Pf[2];
                {
                    bf16x8 Kf[2][4];
#pragma unroll
                    for (int t = 0; t < 2; ++t)
#pragma unroll
                        for (int ks = 0; ks < 4; ++ks) Kf[t][ks] = *(const LAS bf16x8*)(base + (32 * kb + 16 * t + fr) * GQ_KP + (32 * ks + 8 * g) * 2);
#pragma unroll
                    for (int nq = 0; nq < 2; ++nq) {
                        f32x4 s0 = (f32x4){0.f, 0.f, 0.f, 0.f}, s1 = (f32x4){0.f, 0.f, 0.f, 0.f};
#pragma unroll
                        for (int ks = 0; ks < 4; ++ks) { s0 = MFMA16(Kf[0][ks], Qf[nq][ks], s0); s1 = MFMA16(Kf[1][ks], Qf[nq][ks], s1); }
                        float x[8];
#pragma unroll
                        for (int i = 0; i < 4; ++i) { x[i] = s0[i] * SC; x[4 + i] = s1[i] * SC; }
                        float mx = fmaxf(fmaxf(fmaxf(x[0], x[1]), fmaxf(x[2], x[3])), fmaxf(fmaxf(x[4], x[5]), fmaxf(x[6], x[7])));
                        mx = fmaxf(mx, __shfl_xor(mx, 16)); mx = fmaxf(mx, __shfl_xor(mx, 32));
                        const float mn = fmaxf(m[nq], mx), alpha = __builtin_amdgcn_exp2f(m[nq] - mn);
                        float ps = 0.f;
#pragma unroll
                        for (int jj = 0; jj < 8; ++jj) { x[jj] = __builtin_amdgcn_exp2f(x[jj] - mn); ps += x[jj]; }
                        l[nq] = l[nq] * alpha + ps; m[nq] = mn;
#pragma unroll
                        for (int db = 0; db < 8; ++db) O[nq][db] = O[nq][db] * alpha;
                        u32x4 pw; pw.x = cvt_pk_bf16(x[0], x[1]); pw.y = cvt_pk_bf16(x[2], x[3]); pw.z = cvt_pk_bf16(x[4], x[5]); pw.w = cvt_pk_bf16(x[6], x[7]);
                        Pf[nq] = __builtin_bit_cast(bf16x8, pw);
                    }
                }
#pragma unroll
                for (int db = 0; db < 8; ++db) { const bf16x8 Vf = *(const LAS bf16x8*)(base + GQ_KT + (16 * db + fr) * GQ_VP + (32 * kb + 8 * g) * 2);
                    O[0][db] = MFMA16(Vf, Pf[0], O[0][db]); O[1][db] = MFMA16(Vf, Pf[1], O[1][db]); }
            }
            __syncthreads();
            if (j + 1 < j1) GQ_STORE(cur ^ 1);
            __syncthreads();
        }
#undef GQ_LOAD
#undef GQ_STORE
#pragma unroll
        for (int nq = 0; nq < 2; ++nq) { float lt = l[nq]; lt += __shfl_xor(lt, 16); lt += __shfl_xor(lt, 32); const float inv = 1.f / lt;
#pragma unroll
            for (int db = 0; db < 8; ++db) { const f32x4 o = O[nq][db] * inv; u32x2 wv; wv.x = cvt_pk_bf16(o[0], o[1]); wv.y = cvt_pk_bf16(o[2], o[3]);
                *(u32x2*)(CO + (size_t)(qrow0 + 16 * nq + fr) * 1024 + hq * 128 + 16 * db + 4 * g) = wv; } }
    }
    __syncthreads();
}

__device__ __forceinline__ void gla_unit_rows(int b, int c, int& row0, int& tok0) { if (c < 4) { row0 = NL + b * LC + 64 * c; tok0 = S + 64 * c; } else { row0 = b * S + 64 * (c - 4); tok0 = 64 * (c - 4); } }
__device__ __forceinline__ void ph_gla_a(const Ctx& F, const bf16_t* P, const bf16_t* VT, const float* LG, float* OG, bf16_t* QT, bf16_t* KVb, float* DEC) {
    const int lane = F.lane, fr = lane & 15, g = lane >> 4, tid = F.tid, w = F.wave;
    LAS float* Gs = (LAS float*)F.lds;
    LAS unsigned char* Qt = F.lds + 32768;
    LAS unsigned char* Kt = F.lds + 50176;
    LAS unsigned char* KhT = F.lds + 67584;
    LAS unsigned char* Pfr = F.lds + 86016;
    LAS float* Seg = (LAS float*)(F.lds + 94208);
    for (int u = F.bid; u < 1152; u += F.nb) {
        const int c = u % 36, h = (u / 36) & 3, b = (u / 144) & 3, dir = u / 576;
        int row0, tok0; gla_unit_rows(b, c, row0, tok0);
        __syncthreads();
        bf16x8 Vf[2][2];
#pragma unroll
        for (int db = 0; db < 2; ++db)
#pragma unroll
            for (int jb = 0; jb < 2; ++jb) Vf[db][jb] = *(const bf16x8*)(VT + ((size_t)b * 2304 + 1024 + h * 256 + 32 * w + 16 * db + fr) * 2304 + tok0 + 32 * jb + 8 * g);
        {
            const int col = tid & 127, seg = tid >> 7;
            float v[16];
#pragma unroll
            for (int i = 0; i < 16; ++i) v[i] = LG[((size_t)dir * NR + row0 + seg * 16 + i) * 512 + h * 128 + col];
            if (dir == 0) {
#pragma unroll
                for (int i = 1; i < 16; ++i) v[i] += v[i - 1];
                Seg[seg * 128 + col] = v[15];
            } else {
#pragma unroll
                for (int i = 14; i >= 0; --i) v[i] += v[i + 1];
                Seg[seg * 128 + col] = v[0];
            }
            __syncthreads();
            float off = 0.f;
            if (dir == 0) { for (int s2 = 0; s2 < seg; ++s2) off += Seg[s2 * 128 + col]; }
            else { for (int s2 = 3; s2 > seg; --s2) off += Seg[s2 * 128 + col]; }
#pragma unroll
            for (int i = 0; i < 16; ++i) Gs[(seg * 16 + i) * 128 + col] = v[i] + off;
        }
        __syncthreads();
        {
            const int tok = tid >> 3, d0 = (tid & 7) * 16;
            const bf16_t* pr = P + (size_t)(row0 + tok) * PW;
            const u32x4 q0 = *(const u32x4*)(pr + O_GLQ + h * 128 + d0), q1 = *(const u32x4*)(pr + O_GLQ + h * 128 + d0 + 8);
            const u32x4 k0 = *(const u32x4*)(pr + O_GLK + h * 128 + d0), k1 = *(const u32x4*)(pr + O_GLK + h * 128 + d0 + 8);
            const unsigned qw[8] = {q0.x, q0.y, q0.z, q0.w, q1.x, q1.y, q1.z, q1.w}, kw[8] = {k0.x, k0.y, k0.z, k0.w, k1.x, k1.y, k1.z, k1.w};
            const int glast = dir == 0 ? 63 : 0;
            unsigned qo[8], ko[8];
#pragma unroll
            for (int p2 = 0; p2 < 8; ++p2) {
                float qt[2], kt[2], kh[2];
#pragma unroll
                for (int e = 0; e < 2; ++e) { const int dk = d0 + 2 * p2 + e;
                    const float gg = Gs[tok * 128 + dk], GG = Gs[glast * 128 + dk];
                    const float qv = e ? __uint_as_float(qw[p2] & 0xffff0000u) : __uint_as_float(qw[p2] << 16), kv = e ? __uint_as_float(kw[p2] & 0xffff0000u) : __uint_as_float(kw[p2] << 16);
                    qt[e] = qv * 0.08838834764831845f * __builtin_amdgcn_exp2f(gg * LOG2E); kt[e] = kv * __builtin_amdgcn_exp2f(-gg * LOG2E); kh[e] = kv * __builtin_amdgcn_exp2f((GG - gg) * LOG2E);
                    *(LAS bf16_t*)(KhT + dk * 144 + tok * 2) = (bf16_t)f2bf(kh[e]); }
                qo[p2] = cvt_pk_bf16(qt[0], qt[1]); ko[p2] = cvt_pk_bf16(kt[0], kt[1]);
            }
            *(LAS u32x4*)(Qt + tok * 272 + d0 * 2) = (u32x4){qo[0], qo[1], qo[2], qo[3]}; *(LAS u32x4*)(Qt + tok * 272 + d0 * 2 + 16) = (u32x4){qo[4], qo[5], qo[6], qo[7]};
            *(LAS u32x4*)(Kt + tok * 272 + d0 * 2) = (u32x4){ko[0], ko[1], ko[2], ko[3]}; *(LAS u32x4*)(Kt + tok * 272 + d0 * 2 + 16) = (u32x4){ko[4], ko[5], ko[6], ko[7]};
            bf16_t* qg = QT + ((size_t)dir * NR + row0 + tok) * 512 + h * 128 + d0;
            *(u32x4*)qg = (u32x4){qo[0], qo[1], qo[2], qo[3]}; *(u32x4*)(qg + 8) = (u32x4){qo[4], qo[5], qo[6], qo[7]};
            if (tid < 128) DEC[(size_t)u * 128 + tid] = __builtin_amdgcn_exp2f(Gs[glast * 128 + tid] * LOG2E);
        }
        __syncthreads();
        {
            const int ib = w & 3, jb = w >> 2;
            f32x4 s0 = (f32x4){0.f, 0.f, 0.f, 0.f}, s1 = (f32x4){0.f, 0.f, 0.f, 0.f};
            const int jr = 32 * jb + 8 * (fr >> 2) + (fr & 3);
#pragma unroll
            for (int ks = 0; ks < 4; ++ks) {
                const bf16x8 qf = *(const LAS bf16x8*)(Qt + (16 * ib + fr) * 272 + (32 * ks + 8 * g) * 2);
                const bf16x8 k0f = *(const LAS bf16x8*)(Kt + jr * 272 + (32 * ks + 8 * g) * 2), k1f = *(const LAS bf16x8*)(Kt + (jr + 4) * 272 + (32 * ks + 8 * g) * 2);
                s0 = MFMA16(k0f, qf, s0); s1 = MFMA16(k1f, qf, s1);
            }
            const int i = 16 * ib + fr, j0 = 32 * jb + 8 * g;
            float x[8];
#pragma unroll
            for (int e = 0; e < 4; ++e) { x[e] = s0[e]; x[4 + e] = s1[e]; }
#pragma unroll
            for (int e = 0; e < 8; ++e) { const int j = j0 + e; const bool keep = dir == 0 ? (j <= i) : (j >= i); x[e] = keep ? x[e] : 0.f; }
            u32x4 pw; pw.x = cvt_pk_bf16(x[0], x[1]); pw.y = cvt_pk_bf16(x[2], x[3]); pw.z = cvt_pk_bf16(x[4], x[5]); pw.w = cvt_pk_bf16(x[6], x[7]);
            *(LAS u32x4*)(Pfr + (jb * 4 + ib) * 1024 + lane * 16) = pw;
        }
        __syncthreads();
        {
#pragma unroll
            for (int ib = 0; ib < 4; ++ib) {
                const bf16x8 p0 = *(const LAS bf16x8*)(Pfr + (0 * 4 + ib) * 1024 + lane * 16), p1 = *(const LAS bf16x8*)(Pfr + (1 * 4 + ib) * 1024 + lane * 16);
#pragma unroll
                for (int db = 0; db < 2; ++db) {
                    f32x4 o = (f32x4){0.f, 0.f, 0.f, 0.f};
                    o = MFMA16(Vf[db][0], p0, o); o = MFMA16(Vf[db][1], p1, o);
                    *(f32x4*)(OG + ((size_t)dir * NR + row0 + 16 * ib + fr) * 1024 + h * 256 + 32 * w + 16 * db + 4 * g) = o;
                }
            }
#pragma unroll
            for (int dkb = 0; dkb < 8; ++dkb) {
                const bf16x8 kh0 = *(const LAS bf16x8*)(KhT + (16 * dkb + fr) * 144 + (8 * g) * 2), kh1 = *(const LAS bf16x8*)(KhT + (16 * dkb + fr) * 144 + (32 + 8 * g) * 2);
#pragma unroll
                for (int db = 0; db < 2; ++db) {
                    f32x4 o = (f32x4){0.f, 0.f, 0.f, 0.f};
                    o = MFMA16(Vf[db][0], kh0, o); o = MFMA16(Vf[db][1], kh1, o);
                    bf16_t* dst = KVb + ((size_t)u * 256 + 32 * w + 16 * db + 4 * g) * 128 + 16 * dkb + fr;
#pragma unroll
                    for (int e = 0; e < 4; ++e) dst[e * 128] = (bf16_t)f2bf(o[e]);
                }
            }
        }
    }
    __syncthreads();
}
__device__ __forceinline__ void ph_gla_scan(const Ctx& F, bf16_t* KVb, const float* DEC) {
    for (int e = F.bid * NTHR + F.tid; e < 32 * 16384; e += F.nb * NTHR) {
        const int chain = e >> 14, pe = e & 16383, dv = pe >> 6, dk2 = (pe & 63) * 2, dir = chain >> 4;
        float s0 = 0.f, s1 = 0.f;
#pragma unroll 4
        for (int n = 0; n < 36; ++n) {
            const int c = dir == 0 ? n : (n < 4 ? 3 - n : 39 - n);
            const size_t u = (size_t)chain * 36 + c;
            unsigned* pk = (unsigned*)(KVb + (u * 256 + dv) * 128 + dk2);
            const unsigned kv = *pk; const float d0 = DEC[u * 128 + dk2], d1 = DEC[u * 128 + dk2 + 1];
            *pk = pk2(s0, s1);
            s0 = d0 * s0 + __uint_as_float(kv << 16); s1 = d1 * s1 + __uint_as_float(kv & 0xffff0000u);
        }
    }
}
__device__ __forceinline__ void ph_gla_c(const Ctx& F, const bf16_t* P, const float* OG, const bf16_t* QT, const bf16_t* KVb, const float* ng, bf16_t* BO, bool with_ctx) {
    const int lane = F.lane, fr = lane & 15, g = lane >> 4, w = F.wave;
    const int c_lo = with_ctx ? 0 : 4, nun = NB * (36 - c_lo);
    for (int uu = F.bid; uu < nun; uu += F.nb) {
        const int b = uu / (36 - c_lo), c = c_lo + uu % (36 - c_lo), h = w >> 1;
        int row0, tok0; gla_unit_rows(b, c, row0, tok0);
        f32x4 acc[2][16];
#pragma unroll
        for (int ibl = 0; ibl < 2; ++ibl) { const size_t r = (size_t)(row0 + 16 * (2 * (w & 1) + ibl) + fr);
#pragma unroll
            for (int db = 0; db < 16; ++db) acc[ibl][db] = *(const f32x4*)(OG + r * 1024 + h * 256 + 16 * db + 4 * g) + *(const f32x4*)(OG + ((size_t)NR + r) * 1024 + h * 256 + 16 * db + 4 * g); }
#pragma unroll 1
        for (int dir = 0; dir < 2; ++dir) {
            const size_t ud = (size_t)((dir * 4 + b) * 4 + h) * 36 + c;
            bf16x8 Qf[2][4];
#pragma unroll
            for (int ibl = 0; ibl < 2; ++ibl)
#pragma unroll
                for (int ks = 0; ks < 4; ++ks) Qf[ibl][ks] = *(const bf16x8*)(QT + ((size_t)dir * NR + row0 + 16 * (2 * (w & 1) + ibl) + fr) * 512 + h * 128 + 32 * ks + 8 * g);
#pragma unroll
            for (int db = 0; db < 16; ++db)
#pragma unroll
                for (int ks = 0; ks < 4; ++ks) { const bf16x8 Sf = *(const bf16x8*)(KVb + (ud * 256 + 16 * db + fr) * 128 + 32 * ks + 8 * g);
                    acc[0][db] = MFMA16(Sf, Qf[0][ks], acc[0][db]); acc[1][db] = MFMA16(Sf, Qf[1][ks], acc[1][db]); }
        }
#pragma unroll
        for (int ibl = 0; ibl < 2; ++ibl) { const size_t r = (size_t)(row0 + 16 * (2 * (w & 1) + ibl) + fr);
            float ss = 0.f;
#pragma unroll
            for (int db = 0; db < 16; ++db) ss += acc[ibl][db][0] * acc[ibl][db][0] + acc[ibl][db][1] * acc[ibl][db][1] + acc[ibl][db][2] * acc[ibl][db][2] + acc[ibl][db][3] * acc[ibl][db][3];
            ss += __shfl_xor(ss, 16); ss += __shfl_xor(ss, 32);
            const float rs = rsqrtf(ss * (1.f / 256.f) + EPS);
#pragma unroll
            for (int db = 0; db < 16; ++db) { const int dv = 16 * db + 4 * g;
                const u32x2 og = *(const u32x2*)(P + r * PW + O_GLOG + h * 256 + dv); const f32x4 gg = *(const f32x4*)(ng + dv);
                const float z0 = __uint_as_float(og.x << 16), z1 = __uint_as_float(og.x & 0xffff0000u), z2 = __uint_as_float(og.y << 16), z3 = __uint_as_float(og.y & 0xffff0000u);
                const float o0 = acc[ibl][db][0] * rs * gg[0] * z0 * fast_sigmoid(z0), o1 = acc[ibl][db][1] * rs * gg[1] * z1 * fast_sigmoid(z1);
                const float o2 = acc[ibl][db][2] * rs * gg[2] * z2 * fast_sigmoid(z2), o3 = acc[ibl][db][3] * rs * gg[3] * z3 * fast_sigmoid(z3);
                u32x2 wv; wv.x = cvt_pk_bf16(o0, o1); wv.y = cvt_pk_bf16(o2, o3);
                *(u32x2*)(BO + r * 1024 + h * 256 + dv) = wv; }
        }
    }
}
template <bool DO_NA, bool DO_GQA, bool DO_GLA>
__device__ __forceinline__ void ph_attn_naive(const Ctx& F, const bf16_t* P, const float* rpb, const float* LG, bf16_t* AO, bf16_t* CO, float* OG, int MR) {
    if (DO_NA) {
        LAS float* qs = (LAS float*)F.lds + F.wave * 64;
        LAS float* ps = (LAS float*)F.lds + 8 * 64 + F.wave * 384;
        for (int w = F.bid * NWAVES + F.wave; w < MR * 16; w += F.nb * NWAVES) {
            const int r = w / 16, h = w % 16;
            const bool lat = r < NL; const int b = lat ? (r >> 11) : ((r - NL) >> 8);
            qs[F.lane] = bf2f(P[(size_t)r * PW + O_NAQ + h * 64 + F.lane]) * 0.125f;
            __builtin_amdgcn_s_waitcnt(0); __builtin_amdgcn_wave_barrier();
            const int nk = lat ? 384 : 256;
            int qrow = 0, qcol = 0, r0 = 0, c0 = 0;
            if (lat) { const int t = r & (S - 1); qrow = t / GW; qcol = t % GW; r0 = min(max(qrow - 4, 0), 24); c0 = min(max(qcol - 8, 0), 48); }
            float mx = -INFINITY;
            for (int kk = F.lane; kk < nk; kk += 64) {
                int kr; float bias = 0.f;
                if (lat && kk < 128) { const int wr_ = kk >> 4, wc_ = kk & 15; const int krow = r0 + wr_, kcol = c0 + wc_; kr = b * S + krow * GW + kcol;
                    const int dr = krow - qrow + 7; const int dc = min(max(kcol - qcol + 15, 0), 30); bias = rpb[(h * 15 + dr) * 31 + dc]; }
                else { const int l = lat ? kk - 128 : kk; kr = NL + b * LC + l; }
                const bf16_t* kp = P + (size_t)kr * PW + O_NAK + h * 64;
                float s = 0.f;
                for (int d = 0; d < 64; d += 8) { const u32x4 kv = *(const u32x4*)(kp + d);
                    s += qs[d] * __uint_as_float(kv.x << 16) + qs[d + 1] * __uint_as_float(kv.x & 0xffff0000u) + qs[d + 2] * __uint_as_float(kv.y << 16) + qs[d + 3] * __uint_as_float(kv.y & 0xffff0000u)
                       + qs[d + 4] * __uint_as_float(kv.z << 16) + qs[d + 5] * __uint_as_float(kv.z & 0xffff0000u) + qs[d + 6] * __uint_as_float(kv.w << 16) + qs[d + 7] * __uint_as_float(kv.w & 0xffff0000u); }
                s += bias; ps[kk] = s; mx = fmaxf(mx, s);
            }
            mx = wave_max(mx);
            float sum = 0.f;
            for (int kk = F.lane; kk < nk; kk += 64) { const float e = expf(ps[kk] - mx); ps[kk] = e; sum += e; }
            sum = wave_sum(sum);
            __builtin_amdgcn_s_waitcnt(0); __builtin_amdgcn_wave_barrier();
            float o = 0.f;
            for (int kk = 0; kk < nk; ++kk) {
                int kr;
                if (lat && kk < 128) { const int wr_ = kk >> 4, wc_ = kk & 15; kr = b * S + (r0 + wr_) * GW + (c0 + wc_); }
                else { const int l = lat ? kk - 128 : kk; kr = NL + b * LC + l; }
                o += ps[kk] * bf2f(P[(size_t)kr * PW + O_NAV + h * 64 + F.lane]);
            }
            AO[(size_t)r * 1024 + h * 64 + F.lane] = (bf16_t)f2bf(o / sum);
            __builtin_amdgcn_s_waitcnt(0); __builtin_amdgcn_wave_barrier();
        }
    }
    __syncthreads();
    if (DO_GQA) {
        LAS float* qs = (LAS float*)F.lds + F.wave * 128;
        LAS float* ps = (LAS float*)F.lds + 8 * 128 + F.wave * 2304;
        for (int w = F.bid * NWAVES + F.wave; w < MR * 8; w += F.nb * NWAVES) {
            const int r = w / 8, hq = w % 8, kvh = hq >> 2;
            const bool lat = r < NL; const int b = lat ? (r >> 11) : ((r - NL) >> 8);
            const int nk = lat ? (S + LC) : LC;
            qs[F.lane] = bf2f(P[(size_t)r * PW + O_GQQ + hq * 128 + F.lane]); qs[F.lane + 64] = bf2f(P[(size_t)r * PW + O_GQQ + hq * 128 + F.lane + 64]);
            __builtin_amdgcn_s_waitcnt(0); __builtin_amdgcn_wave_barrier();
            const float scale = 0.08838834764831845f;
            float mx = -INFINITY;
            for (int kk = F.lane; kk < nk; kk += 64) {
                int kr; if (lat) kr = kk < S ? b * S + kk : NL + b * LC + (kk - S); else kr = NL + b * LC + kk;
                const bf16_t* kp = P + (size_t)kr * PW + O_GQK + kvh * 128;
                float s = 0.f;
                for (int d = 0; d < 128; d += 8) { const u32x4 kv = *(const u32x4*)(kp + d);
                    s += qs[d] * __uint_as_float(kv.x << 16) + qs[d + 1] * __uint_as_float(kv.x & 0xffff0000u) + qs[d + 2] * __uint_as_float(kv.y << 16) + qs[d + 3] * __uint_as_float(kv.y & 0xffff0000u)
                       + qs[d + 4] * __uint_as_float(kv.z << 16) + qs[d + 5] * __uint_as_float(kv.z & 0xffff0000u) + qs[d + 6] * __uint_as_float(kv.w << 16) + qs[d + 7] * __uint_as_float(kv.w & 0xffff0000u); }
                s *= scale; ps[kk] = s; mx = fmaxf(mx, s);
            }
            mx = wave_max(mx);
            float sum = 0.f;
            for (int kk = F.lane; kk < nk; kk += 64) { const float e = expf(ps[kk] - mx); ps[kk] = e; sum += e; }
            sum = wave_sum(sum);
            __builtin_amdgcn_s_waitcnt(0); __builtin_amdgcn_wave_barrier();
            float o0 = 0.f, o1 = 0.f;
            for (int kk = 0; kk < nk; ++kk) {
                int kr; if (lat) kr = kk < S ? b * S + kk : NL + b * LC + (kk - S); else kr = NL + b * LC + kk;
                const unsigned vv = *(const unsigned*)(P + (size_t)kr * PW + O_GQV + kvh * 128 + 2 * F.lane);
                const float pp = ps[kk];
                o0 += pp * __uint_as_float(vv << 16); o1 += pp * __uint_as_float(vv & 0xffff0000u);
            }
            const float inv = 1.f / sum;
            *(unsigned*)(CO + (size_t)r * 1024 + hq * 128 + 2 * F.lane) = pk2(o0 * inv, o1 * inv);
            __builtin_amdgcn_s_waitcnt(0); __builtin_amdgcn_wave_barrier();
        }
    }
    __syncthreads();
    if (DO_GLA) {
        LAS float* sq = (LAS float*)F.lds; LAS float* sk = sq + 128; LAS float* sg = sk + 128; LAS float* sv = sg + 128; LAS float* red = sv + 64;
        for (int u = F.bid; u < 128; u += F.nb) {
            const int sl = u & 3, h = (u >> 2) & 3, b = (u >> 4) & 3, dir = u >> 6;
            const int dvi = F.tid & 63, kg = F.tid >> 6;
            float st[16];
#pragma unroll
            for (int i = 0; i < 16; ++i) st[i] = 0.f;
            const float qscale = 0.08838834764831845f;
            for (int step = 0; step < LC + S; ++step) {
                int r;
                if (step < LC) r = NL + b * LC + (dir ? (LC - 1 - step) : step);
                else { const int t = step - LC; r = b * S + (dir ? (S - 1 - t) : t); }
                const bf16_t* pr = P + (size_t)r * PW;
                if (F.tid < 128) { sq[F.tid] = bf2f(pr[O_GLQ + h * 128 + F.tid]) * qscale; sk[F.tid] = bf2f(pr[O_GLK + h * 128 + F.tid]); }
                else if (F.tid < 256) { const int d = F.tid - 128; sg[d] = expf(LG[((size_t)dir * NR + r) * 512 + h * 128 + d]); }
                else if (F.tid < 320) { const int d = F.tid - 256; sv[d] = bf2f(pr[O_GLV + h * 256 + sl * 64 + d]); }
                __syncthreads();
                const float v = sv[dvi]; float o = 0.f;
#pragma unroll
                for (int i = 0; i < 16; ++i) { const int d = kg * 16 + i; st[i] = sg[d] * st[i] + sk[d] * v; o += sq[d] * st[i]; }
                red[kg * 64 + dvi] = o;
                __syncthreads();
                if (F.tid < 64) { float s = 0.f;
#pragma unroll
                    for (int j = 0; j < 8; ++j) s += red[j * 64 + F.tid];
                    OG[((size_t)dir * NR + r) * 1024 + h * 256 + sl * 64 + F.tid] = s; }
            }
            __syncthreads();
        }
    }
}
__device__ __forceinline__ void ph_gla_finish(const Ctx& F, const float* OG, const bf16_t* P, const float* ng, bf16_t* BO, int MR) {
    for (int w = F.bid * NWAVES + F.wave; w < MR * 4; w += F.nb * NWAVES) {
        const int r = w >> 2, h = w & 3;
        const int c = h * 256 + 4 * F.lane;
        const f32x4 a = *(const f32x4*)(OG + (size_t)r * 1024 + c), b = *(const f32x4*)(OG + ((size_t)NR + r) * 1024 + c);
        const f32x4 v = a + b;
        const float ss = wave_sum(v[0] * v[0] + v[1] * v[1] + v[2] * v[2] + v[3] * v[3]);
        const float rs = rsqrtf(ss * (1.f / 256.f) + EPS);
        const u32x2 og = *(const u32x2*)(P + (size_t)r * PW + O_GLOG + c);
        const f32x4 gg = *(const f32x4*)(ng + 4 * F.lane);
        const float o0 = v[0] * rs * gg[0] * siluf_(__uint_as_float(og.x << 16)), o1 = v[1] * rs * gg[1] * siluf_(__uint_as_float(og.x & 0xffff0000u));
        const float o2 = v[2] * rs * gg[2] * siluf_(__uint_as_float(og.y << 16)), o3 = v[3] * rs * gg[3] * siluf_(__uint_as_float(og.y & 0xffff0000u));
        u32x2 wv; wv.x = pk2(o0, o1); wv.y = pk2(o2, o3);
        *(u32x2*)(BO + (size_t)r * 1024 + c) = wv;
    }
}
__device__ __forceinline__ void ph_moe_sort(const Ctx& F, const int* tok_e, int* tok_slot, const bf16_t* H, bf16_t* HS, unsigned* cnt_out) {
    if (F.bid >= 32) return;
    LAS int* tot = (LAS int*)F.lds;
    LAS int* pre = tot + 8;
    LAS int* wcnt = pre + 8;
    LAS int* slots = wcnt + 64;
    if (F.tid < 16) tot[F.tid] = 0;
    __syncthreads();
    {
        int ct[8], cp[8];
#pragma unroll
        for (int e = 0; e < 8; ++e) { ct[e] = 0; cp[e] = 0; }
        for (int i = F.tid; i < NL * 2; i += NTHR) { const int e = tok_e[i]; const bool before = i < F.bid * 512;
#pragma unroll
            for (int j = 0; j < 8; ++j) { ct[j] += (e == j); cp[j] += (e == j && before); } }
#pragma unroll
        for (int e = 0; e < 8; ++e) { const int a = (int)wave_sum((float)ct[e]), b = (int)wave_sum((float)cp[e]); if (F.lane == 0) { atomicAdd((int*)&tot[e], a); atomicAdd((int*)&pre[e], b); } }
    }
    __syncthreads();
    int pstart[8]; { int acc = 0;
#pragma unroll
        for (int e = 0; e < 8; ++e) { pstart[e] = acc; acc += (tot[e] + 255) / 256 * 256; } }
    const int ai = F.bid * 512 + F.tid; const int me = tok_e[ai];
    int rank_in_wave = 0;
#pragma unroll
    for (int e = 0; e < 8; ++e) { const unsigned long long m = __ballot(me == e); if (me == e) rank_in_wave = __popcll(m & ((1ull << F.lane) - 1ull)); if (F.lane == 0) wcnt[F.wave * 8 + e] = __popcll(m); }
    __syncthreads();
    int before_w = 0; for (int w = 0; w < F.wave; ++w) before_w += wcnt[w * 8 + me];
    int ps_me = 0, pre_me = pre[me];
#pragma unroll
    for (int e = 0; e < 8; ++e) if (me == e) ps_me = pstart[e];
    const int slot = ps_me + pre_me + before_w + rank_in_wave;
    tok_slot[ai] = slot; slots[F.tid] = slot;
    if (F.bid == 0 && F.tid < 8) cnt_out[F.tid] = (unsigned)tot[F.tid];
    __syncthreads();
    for (int a = F.wave; a < 512; a += NWAVES) { const int t = F.bid * 256 + (a >> 1); const u32x4* s = (const u32x4*)(H + (size_t)t * D); u32x4* d = (u32x4*)(HS + (size_t)slots[a] * D);
#pragma unroll
        for (int j = 0; j < 4; ++j) d[F.lane + 64 * j] = s[F.lane + 64 * j]; }
    if (F.bid < 8) {
        int lo = 0, hi = 0;
#pragma unroll
        for (int e = 0; e < 8; ++e) if (F.bid == e) { lo = pstart[e] + tot[e]; hi = pstart[e] + (tot[e] + 255) / 256 * 256; }
        for (int rr = lo + F.wave; rr < hi; rr += NWAVES) { u32x4* d = (u32x4*)(HS + (size_t)rr * D);
#pragma unroll
            for (int j = 0; j < 4; ++j) d[F.lane + 64 * j] = (u32x4){0u, 0u, 0u, 0u}; } }
}
__device__ __forceinline__ void ph_final(const Ctx& F, const float* XR, const float* Y2, const int* tok_slot, const float* tok_w, const float* modl, const float* fg, float* out) {
    for (int row = F.bid * NWAVES + F.wave; row < NL; row += F.nb * NWAVES) {
        const f32x4* xr = (const f32x4*)(XR + (size_t)row * D) + F.lane;
        const f32x4* y0 = (const f32x4*)(Y2 + (size_t)tok_slot[row * 2] * D) + F.lane; const f32x4* y1 = (const f32x4*)(Y2 + (size_t)tok_slot[row * 2 + 1] * D) + F.lane;
        const float w0 = tok_w[row * 2], w1 = tok_w[row * 2 + 1];
        const float* g2 = modl + (size_t)batch_of(row) * MOD_W + 5 * D;
        f32x4 v[8]; float ss = 0.f;
#pragma unroll
        for (int j = 0; j < 8; ++j) { const f32x4 gg = *(const f32x4*)(g2 + 4 * F.lane + 256 * j); v[j] = xr[64 * j] + gg * (w0 * y0[64 * j] + w1 * y1[64 * j]);
            ss += v[j][0] * v[j][0] + v[j][1] * v[j][1] + v[j][2] * v[j][2] + v[j][3] * v[j][3]; }
        ss = wave_sum(ss);
        const float rs = rsqrtf(ss * (1.f / D) + EPS);
#pragma unroll
        for (int j = 0; j < 8; ++j) { const f32x4 gg = *(const f32x4*)(fg + 4 * F.lane + 256 * j); ((f32x4*)(out + (size_t)row * D))[F.lane + 64 * j] = v[j] * rs * gg; }
    }
}

constexpr int PH_PER_LAYER = 12, PH_FINAL = 2 + 2 * PH_PER_LAYER, N_PHASES = PH_FINAL + 1;
__global__ void __launch_bounds__(NTHR, 2) mega(Params p) {
    extern __shared__ __attribute__((aligned(16))) unsigned char lds_raw[];
    LAS unsigned char* lds = (LAS unsigned char*)lds_raw;
    volatile LAS unsigned* MISC = (volatile LAS unsigned*)(lds + MISC_OFF);
    Ctx F; F.lds = lds; F.tid = threadIdx.x; F.lane = F.tid & 63; F.wave = __builtin_amdgcn_readfirstlane(F.tid >> 6); F.bid = blockIdx.x; F.nb = gridDim.x;
#define FRESH() do { int t_ = threadIdx.x; asm volatile("" : "+v"(t_)); F.tid = t_; F.lane = t_ & 63; F.wave = __builtin_amdgcn_readfirstlane(t_ >> 6); \
        int b_ = blockIdx.x; asm volatile("" : "+s"(b_)); F.bid = b_; unsigned long long w_ = (unsigned long long)ws; asm volatile("" : "+s"(w_)); ws = (unsigned char*)(GAS unsigned char*)w_; } while (0)
    unsigned char* ws = (unsigned char*)(GAS unsigned char*)p.ws;
    for (int u = F.tid; u < (LDS_BYTES - RING_BYTES) / 4; u += NTHR) ((LAS unsigned*)(lds + RING_BYTES))[u] = 0u;
    __syncthreads();
    XcdBarrier bar; bar.bar = (unsigned*)(ws + WS_CTL) + CW_BAR; bar.x = 0; bar.st = nullptr;
    if (!MK_SPLIT) bar = xcd_barrier_post((unsigned*)(ws + WS_CTL) + CW_BAR, MISC + 8);
    const int lo = p.ph_lo, hi = p.ph_hi;
#define GIN(k) ((const float*)(const GAS float*)p.in[k])
    LAS pg8::UnitRec* UTAB = (LAS pg8::UnitRec*)(lds + UTAB_OFF); LAS int* NCELL = (LAS int*)(lds + MISC_OFF + 64);
#ifndef PH_MASK
#define PH_MASK 0xffffffffu
#endif
#define IN(k) (((PH_MASK >> (((k) - 2) % PH_PER_LAYER + 2 < 2 ? (k) : (((k) < 2) ? (k) : (((k) == PH_FINAL) ? 14 : ((k) - 2) % PH_PER_LAYER + 2)))) & 1u) && lo <= (k) && (k) < hi)
#define SEAM(k) do { if (IN(k) && IN((k) + 1)) xcd_barrier(bar); FRESH(); } while (0)
#define MODP ((float*)(ws + WS_MODP))
#define MOD ((float*)(ws + WS_MOD))
#define XR ((float*)(ws + WS_XR))
#define H ((bf16_t*)(ws + WS_H))
#define HS ((bf16_t*)(ws + WS_HS))
#define P ((bf16_t*)(ws + WS_P))
#define Y2 ((float*)(ws + WS_P))
#define ABF ((float*)(ws + WS_ABF))
#define LG ((float*)(ws + WS_LG))
#define OG ((float*)(ws + WS_OG))
#define AO ((bf16_t*)(ws + WS_AO))
#define BO ((bf16_t*)(ws + WS_BO))
#define CO ((bf16_t*)(ws + WS_CO))
#define MG ((bf16_t*)(ws + WS_MG))
#define ACT ((bf16_t*)(ws + WS_ACT))
#define VT ((bf16_t*)(ws + WS_VT))
#define QT ((bf16_t*)(ws + WS_QT))
#define KVB ((bf16_t*)(ws + WS_KV))
#define DEC ((float*)(ws + WS_DEC))
#define tok_e ((int*)(ws + WS_RT))
#define tok_w ((float*)(ws + WS_RT + (size_t)NL * 2 * 4))
#define tok_slot ((int*)(ws + WS_RT + (size_t)NL * 2 * 8))
#define ctl ((unsigned*)(ws + WS_CTL))

    if (IN(0)) { ph_mod_partial(F, GIN(1), GIN(3), GIN(4), MODP); ph_copy_x(F, GIN(0), GIN(2), XR); }
    SEAM(0);
    if (IN(1)) { ph_mod_reduce(F, MODP, GIN(5), MOD); ph_convert(F, p); }
    SEAM(1);
    for (int layer = 0; layer < 2; ++layer) {
        const int pb = 2 + layer * PH_PER_LAYER;
        const bool last = layer == 1;
        const float* modl = MOD + (size_t)layer * 5 * MOD_W;
        const int MR = last ? NL : NR;
        if (IN(pb + 0)) ph_norm<false>(F, XR, GIN(6) + layer * D, modl, 0, D, H, NR, nullptr, nullptr, nullptr, nullptr);
        SEAM(pb + 0);
        if (IN(pb + 1)) {
            pg8::InprojOrder So{(const char*)H, (const char*)((bf16_t*)(ws + WS_WIN) + (size_t)layer * NIN * D), last ? 32 : 36, last ? 4 : 0, F.nb, F.bid, (size_t)256 * D * 2};
            pg8::EpiInproj E{P, ABF};
            { const int nu = pg8::fill_table(So, UTAB, NCELL); const pg8::TableOrder T{UTAB, nu}; pg8::gemm_phase(lds, D, T, E); }
        }
        SEAM(pb + 1);
        if (IN(pb + 2)) { ph_vt(F, P, VT); FRESH(); }
        if (IN(pb + 2)) ph_prep(F, P, ABF, GIN(13) + layer * 128, GIN(14) + layer * 128, GIN(10) + (size_t)layer * 2 * 16 * 512, GIN(11) + layer * 2 * 512, LG);
        SEAM(pb + 2);
        if (IN(pb + 3)) {
#ifndef ATTN_SEL
#define ATTN_SEL 7
#endif
            if (ATTN_SEL & 1) { ph_gqa(F, P, VT, CO, !last); FRESH(); }
            if (ATTN_SEL & 2) { ph_na(F, P, VT, GIN(9) + (size_t)layer * 16 * 15 * 31, AO, !last); FRESH(); }
            if (ATTN_SEL & 4) ph_gla_a(F, P, VT, LG, OG, QT, KVB, DEC);
        }
        SEAM(pb + 3);
        if (IN(pb + 4)) ph_gla_scan(F, KVB, DEC);
        SEAM(pb + 4);
        if (IN(pb + 5)) ph_gla_c(F, P, OG, QT, KVB, GIN(12) + layer * 256, BO, !last);
        SEAM(pb + 5);
        if (IN(pb + 6)) {
            const bf16_t* wp = (const bf16_t*)(ws + WS_WP) + (size_t)layer * 3 * D * 1024;
            pg8::MergeOrder So{(const char*)AO, (size_t)(WS_BO - WS_AO), (const char*)wp, (size_t)D * 1024 * 2, MR / 256, F.nb, F.bid};
            static_assert(WS_CO - WS_BO == WS_BO - WS_AO, "branch outputs equally spaced");
            pg8::EpiMerge E{P, MG};
            { const int nu = pg8::fill_table(So, UTAB, NCELL); const pg8::TableOrder T{UTAB, nu}; pg8::gemm_phase(lds, 1024, T, E); }
        }
        SEAM(pb + 6);
        if (IN(pb + 7)) {
            pg8::PlainOrder So{(const char*)MG, (const char*)((bf16_t*)(ws + WS_WOUT) + (size_t)layer * D * D), MR / 256, 8, F.nb, F.bid, (size_t)256 * D * 2};
            pg8::EpiResid E{XR, modl, 2 * D};
            { const int nu = pg8::fill_table(So, UTAB, NCELL); const pg8::TableOrder T{UTAB, nu}; pg8::gemm_phase(lds, D, T, E); }
        }
        SEAM(pb + 7);
        if (IN(pb + 8)) {
            if (!last) ph_norm<false>(F, XR, GIN(7) + layer * D, modl, 3 * D, 4 * D, H, MR, nullptr, nullptr, nullptr, nullptr);
            else ph_norm<true>(F, XR, GIN(7) + layer * D, modl, 3 * D, 4 * D, H, MR, GIN(22), GIN(23), tok_e, tok_w);
        }
        SEAM(pb + 8);
        if (IN(pb + 9)) { if (last) ph_moe_sort(F, tok_e, tok_slot, H, HS, ctl + CW_CNT); }
        SEAM(pb + 9);
        if (!last) {
            if (IN(pb + 10)) {
                pg8::PlainOrder So{(const char*)H, (const char*)(ws + WS_DGU), MR / 256, 44, F.nb, F.bid, (size_t)256 * D * 2};
                pg8::EpiSwiglu E{ACT};
                { const int nu = pg8::fill_table(So, UTAB, NCELL); const pg8::TableOrder T{UTAB, nu}; pg8::gemm_phase(lds, D, T, E); }
            }
            SEAM(pb + 10);
            if (IN(pb + 11)) {
                pg8::PlainOrder So{(const char*)ACT, (const char*)(ws + WS_DDN), MR / 256, 8, F.nb, F.bid, (size_t)256 * DFF * 2};
                pg8::EpiResid E{XR, modl, 5 * D};
                { const int nu = pg8::fill_table(So, UTAB, NCELL); const pg8::TableOrder T{UTAB, nu}; pg8::gemm_phase(lds, DFF, T, E); }
            }
            SEAM(pb + 11);
        } else {
            if (IN(pb + 10)) {
                pg8::MoeOrder So{(const char*)HS, (const char*)(ws + WS_MGU), 44, F.nb, F.bid, (size_t)256 * D * 2, (size_t)2 * DFF * D * 2, ctl + CW_CNT};
                pg8::EpiSwiglu E{ACT};
                { const int nu = pg8::fill_table(So, UTAB, NCELL); const pg8::TableOrder T{UTAB, nu}; pg8::gemm_phase(lds, D, T, E); }
            }
            SEAM(pb + 10);
            if (IN(pb + 11)) {
                pg8::MoeOrder So{(const char*)ACT, (const char*)(ws + WS_MDN), 8, F.nb, F.bid, (size_t)256 * DFF * 2, (size_t)D * DFF * 2, ctl + CW_CNT};
                pg8::EpiStoreF32 E{Y2};
                { const int nu = pg8::fill_table(So, UTAB, NCELL); const pg8::TableOrder T{UTAB, nu}; pg8::gemm_phase(lds, DFF, T, E); }
            }
            SEAM(pb + 11);
        }
    }
    if (IN(PH_FINAL)) ph_final(F, XR, Y2, tok_slot, tok_w, MOD + (size_t)5 * MOD_W, GIN(27), (float*)(GAS float*)p.out);
#undef IN
#undef SEAM
#undef MODP
#undef MOD
#undef XR
#undef H
#undef HS
#undef P
#undef Y2
#undef ABF
#undef LG
#undef OG
#undef AO
#undef BO
#undef CO
#undef MG
#undef ACT
#undef VT
#undef QT
#undef KVB
#undef DEC
#undef tok_e
#undef tok_w
#undef tok_slot
#undef ctl
}

extern "C" void kernel_launch(void* const* d_in, const int* in_sizes, int n_in, void* d_out, int out_size, void* d_ws, size_t ws_size, hipStream_t stream) {
    static int grid = 0;
    if (grid == 0) {
        if (n_in != 28 || ws_size < WS_END) { fprintf(stderr, "kernel_launch: need 28 inputs and %zu bytes of workspace (got %d, %zu)\n", (size_t)WS_END, n_in, ws_size); grid = -1; return; }
        int dev = 0, cus = 0, per_cu = 0;
        if (hipGetDevice(&dev) != hipSuccess || hipDeviceGetAttribute(&cus, hipDeviceAttributeMultiprocessorCount, dev) != hipSuccess) { grid = -1; return; }
        if (hipFuncSetAttribute((const void*)mega, hipFuncAttributeMaxDynamicSharedMemorySize, LDS_BYTES) != hipSuccess) { fprintf(stderr, "kernel_launch: hipFuncSetAttribute failed\n"); grid = -1; return; }
        if (hipOccupancyMaxActiveBlocksPerMultiprocessor(&per_cu, (const void*)mega, NTHR, LDS_BYTES) != hipSuccess || per_cu < 1) { fprintf(stderr, "kernel_launch: occupancy query says %d\n", per_cu); }
        (void)hipGetLastError();
        grid = cus;
    }
    if (grid < 0) return;
    (void)hipMemsetAsync((char*)d_ws + WS_CTL, 0, CTL_BYTES, stream);
    Params p{};
    for (int i = 0; i < 28; ++i) p.in[i] = (const float*)d_in[i];
    p.out = (float*)d_out; p.ws = (unsigned char*)d_ws;
#if MK_SPLIT
    for (int k = 0; k < N_PHASES; ++k) { p.ph_lo = k; p.ph_hi = k + 1; hipLaunchKernelGGL(mega, dim3(grid), dim3(NTHR), LDS_BYTES, stream, p); }
#else
    p.ph_lo = 0; p.ph_hi = N_PHASES;
    hipLaunchKernelGGL(mega, dim3(grid), dim3(NTHR), LDS_BYTES, stream, p);
#endif
}
```

```cpp
#include <hip/hip_runtime.h>
#include <cstdio>
#include <cstdint>

#ifndef MK_SPLIT
#define MK_SPLIT 0
#endif

constexpr int D = 2048, NB = 4, S = 2048, LC = 256, NL = NB * S, NC = NB * LC, NR = NL + NC;
constexpr int DIN = 13856, DFF = 5632, NE = 8, GW = 64;
constexpr int S_AF = 6144;
constexpr int PW = 13824;
constexpr int O_NAQ = 0, O_NAK = 1024, O_NAV = 2048, O_GLQ = 3072, O_GLK = 3584, O_GLV = 4096, O_GLOG = 5120,
              O_GQQ = 6144, O_GQK = 7168, O_GQV = 7424, O_GA = 7680, O_GB = 9728, O_GC = 11776;
constexpr int NIN = 14080;
constexpr int MOD_W = 6 * D;
constexpr int NSLOT = 18432;
constexpr float EPS = 1e-6f;
constexpr float LOG2E = 1.4426950408889634f;
constexpr int NWAVES = 8, NTHR = 512;

#define GAS __attribute__((address_space(1)))
#define LAS __attribute__((address_space(3)))
typedef unsigned short bf16_t;
typedef short bf16x8 __attribute__((ext_vector_type(8)));
typedef float f32x4 __attribute__((ext_vector_type(4)));
typedef unsigned u32x4 __attribute__((ext_vector_type(4)));
typedef unsigned u32x2 __attribute__((ext_vector_type(2)));

__device__ __forceinline__ int batch_of(int r) { return r < NL ? (r >> 11) : 4; }
__device__ __forceinline__ float bf2f(bf16_t v) { return __uint_as_float((unsigned)v << 16); }
__device__ __forceinline__ unsigned f2bf(float f) { unsigned u = __float_as_uint(f); return (u + 0x7fffu + ((u >> 16) & 1u)) >> 16; }
__device__ __forceinline__ unsigned pk2(float lo, float hi) { return f2bf(lo) | (f2bf(hi) << 16); }
__device__ __forceinline__ unsigned cvt_pk_bf16(float lo, float hi) { unsigned r; asm volatile("v_cvt_pk_bf16_f32 %0, %1, %2" : "=v"(r) : "v"(lo), "v"(hi)); return r; }
__device__ __forceinline__ float sigmoidf_(float x) { return 1.f / (1.f + expf(-x)); }
__device__ __forceinline__ float siluf_(float x) { return x / (1.f + expf(-x)); }
__device__ __forceinline__ float fast_sigmoid(float x) { return __builtin_amdgcn_rcpf(1.f + __builtin_amdgcn_exp2f(-1.4426950408889634f * x)); }
__device__ __forceinline__ float wave_sum(float v) {
#pragma unroll
    for (int o = 1; o < 64; o <<= 1) v += __shfl_xor(v, o);
    return v;
}
__device__ __forceinline__ float wave_max(float v) {
#pragma unroll
    for (int o = 1; o < 64; o <<= 1) v = fmaxf(v, __shfl_xor(v, o));
    return v;
}

#define XB_TMO      128
#define XB_XCNT(j)  (256  + 64 * (j))
#define XB_XSUB(j)  (1280 + 64 * (j))
#define XB_XGEN(j)  (2304 + 64 * (j))
#define XB_TOP      3328
#define XB_TOPGEN   3392
#define XCD_BAR_WORDS 3456
#define XB_SPIN_CAP (1u << 18)
__device__ __forceinline__ unsigned xb_ld(unsigned* p)              { return __hip_atomic_load(p, __ATOMIC_RELAXED, __HIP_MEMORY_SCOPE_AGENT); }
__device__ __forceinline__ unsigned xb_add(unsigned* p, unsigned v) { return __hip_atomic_fetch_add(p, v, __ATOMIC_RELAXED, __HIP_MEMORY_SCOPE_AGENT); }
__device__ __forceinline__ unsigned xb_xcc_id() { return (unsigned)__builtin_amdgcn_s_getreg((3 << 11) | 20) & 0xFu; }
#define XB_SPIN(cond, bar) do { unsigned _sp = 0; while (cond) { __builtin_amdgcn_s_sleep(1); \
    if ((++_sp & 255u) == 0u) { if (xb_ld(&(bar)[XB_TMO])) break; if (_sp > XB_SPIN_CAP) { atomicAdd(&(bar)[XB_TMO], 1u); break; } } } } while (0)
struct XcdBarrier { unsigned* bar; unsigned x; volatile LAS unsigned* st; };
__device__ __forceinline__ XcdBarrier xcd_barrier_post(unsigned* bar, volatile LAS unsigned* st) {
    XcdBarrier b; b.bar = bar; b.x = xb_xcc_id(); b.st = st;
    if (threadIdx.x == 0) (void)xb_add(&bar[XB_XCNT(b.x)], 1u);
    return b;
}
__device__ __forceinline__ void xcd_barrier_complete(unsigned* bar, unsigned x, unsigned& nloc, unsigned& nx) {
    const unsigned G = gridDim.x * gridDim.y * gridDim.z;
    unsigned sum, cnt, mine, sp = 0u;
    asm volatile("" : "+s"(x));
    { unsigned long long bb = (unsigned long long)bar; asm volatile("" : "+s"(bb)); bar = (unsigned*)(GAS unsigned*)bb; }
    for (;;) {
        sum = 0u; cnt = 0u; mine = 0u;
#pragma unroll
        for (unsigned j = 0; j < 16; ++j) { const unsigned c = xb_ld(&bar[XB_XCNT(j)]); sum += c; cnt += (c > 0u) ? 1u : 0u; mine = (j == x) ? c : mine; }
        if (sum == G) break;
        __builtin_amdgcn_s_sleep(1);
        if ((++sp & 255u) == 0u) { if (xb_ld(&bar[XB_TMO])) break; if (sp > XB_SPIN_CAP) { atomicAdd(&bar[XB_TMO], 1u); break; } }
    }
    nloc = mine > 0u ? mine : 1u; nx = cnt > 0u ? cnt : 1u;
}
__device__ __forceinline__ void xcd_barrier(const XcdBarrier& b) {
    asm volatile("s_waitcnt vmcnt(0)" ::: "memory");
    __syncthreads();
    if (threadIdx.x == 0) {
        unsigned* bar = b.bar;
        __builtin_amdgcn_s_waitcnt(0);
        unsigned nloc = b.st[0], nx = b.st[1];
        if (nloc == 0u) { xcd_barrier_complete(bar, b.x, nloc, nx); b.st[0] = nloc; b.st[1] = nx; }
        const unsigned old = xb_add(&bar[XB_XSUB(b.x)], 1u);
        const unsigned gen = old / nloc;
        if (old + 1u == (gen + 1u) * nloc) {
            __builtin_amdgcn_fence(__ATOMIC_RELEASE, "agent");
            asm volatile("s_waitcnt vmcnt(0)" ::: "memory");
            const unsigned og = xb_add(&bar[XB_TOP], 1u);
            const unsigned tg = og / nx;
            if (og + 1u == (tg + 1u) * nx) xb_add(&bar[XB_TOPGEN], 1u);
            else XB_SPIN(xb_ld(&bar[XB_TOPGEN]) == tg, bar);
            __builtin_amdgcn_fence(__ATOMIC_ACQUIRE, "agent");
            xb_add(&bar[XB_XGEN(b.x)], 1u);
            asm volatile("s_waitcnt vmcnt(0)" ::: "memory");
        } else {
            XB_SPIN(xb_ld(&bar[XB_XGEN(b.x)]) == gen, bar);
            __builtin_amdgcn_fence(__ATOMIC_ACQUIRE, "agent");
            asm volatile("s_waitcnt vmcnt(0)" ::: "memory");
        }
    }
    __syncthreads();
}

namespace pg8 {
constexpr int BM = 256, BK = 64, HALF = 128, HTB = HALF * BK * 2, STAGE_BYTES = 8 * HTB, NXCD = 8, WGM = 8;
__host__ __device__ __forceinline__ int lds_byte(int r, int c) { const int st = (r >> 4) * 2 + (c >> 5), rr = r & 15, cc = c & 31, ob = rr * 64 + cc * 2; return st * 1024 + (ob ^ (((ob >> 9) & 1) << 5)); }
__host__ __device__ __forceinline__ void stage_rc(int b, int& R, int& C) { const int st = b / 1024, sb = b % 1024, swz = sb ^ (((sb >> 9) & 1) << 5); R = (st >> 1) * 16 + swz / 64; C = (st & 1) * 32 + (swz % 64) / 2; }
__host__ __device__ __forceinline__ int perm32(int rho) { const int n = rho >> 4, i = rho & 15; return 8 * (i >> 2) + 4 * n + (i & 3); }

struct Unit { const char* a; const char* b; int pm, pn, sub, aux; };

__device__ __forceinline__ void tile_of(int wgid, int nM, int nN, int& pm, int& pn) {
    const int nwg = nM * nN; { const int q = nwg / NXCD, r = nwg % NXCD, xcd = wgid % NXCD, off = wgid / NXCD; wgid = (xcd < r ? xcd * (q + 1) : r * (q + 1) + (xcd - r) * q) + off; }
    const int nig = WGM * nN, gid = wgid / nig, fm = gid * WGM, gsz = (nM - fm) < WGM ? (nM - fm) : WGM;
    pm = fm + ((wgid % nig) % gsz); pn = (wgid % nig) / gsz;
}

struct UnitRec { unsigned a_lo, a_hi, b_lo, b_hi; int pm, pn, sub, aux; };
struct TableOrder {
    const LAS UnitRec* tab; int n;
    __device__ __forceinline__ bool next(int i, Unit& u) const {
        if (i >= n) return false;
        const LAS unsigned* r = (const LAS unsigned*)(tab + i);
        const unsigned alo = __builtin_amdgcn_readfirstlane(r[0]), ahi = __builtin_amdgcn_readfirstlane(r[1]), blo = __builtin_amdgcn_readfirstlane(r[2]), bhi = __builtin_amdgcn_readfirstlane(r[3]);
        u.a = (const char*)(((unsigned long long)ahi << 32) | alo); u.b = (const char*)(((unsigned long long)bhi << 32) | blo);
        u.pm = __builtin_amdgcn_readfirstlane(r[4]); u.pn = __builtin_amdgcn_readfirstlane(r[5]); u.sub = __builtin_amdgcn_readfirstlane(r[6]); u.aux = __builtin_amdgcn_readfirstlane(r[7]);
        return true;
    }
};
template <class Epi, class Sched>
__device__ __forceinline__ void gemm_phase(LAS unsigned char* lds, const int K, const int ld, const Sched& S, const Epi& E) {
    int tid = threadIdx.x; asm volatile("" : "+v"(tid));
    const int wid = __builtin_amdgcn_readfirstlane(tid >> 6), lane = tid & 63, wr = wid >> 2, wc = wid & 3, fr = lane & 15, fq = lane >> 4;
    const int nt = K / BK;
    unsigned voffA[2], voffB[2];
#pragma unroll
    for (int i = 0; i < 2; ++i) { int R, C; stage_rc(tid * 16 + i * 8192, R, C); const int Rb = Epi::PERM ? ((R & ~31) + perm32(R & 31)) : R;
        voffA[i] = (unsigned)(R * ld + C) * 2u; voffB[i] = (unsigned)(Rb * ld + C) * 2u; }
    const size_t kstep = (size_t)(BK * 2);
    const size_t hstep = (size_t)HALF * ld * 2;
    const unsigned ldsw = (unsigned)wid * 1024u;
    const int aoff = lds_byte(wr * 64 + fr, fq * 8), boff = lds_byte(wc * 32 + fr, fq * 8);
#define PG8_SA(b, h) (((b) * 2 + (h)) * HTB)
#define PG8_SB(b, h) ((4 + (b) * 2 + (h)) * HTB)
#define PG8_STAGE(bufoff, gbase, voff) do { _Pragma("unroll") for (int _i = 0; _i < 2; ++_i) \
        __builtin_amdgcn_global_load_lds((const unsigned*)((const char*)(gbase) + (voff)[_i]), (LAS unsigned*)(lds + (bufoff) + ldsw + _i * 8192), 16, 0, 0); } while (0)
#define PG8_LDA(dst, b, h) do { _Pragma("unroll") for (int m = 0; m < 4; ++m) _Pragma("unroll") for (int k = 0; k < 2; ++k) dst[m][k] = *(const LAS bf16x8*)(lds + PG8_SA(b, h) + aoff + m * 2048 + k * 1024); } while (0)
#define PG8_LDB(dst, b, h) do { _Pragma("unroll") for (int n = 0; n < 2; ++n) _Pragma("unroll") for (int k = 0; k < 2; ++k) dst[n][k] = *(const LAS bf16x8*)(lds + PG8_SB(b, h) + boff + n * 2048 + k * 1024); } while (0)
#define PG8_MMA(ai, bj, At, Bt) do { __builtin_amdgcn_s_setprio(1); _Pragma("unroll") for (int m = 0; m < 4; ++m) _Pragma("unroll") for (int n = 0; n < 2; ++n) _Pragma("unroll") for (int k = 0; k < 2; ++k) \
        acc[ai][bj][m][n] = __builtin_amdgcn_mfma_f32_16x16x32_bf16(Bt[n][k], At[m][k], acc[ai][bj][m][n], 0, 0, 0); __builtin_amdgcn_s_setprio(0); } while (0)
#define PG8_WAIT_V(n) asm volatile("s_waitcnt vmcnt(" #n ")" ::: "memory")
#define PG8_WAIT_L(n) asm volatile("s_waitcnt lgkmcnt(" #n ")" ::: "memory")
#define PG8_BAR __builtin_amdgcn_s_barrier()
#define PG8_SCHED __builtin_amdgcn_sched_barrier(0)
    Unit cur, nxt; int ui = 0;
    if (!S.next(0, cur)) return;
    f32x4 acc[2][2][4][2];
#pragma unroll
    for (int a = 0; a < 2; ++a)
#pragma unroll
        for (int b = 0; b < 2; ++b)
#pragma unroll
            for (int m = 0; m < 4; ++m)
#pragma unroll
                for (int n = 0; n < 2; ++n) acc[a][b][m][n] = (f32x4){0.f, 0.f, 0.f, 0.f};
    bf16x8 At[4][2], B0[2][2], B1[2][2];
    const char* cA = cur.a; const char* cB = cur.b;
    PG8_STAGE(PG8_SB(0, 0), cB, voffB); PG8_STAGE(PG8_SB(0, 1), cB + hstep, voffB); PG8_STAGE(PG8_SA(0, 0), cA, voffA); PG8_STAGE(PG8_SA(0, 1), cA + hstep, voffA);
    if (wr == 1) PG8_BAR;
    PG8_WAIT_V(2); PG8_BAR;
    PG8_STAGE(PG8_SB(1, 0), cB + kstep, voffB); PG8_STAGE(PG8_SA(1, 0), cA + kstep, voffA); PG8_STAGE(PG8_SB(1, 1), cB + hstep + kstep, voffB);
    PG8_WAIT_V(6); PG8_BAR;
    for (;;) {
        const bool has_next = S.next(ui + 1, nxt);
        const char* nA = has_next ? nxt.a : cA; const char* nB = has_next ? nxt.b : cB;
        for (int t = 0; t < nt; t += 2) {
            const bool last = (t == nt - 2);
            const char* a1 = cA + (size_t)(t + 1) * kstep;
            const char* a2 = last ? nA : cA + (size_t)(t + 2) * kstep; const char* b2 = last ? nB : cB + (size_t)(t + 2) * kstep;
            const char* a3 = a2 + kstep; const char* b3 = b2 + kstep;
            PG8_LDB(B0, 0, 0); PG8_LDB(B1, 0, 1); PG8_SCHED; PG8_LDA(At, 0, 0); PG8_STAGE(PG8_SA(1, 1), a1 + hstep, voffA);
            PG8_WAIT_V(8); PG8_WAIT_L(0); PG8_BAR; PG8_MMA(0, 0, At, B0); PG8_MMA(0, 1, At, B1); PG8_BAR; PG8_SCHED;
            PG8_LDA(At, 0, 1); PG8_STAGE(PG8_SB(0, 0), b2, voffB); PG8_STAGE(PG8_SB(0, 1), b2 + hstep, voffB); PG8_STAGE(PG8_SA(0, 0), a2, voffA);
            PG8_WAIT_V(8); PG8_WAIT_L(0); PG8_BAR; PG8_MMA(1, 0, At, B0); PG8_MMA(1, 1, At, B1); PG8_BAR; PG8_SCHED;
            PG8_LDB(B0, 1, 0); PG8_LDB(B1, 1, 1); PG8_SCHED; PG8_LDA(At, 1, 0); PG8_STAGE(PG8_SA(0, 1), a2 + hstep, voffA);
            PG8_WAIT_V(8); PG8_WAIT_L(0); PG8_BAR; PG8_MMA(0, 0, At, B0); PG8_MMA(0, 1, At, B1); PG8_BAR; PG8_SCHED;
            PG8_LDA(At, 1, 1); PG8_STAGE(PG8_SB(1, 0), b3, voffB); PG8_STAGE(PG8_SB(1, 1), b3 + hstep, voffB); PG8_STAGE(PG8_SA(1, 0), a3, voffA);
            PG8_WAIT_V(8); PG8_WAIT_L(0); PG8_BAR; PG8_MMA(1, 0, At, B0); PG8_MMA(1, 1, At, B1); PG8_BAR; PG8_SCHED;
        }
        if (wr == 0) PG8_BAR;
        E(acc, cur, wr, wc, fr, fq);
        if (!has_next) break;
        cur = nxt; cA = nA; cB = nB; ++ui;
        if (wr == 1) PG8_BAR;
    }
    PG8_WAIT_V(0);
    PG8_BAR;
#undef PG8_SA
#undef PG8_SB
#undef PG8_STAGE
#undef PG8_LDA
#undef PG8_LDB
#undef PG8_MMA
#undef PG8_WAIT_V
#undef PG8_WAIT_L
#undef PG8_BAR
#undef PG8_SCHED
}
#define ACC_T f32x4 (&acc)[2][2][4][2]
#define ZERO_ACC() do { _Pragma("unroll") for (int a_ = 0; a_ < 2; ++a_) _Pragma("unroll") for (int b_ = 0; b_ < 2; ++b_) _Pragma("unroll") for (int m_ = 0; m_ < 4; ++m_) \
    _Pragma("unroll") for (int n_ = 0; n_ < 2; ++n_) acc[a_][b_][m_][n_] = (f32x4){0.f, 0.f, 0.f, 0.f}; } while (0)

struct EpiInproj {
    static constexpr bool PERM = true;
    bf16_t* P; float* ABF;
    __device__ __forceinline__ void operator()(ACC_T, const Unit& u, int wr, int wc, int fr, int fq) const {
        const int row0 = u.pm * BM + wr * 64 + fr;
        if (u.pn < 54) {
            const bool gate = u.pn >= 30;
#pragma unroll
            for (int ai = 0; ai < 2; ++ai)
#pragma unroll
                for (int m = 0; m < 4; ++m) { bf16_t* rowp = P + (size_t)(row0 + ai * HALF + m * 16) * PW + u.pn * BM + wc * 32 + 8 * fq;
#pragma unroll
                    for (int bj = 0; bj < 2; ++bj) { f32x4 v0 = acc[ai][bj][m][0], v1 = acc[ai][bj][m][1];
                        if (gate) {
#pragma unroll
                            for (int j = 0; j < 4; ++j) { v0[j] = fast_sigmoid(v0[j]); v1[j] = fast_sigmoid(v1[j]); } }
                        u32x4 w; w.x = cvt_pk_bf16(v0[0], v0[1]); w.y = cvt_pk_bf16(v0[2], v0[3]); w.z = cvt_pk_bf16(v1[0], v1[1]); w.w = cvt_pk_bf16(v1[2], v1[3]);
                        *(u32x4*)(rowp + bj * HALF) = w; } }
        } else if (wc == 0) {
#pragma unroll
            for (int ai = 0; ai < 2; ++ai)
#pragma unroll
                for (int m = 0; m < 4; ++m) { float* rp = ABF + (size_t)(row0 + ai * HALF + m * 16) * 32 + 8 * fq;
                    *(f32x4*)rp = acc[ai][0][m][0]; *(f32x4*)(rp + 4) = acc[ai][0][m][1]; }
        }
        ZERO_ACC();
    }
};
struct EpiMerge {
    static constexpr bool PERM = true;
    const bf16_t* P; bf16_t* MG;
    __device__ __forceinline__ void operator()(ACC_T, const Unit& u, int wr, int wc, int fr, int fq) const {
        const int row0 = u.pm * BM + wr * 64 + fr, col0 = u.pn * BM + wc * 32 + 8 * fq;
        const int gcur = u.sub == 0 ? O_GA : (u.sub == 1 ? O_GB : O_GC), gnext = u.sub == 0 ? O_GB : O_GC;
#pragma unroll
        for (int ai = 0; ai < 2; ++ai)
#pragma unroll
            for (int m = 0; m < 4; ++m) { const size_t r = (size_t)(row0 + ai * HALF + m * 16);
#pragma unroll
                for (int bj = 0; bj < 2; ++bj) {
                    const u32x4 gc = *(const u32x4*)(P + r * PW + gcur + col0 + bj * HALF);
                    float sc[8]; sc[0] = __uint_as_float(gc.x << 16); sc[1] = __uint_as_float(gc.x & 0xffff0000u); sc[2] = __uint_as_float(gc.y << 16); sc[3] = __uint_as_float(gc.y & 0xffff0000u);
                    sc[4] = __uint_as_float(gc.z << 16); sc[5] = __uint_as_float(gc.z & 0xffff0000u); sc[6] = __uint_as_float(gc.w << 16); sc[7] = __uint_as_float(gc.w & 0xffff0000u);
#pragma unroll
                    for (int j = 0; j < 8; ++j) sc[j] = fmaxf(sc[j], 1e-20f);
                    if (u.sub < 2) {
                        const u32x4 gn = *(const u32x4*)(P + r * PW + gnext + col0 + bj * HALF);
                        float sn[8]; sn[0] = __uint_as_float(gn.x << 16); sn[1] = __uint_as_float(gn.x & 0xffff0000u); sn[2] = __uint_as_float(gn.y << 16); sn[3] = __uint_as_float(gn.y & 0xffff0000u);
                        sn[4] = __uint_as_float(gn.z << 16); sn[5] = __uint_as_float(gn.z & 0xffff0000u); sn[6] = __uint_as_float(gn.w << 16); sn[7] = __uint_as_float(gn.w & 0xffff0000u);
#pragma unroll
                        for (int j = 0; j < 8; ++j) { const float f = sc[j] * __builtin_amdgcn_rcpf(fmaxf(sn[j], 1e-20f)); if (j < 4) acc[ai][bj][m][0][j] *= f; else acc[ai][bj][m][1][j - 4] *= f; }
                    } else {
                        f32x4 v0 = acc[ai][bj][m][0], v1 = acc[ai][bj][m][1];
#pragma unroll
                        for (int j = 0; j < 4; ++j) { v0[j] *= sc[j]; v1[j] *= sc[4 + j]; }
                        u32x4 w; w.x = cvt_pk_bf16(v0[0], v0[1]); w.y = cvt_pk_bf16(v0[2], v0[3]); w.z = cvt_pk_bf16(v1[0], v1[1]); w.w = cvt_pk_bf16(v1[2], v1[3]);
                        *(u32x4*)(MG + r * D + col0 + bj * HALF) = w;
                        acc[ai][bj][m][0] = (f32x4){0.f, 0.f, 0.f, 0.f}; acc[ai][bj][m][1] = (f32x4){0.f, 0.f, 0.f, 0.f};
                    } }
                asm volatile("" ::: "memory"); }
    }
};
struct EpiResid {
    static constexpr bool PERM = false;
    float* X; const float* modl; int goff; const float* xl; const float* xc;
    __device__ __forceinline__ void operator()(ACC_T, const Unit& u, int wr, int wc, int fr, int fq) const {
        const int row0 = u.pm * BM + wr * 64 + fr, col0 = u.pn * BM + wc * 32 + 4 * fq;
        const float* g = modl + (size_t)batch_of(u.pm * BM) * MOD_W + goff + col0;
        f32x4 gv[2][2];
#pragma unroll
        for (int bj = 0; bj < 2; ++bj)
#pragma unroll
            for (int n = 0; n < 2; ++n) gv[bj][n] = *(const f32x4*)(g + bj * HALF + n * 16);
#pragma unroll
        for (int ai = 0; ai < 2; ++ai)
#pragma unroll
            for (int m = 0; m < 4; ++m) { float* rowp = X + (size_t)(row0 + ai * HALF + m * 16) * D + col0;
#pragma unroll
                for (int bj = 0; bj < 2; ++bj)
#pragma unroll
                    for (int n = 0; n < 2; ++n) { f32x4* p = (f32x4*)(rowp + bj * HALF + n * 16); const int rr_ = row0 + ai * HALF + m * 16;
                        const f32x4* q_ = xl ? (const f32x4*)((rr_ < NL ? xl + (size_t)rr_ * D : xc + (size_t)(rr_ - NL) * D) + col0 + bj * HALF + n * 16) : (const f32x4*)p;
                        *p = *q_ + gv[bj][n] * acc[ai][bj][m][n]; } }
        ZERO_ACC();
    }
};
struct EpiSwiglu {
    static constexpr bool PERM = true;
    bf16_t* ACT;
    __device__ __forceinline__ void operator()(ACC_T, const Unit& u, int wr, int wc, int fr, int fq) const {
        const int row0 = u.pm * BM + wr * 64 + fr, col0 = u.pn * HALF + wc * 32 + 8 * fq;
#pragma unroll
        for (int ai = 0; ai < 2; ++ai)
#pragma unroll
            for (int m = 0; m < 4; ++m) { f32x4 o[2];
#pragma unroll
                for (int n = 0; n < 2; ++n)
#pragma unroll
                    for (int j = 0; j < 4; ++j) { const float gt = acc[ai][0][m][n][j]; o[n][j] = gt * fast_sigmoid(gt) * acc[ai][1][m][n][j]; }
                u32x4 w; w.x = cvt_pk_bf16(o[0][0], o[0][1]); w.y = cvt_pk_bf16(o[0][2], o[0][3]); w.z = cvt_pk_bf16(o[1][0], o[1][1]); w.w = cvt_pk_bf16(o[1][2], o[1][3]);
                *(u32x4*)(ACT + (size_t)(row0 + ai * HALF + m * 16) * DFF + col0) = w; }
        ZERO_ACC();
    }
};
struct EpiStoreF32 {
    static constexpr bool PERM = false;
    float* C;
    __device__ __forceinline__ void operator()(ACC_T, const Unit& u, int wr, int wc, int fr, int fq) const {
        const int row0 = u.pm * BM + wr * 64 + fr, col0 = u.pn * BM + wc * 32 + 4 * fq;
#pragma unroll
        for (int ai = 0; ai < 2; ++ai)
#pragma unroll
            for (int m = 0; m < 4; ++m) { float* rowp = C + (size_t)(row0 + ai * HALF + m * 16) * D + col0;
#pragma unroll
                for (int bj = 0; bj < 2; ++bj)
#pragma unroll
                    for (int n = 0; n < 2; ++n) *(f32x4*)(rowp + bj * HALF + n * 16) = acc[ai][bj][m][n]; }
        ZERO_ACC();
    }
};

struct EpiAtomicF32 {
    static constexpr bool PERM = false;
    float* C;
    __device__ __forceinline__ void operator()(ACC_T, const Unit& u, int wr, int wc, int fr, int fq) const {
        const int row0 = u.pm * BM + wr * 64 + fr, col0 = u.pn * BM + wc * 32 + 4 * fq;
#pragma unroll
        for (int ai = 0; ai < 2; ++ai)
#pragma unroll
            for (int m = 0; m < 4; ++m) { float* rowp = C + (size_t)(row0 + ai * HALF + m * 16) * D + col0;
#pragma unroll
                for (int bj = 0; bj < 2; ++bj)
#pragma unroll
                    for (int n = 0; n < 2; ++n)
#pragma unroll
                        for (int j = 0; j < 4; ++j) (void)__hip_atomic_fetch_add(rowp + bj * HALF + n * 16 + j, acc[ai][bj][m][n][j], __ATOMIC_RELAXED, __HIP_MEMORY_SCOPE_AGENT); }
        ZERO_ACC();
    }
};
struct PlainOrder {
    const char* A; const char* B; int nM, nN, G, c; size_t tstep;
    __device__ __forceinline__ bool next(int i, Unit& u) const {
        const int L = i * G + c; if (c >= G || L >= nM * nN) return false;
        tile_of(L, nM, nN, u.pm, u.pn); u.sub = 0; u.aux = 0; u.a = A + (size_t)u.pm * tstep; u.b = B + (size_t)u.pn * tstep; return true;
    }
};
struct InprojOrder {
    const char* A; const char* B; int nM1, nctx, G, c; size_t tstep;
    __device__ __forceinline__ bool next(int i, Unit& u) const {
        const int L = i * G + c, n1 = nM1 * 55; u.sub = 0; u.aux = 0;
        if (c >= G) return false;
        if (L < n1) tile_of(L, nM1, 55, u.pm, u.pn);
        else { const int r = L - n1; if (r >= nctx * 17) return false; const int j = r % 17; u.pm = 32 + r / 17;
            u.pn = j < 8 ? 4 + j : (j < 10 ? 14 + (j - 8) : (j < 14 ? 16 + (j - 10) : (j < 16 ? 28 + (j - 14) : 54))); }
        u.a = A + (size_t)u.pm * tstep; u.b = B + (size_t)u.pn * tstep; return true;
    }
};
struct MergeOrder {
    const char* A0; size_t sA; const char* B0; size_t sB; int nM, G, c;
    __device__ __forceinline__ bool next(int i, Unit& u) const {
        const int T = (i / 3) * G + c; if (c >= G || T >= nM * 8) return false;
        tile_of(T, nM, 8, u.pm, u.pn); u.sub = i % 3; u.aux = 0;
        const size_t ts = (size_t)256 * 1024 * 2;
        u.a = A0 + (size_t)u.sub * sA + (size_t)u.pm * ts; u.b = B0 + (size_t)u.sub * sB + (size_t)u.pn * ts; return true;
    }
};
struct MoeOrder {
    const char* A; const char* B; int nN, G, c; size_t tstep, estride; const unsigned* cnt; int full_only;
    __device__ __forceinline__ bool next(int i, Unit& u) const {
        int e = 0, acc = 0, nblk = 0; const int L = i * G + c; u.pn = L % nN; u.pm = L / nN; u.sub = 0;
#pragma unroll
        for (int j = 0; j < 8; ++j) { const int cj = (int)__hip_atomic_load(cnt + j, __ATOMIC_RELAXED, __HIP_MEMORY_SCOPE_AGENT); acc += (cj + 255) / 256; if (j < 7) e += (u.pm >= acc) ? 1 : 0; }
        nblk = acc < 72 ? acc : 72;
        const int total = nblk * nN, lim = full_only ? (total / G) * G : total;
        if (L >= lim) return false;
        u.aux = e; u.a = A + (size_t)u.pm * tstep; u.b = B + (size_t)e * estride + (size_t)u.pn * tstep; return true;
    }
};
struct MoeTailOrder {
    const char* A; const char* B; int G, c; size_t tstep, estride; const unsigned* cnt;
    __device__ __forceinline__ bool next(int i, Unit& u) const {
        int acc = 0; int pend[8];
#pragma unroll
        for (int j = 0; j < 8; ++j) { const int cj = (int)__hip_atomic_load(cnt + j, __ATOMIC_RELAXED, __HIP_MEMORY_SCOPE_AGENT); acc += (cj + 255) / 256; pend[j] = acc; }
        const int nblk = acc < 72 ? acc : 72, total = nblk * 8, nfull = (total / G) * G, R = total - nfull;
        const int s = i * G + c; if (s >= 4 * R) return false;
        const int L = nfull + (s >> 2), q = s & 3; u.pn = L % 8; u.pm = L / 8; u.sub = q;
        int e = 0;
#pragma unroll
        for (int j = 0; j < 7; ++j) e += (u.pm >= pend[j]) ? 1 : 0;
        u.aux = e; u.a = A + (size_t)u.pm * tstep + (size_t)q * 1408 * 2; u.b = B + (size_t)e * estride + (size_t)u.pn * tstep + (size_t)q * 1408 * 2; return true;
    }
};
template <class Order>
__device__ __forceinline__ int fill_table(const Order& O, LAS UnitRec* tab, LAS int* ncell) {
    __syncthreads();
    int ti = threadIdx.x; asm volatile("" : "+v"(ti));
    if (ti < 64) {
        Unit u; const bool ok = O.next(ti, u);
        if (ok) { UnitRec r; r.a_lo = (unsigned)(unsigned long long)u.a; r.a_hi = (unsigned)((unsigned long long)u.a >> 32); r.b_lo = (unsigned)(unsigned long long)u.b; r.b_hi = (unsigned)((unsigned long long)u.b >> 32);
            r.pm = u.pm; r.pn = u.pn; r.sub = u.sub; r.aux = u.aux; LAS unsigned* t = (LAS unsigned*)(tab + ti);
            t[0] = r.a_lo; t[1] = r.a_hi; t[2] = r.b_lo; t[3] = r.b_hi; t[4] = (unsigned)r.pm; t[5] = (unsigned)r.pn; t[6] = (unsigned)r.sub; t[7] = (unsigned)r.aux; }
        const unsigned long long m = __ballot(ok);
        if (ti == 0) *ncell = __popcll(m);
    }
    __syncthreads();
    return __builtin_amdgcn_readfirstlane(*ncell);
}
}

constexpr size_t MiB = 1u << 20;
constexpr size_t al(size_t x) { return (x + 4095) & ~(size_t)4095; }
constexpr size_t WS_CTL = 0, CTL_BYTES = 1 * MiB;
constexpr size_t WS_MODP = WS_CTL + CTL_BYTES;
constexpr size_t WS_MOD = WS_MODP + al((size_t)16 * 2 * 5 * MOD_W * 4);
constexpr size_t WS_XR = WS_MOD + al((size_t)2 * 5 * MOD_W * 4);
constexpr size_t WS_H = WS_XR + al((size_t)NR * D * 4);
constexpr size_t WS_HS = WS_H + al((size_t)NR * D * 2);
constexpr size_t WS_P = WS_HS + al((size_t)NSLOT * D * 2);
constexpr size_t WS_ABF = WS_P + al((size_t)NR * PW * 2);
constexpr size_t WS_LG = WS_ABF + al((size_t)NR * 32 * 4);
constexpr size_t WS_OG = WS_LG + al((size_t)2 * NR * 512 * 4);
constexpr size_t WS_AO = WS_OG + al((size_t)2 * NR * 1024 * 4);
constexpr size_t WS_BO = WS_AO + al((size_t)NR * 1024 * 2);
constexpr size_t WS_CO = WS_BO + al((size_t)NR * 1024 * 2);
constexpr size_t WS_MG = WS_CO + al((size_t)NR * 1024 * 2);
constexpr size_t WS_ACT = WS_MG + al((size_t)NR * D * 2);
constexpr size_t WS_RT = WS_ACT + al((size_t)NSLOT * DFF * 2);
constexpr size_t WS_WIN = WS_RT + al((size_t)NL * 2 * 4 * 3);
constexpr size_t WS_WP = WS_WIN + al((size_t)2 * NIN * D * 2);
constexpr size_t WS_WOUT = WS_WP + al((size_t)2 * 3 * D * 1024 * 2);
constexpr size_t WS_DGU = WS_WOUT + al((size_t)2 * D * D * 2);
constexpr size_t WS_DDN = WS_DGU + al((size_t)2 * DFF * D * 2);
constexpr size_t WS_MGU = WS_DDN + al((size_t)D * DFF * 2);
constexpr size_t WS_MDN = WS_MGU + al((size_t)NE * 2 * DFF * D * 2);
constexpr size_t WS_VT = WS_MDN + al((size_t)NE * D * DFF * 2);
constexpr size_t WS_QT = WS_VT + al((size_t)NB * 2304 * 2304 * 2);
constexpr size_t WS_KV = WS_QT + al((size_t)2 * NR * 512 * 2);
constexpr size_t WS_DEC = WS_KV + al((size_t)1152 * 256 * 128 * 2);
constexpr size_t WS_QKN = WS_DEC + al((size_t)1152 * 128 * 4);
constexpr size_t WS_ROPE = WS_QKN + al((size_t)NR * 1280 * 2);
constexpr size_t WS_KVG = WS_ROPE + al((size_t)S * 64 * 8);
constexpr size_t WS_END = WS_KVG + al((size_t)NB * 2304 * 512 * 2);
static_assert((size_t)1152 * 256 * 128 * 2 <= (size_t)NSLOT * DFF * 2, "KVS (scan output) aliases ACT");
static_assert((size_t)NSLOT * D * 4 <= (size_t)NR * PW * 2, "Y2 fits in P");
constexpr int CW_BAR = 4096;
constexpr int CW_CNT = 16384;

constexpr int RING_BYTES = 131072, MISC_OFF = RING_BYTES + 320, UTAB_OFF = MISC_OFF + 128, LDS_BYTES = 147456;

struct Params { const float* in[28]; float* out; unsigned char* ws; int ph_lo, ph_hi; };

struct Ctx { LAS unsigned char* lds; int tid, lane, wave, bid, nb; };

__device__ __forceinline__ void ph_mod_partial(const Ctx& F, const float* c, const float* cctx, const float* w_ada, float* MODP) {
    LAS float* ca = (LAS float*)F.lds;
    for (int i = F.tid; i < 5 * D; i += NTHR) { const int r = i / D, k = i % D; const float v = r < 4 ? c[r * D + k] : cctx[k]; ca[i] = siluf_(v); }
    __syncthreads();
    for (int u = F.bid; u < 2 * 24 * 16; u += F.nb) {
        const int kc = u % 16, cb = (u / 16) % 24, layer = u / (16 * 24);
        const int j = cb * 512 + F.tid;
        const float* w = w_ada + ((size_t)layer * D + kc * 128) * MOD_W + j;
        float acc[5] = {0.f, 0.f, 0.f, 0.f, 0.f};
#pragma unroll 8
        for (int k = 0; k < 128; ++k) { const float wv = w[(size_t)k * MOD_W];
#pragma unroll
            for (int r = 0; r < 5; ++r) acc[r] += ca[r * D + kc * 128 + k] * wv; }
#pragma unroll
        for (int r = 0; r < 5; ++r) MODP[(((size_t)kc * 2 + layer) * 5 + r) * MOD_W + j] = acc[r];
    }
    __syncthreads();
}
__device__ __forceinline__ void ph_rope_table(const Ctx& F, float* ROPE) {
    for (int i = F.bid * NTHR + F.tid; i < S * 64; i += F.nb * NTHR) {
        const int t = i >> 6, pp = i & 63, j = pp & 31; const float pos = pp < 32 ? (float)(t / GW) : (float)(t % GW);
        const float ang = pos * powf(10000.f, -(float)(2 * j) / 64.f);
        ROPE[2 * i] = cosf(ang); ROPE[2 * i + 1] = sinf(ang);
    }
}
__device__ __forceinline__ void ph_mod_reduce(const Ctx& F, const float* MODP, const float* b_ada, float* MOD) {
    for (int i = F.bid * NTHR + F.tid; i < 2 * 5 * MOD_W; i += F.nb * NTHR) {
        const int j = i % MOD_W, layer = i / (5 * MOD_W);
        float s = b_ada[layer * MOD_W + j];
        for (int kc = 0; kc < 16; ++kc) s += MODP[(size_t)kc * 2 * 5 * MOD_W + i];
        MOD[i] = s;
    }
}
struct CvtJob { const float* src; bf16_t* dst; int K, Nsrc, nblk  , map  ; const float* src2; };
__device__ __forceinline__ const float* cvt_src(const CvtJob& J, int g32  , int& col) {
    const float* src = J.src; col = g32 * 32;
    if (J.map == 1) { if (g32 < 192) col = g32 * 32; else if (g32 < 432) col = g32 * 32 + 32; else if (g32 == 432) col = S_AF; else src = nullptr; }
    else if (J.map == 2) { const int tile = g32 >> 3, j = g32 & 7; col = tile * 128 + 32 * (j & 3); if (j >= 4) src = J.src2; }
    return src;
}
__device__ __forceinline__ void cvt_load(const CvtJob& J, int kb, int nbp, int tid, f32x4 (&v)[8]) {
    const int w = tid >> 6, lane = tid & 63, kg = lane & 7, nq = lane >> 3;
    int col; const float* src = cvt_src(J, nbp * 8 + w, col);
    const int k0 = kb * 64 + kg * 8;
    if (src) {
#pragma unroll
        for (int j = 0; j < 8; ++j) v[j] = __builtin_nontemporal_load((const f32x4*)(src + (size_t)(k0 + j) * J.Nsrc + col + 4 * nq));
    } else {
#pragma unroll
        for (int j = 0; j < 8; ++j) v[j] = (f32x4){0.f, 0.f, 0.f, 0.f};
    }
}
__device__ __forceinline__ void cvt_store(const CvtJob& J, int kb, int nbp, int tid, const f32x4 (&v)[8]) {
    const int w = tid >> 6, lane = tid & 63, kg = lane & 7, nq = lane >> 3;
    const int k0 = kb * 64 + kg * 8, r0 = nbp * 256 + 32 * w + 4 * nq;
#pragma unroll
    for (int i = 0; i < 4; ++i) {
        u32x4 wv; wv.x = cvt_pk_bf16(v[0][i], v[1][i]); wv.y = cvt_pk_bf16(v[2][i], v[3][i]); wv.z = cvt_pk_bf16(v[4][i], v[5][i]); wv.w = cvt_pk_bf16(v[6][i], v[7][i]);
        __builtin_nontemporal_store(wv, (u32x4*)(J.dst + (size_t)(r0 + i) * J.K + k0));
    }
}
#define GF(k) ((const float*)(const GAS float*)p.in[k])
__device__ __forceinline__ void ph_convert(const Ctx& F, const Params& p) {
    unsigned char* ws = (unsigned char*)(GAS unsigned char*)p.ws;
    int base = 0;
#define CVT_RUN(SRC, SRC2, DST, KK, NSRC, NBLK, MAP) do { CvtJob J{SRC, DST, KK, NSRC, NBLK, MAP, SRC2}; const int nk = (KK) / 64, nit = nk * ((NBLK) / 2); \
        int it = (F.bid - base % F.nb + F.nb) % F.nb; \
        for (; it < nit; it += 2 * F.nb) { f32x4 va[8], vb[8]; const int it2 = it + F.nb; cvt_load(J, it % nk, it / nk, F.tid, va); if (it2 < nit) cvt_load(J, it2 % nk, it2 / nk, F.tid, vb); \
            cvt_store(J, it % nk, it / nk, F.tid, va); if (it2 < nit) cvt_store(J, it2 % nk, it2 / nk, F.tid, vb); } base += nit; } while (0)
    CVT_RUN(GF(8), nullptr, (bf16_t*)(ws + WS_WIN), D, DIN, NIN / 128, 1);
    CVT_RUN(GF(15), nullptr, (bf16_t*)(ws + WS_WP) + (size_t)0 * D * 1024, 1024, D, D / 128, 0);
    CVT_RUN(GF(16), nullptr, (bf16_t*)(ws + WS_WP) + (size_t)1 * D * 1024, 1024, D, D / 128, 0);
    CVT_RUN(GF(17), nullptr, (bf16_t*)(ws + WS_WP) + (size_t)2 * D * 1024, 1024, D, D / 128, 0);
    CVT_RUN(GF(18), nullptr, (bf16_t*)(ws + WS_WOUT), D, D, D / 128, 0);
#undef CVT_RUN
}
constexpr int BG_WIN = 1760, BG_WP = 128, BG_WOUT = 256, BG_MGU = 1408, BG_MDN = 704, BG_DENSE = BG_MGU + BG_MDN, BG_TOTAL = BG_DENSE + BG_WIN + 3 * BG_WP + BG_WOUT + NE * (BG_MGU + BG_MDN);
__device__ __forceinline__ void bg_item(const Params& p, int t, CvtJob& J, int& kb, int& nbp) {
    unsigned char* ws = (unsigned char*)(GAS unsigned char*)p.ws;
    if (t < BG_MGU) { J = CvtJob{GF(19), (bf16_t*)(ws + WS_DGU), D, DFF, 2 * DFF / 128, 2, GF(20)}; }
    else if ((t -= BG_MGU) < BG_MDN) { J = CvtJob{GF(21), (bf16_t*)(ws + WS_DDN), DFF, D, D / 128, 0, nullptr}; }
    else if ((t -= BG_MDN) < BG_WIN) { J = CvtJob{GF(8) + (size_t)D * DIN, (bf16_t*)(ws + WS_WIN) + (size_t)NIN * D, D, DIN, NIN / 128, 1, nullptr}; }
    else if ((t -= BG_WIN) < 3 * BG_WP) { const int br = t / BG_WP; t -= br * BG_WP;
        J = CvtJob{(br == 0 ? GF(15) : (br == 1 ? GF(16) : GF(17))) + (size_t)1024 * D, (bf16_t*)(ws + WS_WP) + (size_t)(3 + br) * D * 1024, 1024, D, D / 128, 0, nullptr}; }
    else if ((t -= 3 * BG_WP) < BG_WOUT) { J = CvtJob{GF(18) + (size_t)D * D, (bf16_t*)(ws + WS_WOUT) + (size_t)D * D, D, D, D / 128, 0, nullptr}; }
    else if ((t -= BG_WOUT) < NE * BG_MGU) { const int e = t / BG_MGU; t -= e * BG_MGU;
        J = CvtJob{GF(24) + (size_t)e * D * DFF, (bf16_t*)(ws + WS_MGU) + (size_t)e * 2 * DFF * D, D, DFF, 2 * DFF / 128, 2, GF(25) + (size_t)e * D * DFF}; }
    else { t -= NE * BG_MGU; const int e = t / BG_MDN; t -= e * BG_MDN;
        J = CvtJob{GF(26) + (size_t)e * DFF * D, (bf16_t*)(ws + WS_MDN) + (size_t)e * D * DFF, DFF, D, D / 128, 0, nullptr}; }
    const int nk = J.K / 64; kb = t % nk; nbp = t / nk;
}
__device__ __forceinline__ void bg_convert(const Ctx& F, const Params& p, int t0, int n) {
    int t1 = t0 + n; if (t1 > BG_TOTAL) t1 = BG_TOTAL;
    for (int t = t0; t < t1; t += 2) {
        CvtJob Ja, Jb; int ka, na, kb2, nb2; f32x4 va[8], vb[8];
        bg_item(p, t, Ja, ka, na); cvt_load(Ja, ka, na, F.tid, va);
        const bool two = t + 1 < t1;
        if (two) { bg_item(p, t + 1, Jb, kb2, nb2); cvt_load(Jb, kb2, nb2, F.tid, vb); }
        cvt_store(Ja, ka, na, F.tid, va);
        if (two) cvt_store(Jb, kb2, nb2, F.tid, vb);
    }
}
#undef GF
template <bool ROUTER>
__device__ __forceinline__ void ph_norm(const Ctx& F, const float* X, const float* Xc  , const float* g, const float* modl, int sh_off, int sc_off, bf16_t* H, int rows,
                                        const float* rw, const float* rb, int* tok_e, float* tok_w) {
    const int rstep = F.nb * NWAVES;
    f32x4 nx[8];
    { const int row0 = F.bid * NWAVES + F.wave; if (row0 < rows) { const f32x4* xr = (const f32x4*)((Xc && row0 >= NL) ? Xc + (size_t)(row0 - NL) * D : X + (size_t)row0 * D) + F.lane;
#pragma unroll
        for (int j = 0; j < 8; ++j) nx[j] = xr[64 * j]; } }
    for (int row = F.bid * NWAVES + F.wave; row < rows; row += rstep) {
        f32x4 v[8]; float ss = 0.f;
#pragma unroll
        for (int j = 0; j < 8; ++j) { v[j] = nx[j]; ss += v[j][0] * v[j][0] + v[j][1] * v[j][1] + v[j][2] * v[j][2] + v[j][3] * v[j][3]; }
        if (row + rstep < rows) { const int rn_ = row + rstep; const f32x4* xr = (const f32x4*)((Xc && rn_ >= NL) ? Xc + (size_t)(rn_ - NL) * D : X + (size_t)rn_ * D) + F.lane;
#pragma unroll
            for (int j = 0; j < 8; ++j) nx[j] = xr[64 * j]; }
        ss = wave_sum(ss);
        const float rs = rsqrtf(ss * (1.f / D) + EPS);
        const float* mb = modl + (size_t)batch_of(row) * MOD_W;
        float lg[8];
        if (ROUTER) {
#pragma unroll
            for (int e = 0; e < 8; ++e) lg[e] = 0.f; }
#pragma unroll
        for (int j = 0; j < 8; ++j) { const int c = 4 * F.lane + 256 * j;
            const f32x4 gg = *(const f32x4*)(g + c), sc = *(const f32x4*)(mb + sc_off + c), sh = *(const f32x4*)(mb + sh_off + c);
            f32x4 y;
#pragma unroll
            for (int i = 0; i < 4; ++i) y[i] = v[j][i] * rs * gg[i] * (1.f + sc[i]) + sh[i];
            u32x2 w; w.x = pk2(y[0], y[1]); w.y = pk2(y[2], y[3]);
            *(u32x2*)(H + (size_t)row * D + c) = w;
            if (ROUTER) {
#pragma unroll
                for (int i = 0; i < 4; ++i) { const f32x4 w0 = *(const f32x4*)(rw + (size_t)(c + i) * 8), w1 = *(const f32x4*)(rw + (size_t)(c + i) * 8 + 4);
#pragma unroll
                    for (int e = 0; e < 4; ++e) { lg[e] += y[i] * w0[e]; lg[4 + e] += y[i] * w1[e]; } } }
        }
        if (ROUTER) {
#pragma unroll
            for (int e = 0; e < 8; ++e) lg[e] = wave_sum(lg[e]) + rb[e];
            if (F.lane == 0) {
                int i0 = 0;
#pragma unroll
                for (int e = 1; e < 8; ++e) if (lg[e] > lg[i0]) i0 = e;
                int i1 = -1;
#pragma unroll
                for (int e = 0; e < 8; ++e) if (e != i0 && (i1 < 0 || lg[e] > lg[i1])) i1 = e;
                const float e1 = expf(lg[i1] - lg[i0]); const float w0 = 1.f / (1.f + e1);
                tok_e[row * 2] = i0; tok_e[row * 2 + 1] = i1; tok_w[row * 2] = w0; tok_w[row * 2 + 1] = e1 * w0;
            } }
    }
}
__device__ __forceinline__ void ph_prep(const Ctx& F, const bf16_t* P, const float* ROPE, bf16_t* QKN, bf16_t* KVGb, const float* ABF, const float* qn_g, const float* kn_g, const float* w_a2, const float* b_a, float* LG) {
    typedef float f32x2 __attribute__((ext_vector_type(2)));
    const f32x2 gq = *(const f32x2*)(qn_g + 2 * F.lane), gk = *(const f32x2*)(kn_g + 2 * F.lane);
    for (int r = F.bid * NWAVES + F.wave; r < NR; r += F.nb * NWAVES) {
        const bf16_t* pr = P + (size_t)r * PW + 2 * F.lane;
        unsigned v[10];
#pragma unroll
        for (int hh = 0; hh < 10; ++hh) v[hh] = *(const unsigned*)(pr + (hh < 8 ? O_GQQ + hh * 128 : O_GQK + (hh - 8) * 128));
        const unsigned vv0 = *(const unsigned*)(pr + O_GQV), vv1 = *(const unsigned*)(pr + O_GQV + 128);
        bf16_t* kvrow = KVGb + ((size_t)(r < NL ? (r >> 11) * 2304 + (r & (S - 1)) : ((r - NL) >> 8) * 2304 + S + ((r - NL) & (LC - 1)))) * 512;
        f32x2 cs2 = (f32x2){1.f, 0.f};
        if (r < NL) cs2 = *(const f32x2*)(ROPE + ((size_t)(r & (S - 1)) * 64 + F.lane) * 2);
#pragma unroll
        for (int hh = 0; hh < 10; ++hh) {
            float x1 = __uint_as_float(v[hh] << 16), x2 = __uint_as_float(v[hh] & 0xffff0000u);
            const float ss = wave_sum(x1 * x1 + x2 * x2);
            const float rs = rsqrtf(ss * (1.f / 128.f) + EPS);
            const f32x2 gg = hh < 8 ? gq : gk;
            x1 = x1 * rs * gg.x; x2 = x2 * rs * gg.y;
            const float o1 = x1 * cs2.x - x2 * cs2.y, o2 = x1 * cs2.y + x2 * cs2.x;
            if (hh < 8) *(unsigned*)(QKN + (size_t)r * 1280 + hh * 128 + 2 * F.lane) = pk2(o1, o2);
            else *(unsigned*)(kvrow + (hh - 8) * 128 + 2 * F.lane) = pk2(o1, o2);
        }
        *(unsigned*)(kvrow + 256 + 2 * F.lane) = vv0; *(unsigned*)(kvrow + 384 + 2 * F.lane) = vv1;
    }
    {
        const int c = F.tid;
        float w0[16], w1[16];
#pragma unroll
        for (int j = 0; j < 16; ++j) { w0[j] = w_a2[j * 512 + c]; w1[j] = w_a2[(16 + j) * 512 + c]; }
        const float b0 = b_a[c], b1 = b_a[512 + c];
        float an = 0.f;
        if (F.bid < NR) an = ABF[(size_t)F.bid * 32 + (F.lane & 31)];
        for (int r = F.bid; r < NR; r += F.nb) {
            const float a = an;
            if (r + F.nb < NR) an = ABF[(size_t)(r + F.nb) * 32 + (F.lane & 31)];
            float z0 = b0, z1 = b1;
#pragma unroll
            for (int j = 0; j < 16; ++j) { z0 += __uint_as_float(__builtin_amdgcn_readlane(__float_as_uint(a), j)) * w0[j]; z1 += __uint_as_float(__builtin_amdgcn_readlane(__float_as_uint(a), 16 + j)) * w1[j]; }
            const float l0 = fminf(z0, 0.f) - 0.6931471805599453f * __builtin_amdgcn_logf(1.f + __builtin_amdgcn_exp2f(-fabsf(z0) * LOG2E));
            const float l1 = fminf(z1, 0.f) - 0.6931471805599453f * __builtin_amdgcn_logf(1.f + __builtin_amdgcn_exp2f(-fabsf(z1) * LOG2E));
            LG[(size_t)r * 512 + c] = l0 * (1.f / 16.f); LG[((size_t)NR + r) * 512 + c] = l1 * (1.f / 16.f);
        }
    }
}
__device__ __forceinline__ void ph_vt(const Ctx& F, const bf16_t* P, bf16_t* VT) {
    LAS bf16_t* T = (LAS bf16_t*)F.lds;
    const int r = F.tid >> 3, ch = F.tid & 7;
#define VT_SRC(it_) ({ const int b_ = (it_) / (36 * 36), ct_ = ((it_) / 36) % 36, tt_ = (it_) % 36; const int c0_ = ct_ * 64, pc_ = c0_ < 1024 ? O_NAV + c0_ : (c0_ < 2048 ? O_GLV + (c0_ - 1024) : O_GQV + (c0_ - 2048)); \
        const int tok0_ = tt_ * 64, row0_ = tok0_ < S ? b_ * S + tok0_ : NL + b_ * LC + (tok0_ - S); (const u32x4*)(P + (size_t)(row0_ + r) * PW + pc_ + ch * 8); })
    u32x4 nx = (u32x4){0u, 0u, 0u, 0u};
    if (F.bid < NB * 36 * 36) nx = *VT_SRC(F.bid);
    for (int it = F.bid; it < NB * 36 * 36; it += F.nb) {
        const int b = it / (36 * 36), ct = (it / 36) % 36, tt = it % 36, c0 = ct * 64, tok0 = tt * 64;
        const u32x4 v = nx;
        if (it + F.nb < NB * 36 * 36) nx = *VT_SRC(it + F.nb);
        __syncthreads();
        *(LAS u32x4*)(T + r * 72 + ch * 8) = v;
        __syncthreads();
        { const int c = F.tid >> 3, tc = F.tid & 7; unsigned w[4];
#pragma unroll
          for (int j = 0; j < 4; ++j) w[j] = (unsigned)T[(8 * tc + 2 * j) * 72 + c] | ((unsigned)T[(8 * tc + 2 * j + 1) * 72 + c] << 16);
          *(u32x4*)(VT + ((size_t)b * 2304 + c0 + c) * 2304 + tok0 + 8 * tc) = (u32x4){w[0], w[1], w[2], w[3]}; }
    }
#undef VT_SRC
    __syncthreads();
}
#define MFMA16(a, b, c) __builtin_amdgcn_mfma_f32_16x16x32_bf16((a), (b), (c), 0, 0, 0)
__device__ __forceinline__ void ph_na(const Ctx& F, const bf16_t* P, const bf16_t* VT, const float* rpb, bf16_t* AO, int u_lo, int u_hi) {
    const int lane = F.lane, fr = lane & 15, g = lane >> 4;
    LAS float* bias_s = (LAS float*)F.lds + F.wave * 512;
    const int kperm = 8 * (fr >> 2) + (fr & 3);
    for (int u = u_lo + F.bid * NWAVES + F.wave; u < u_hi; u += F.nb * NWAVES) {
        const bool lat = u < 2048;
        int b, h, r = 0, qrow0;
        if (lat) { b = u >> 9; r = (u >> 4) & 31; h = u & 15; qrow0 = b * S + r * GW; }
        else { const int v = u - 2048; b = v >> 6; h = v & 15; qrow0 = NL + b * LC + ((v >> 4) & 3) * 64; }
        if (lat) { for (int i = lane; i < 465; i += 64) bias_s[i] = rpb[h * 465 + i] * LOG2E; }
        bf16x8 Qf[4][2];
#pragma unroll
        for (int nq = 0; nq < 4; ++nq)
#pragma unroll
            for (int ks = 0; ks < 2; ++ks) Qf[nq][ks] = *(const bf16x8*)(P + (size_t)(qrow0 + 16 * nq + fr) * PW + O_NAQ + h * 64 + 32 * ks + 8 * g);
        f32x4 O[4][4]; float m[4], l[4];
#pragma unroll
        for (int nq = 0; nq < 4; ++nq) { m[nq] = -1e30f; l[nq] = 0.f;
#pragma unroll
            for (int db = 0; db < 4; ++db) O[nq][db] = (f32x4){0.f, 0.f, 0.f, 0.f}; }
        const int r0 = min(max(r - 4, 0), 24);
        const int ntile = lat ? 12 : 4;
        __builtin_amdgcn_s_waitcnt(0); __builtin_amdgcn_wave_barrier();
#define NA_KADDR(s_, t_, ks_) ({ const int ti_ = (s_) >> 1, kb_ = (s_) & 1; const int kr_ = ti_ < 4 ? NL + b * LC + ti_ * 64 : b * S + (r0 + ti_ - 4) * GW; \
            (const bf16x8*)(P + (size_t)(kr_ + 32 * kb_ + kperm + 4 * (t_)) * PW + O_NAK + h * 64 + 32 * (ks_) + 8 * g); })
        const int nstep = 2 * ntile;
        bf16x8 Kn[2][2];
#pragma unroll
        for (int t = 0; t < 2; ++t)
#pragma unroll
            for (int ks = 0; ks < 2; ++ks) Kn[t][ks] = *NA_KADDR(0, t, ks);
#pragma unroll 1
        for (int st = 0; st < nstep; ++st) {
            const int ti = st >> 1, kb = st & 1;
            const bool ctile = ti < 4; const int w = ti - 4;
            const int vtok_t = ctile ? S + ti * 64 : (r0 + w) * GW;
            bf16x8 Kf[2][2];
#pragma unroll
            for (int t = 0; t < 2; ++t)
#pragma unroll
                for (int ks = 0; ks < 2; ++ks) Kf[t][ks] = Kn[t][ks];
            bf16x8 Vf[4];
#pragma unroll
            for (int db = 0; db < 4; ++db) Vf[db] = *(const bf16x8*)(VT + ((size_t)b * 2304 + h * 64 + 16 * db + fr) * 2304 + vtok_t + 32 * kb + 8 * g);
            if (st + 1 < nstep) {
#pragma unroll
                for (int t = 0; t < 2; ++t)
#pragma unroll
                    for (int ks = 0; ks < 2; ++ks) Kn[t][ks] = *NA_KADDR(st + 1, t, ks);
            }
            bf16x8 Pf[4];
#pragma unroll
            for (int nq = 0; nq < 4; ++nq) {
                f32x4 s0 = (f32x4){0.f, 0.f, 0.f, 0.f}, s1 = (f32x4){0.f, 0.f, 0.f, 0.f};
                s0 = MFMA16(Kf[0][0], Qf[nq][0], s0); s0 = MFMA16(Kf[0][1], Qf[nq][1], s0);
                s1 = MFMA16(Kf[1][0], Qf[nq][0], s1); s1 = MFMA16(Kf[1][1], Qf[nq][1], s1);
                float x[8];
#pragma unroll
                for (int i = 0; i < 4; ++i) { x[i] = s0[i] * (0.125f * LOG2E); x[4 + i] = s1[i] * (0.125f * LOG2E); }
                if (!ctile) {
                    const int qcol = 16 * nq + fr, c0 = min(max(qcol - 8, 0), 48), kc0 = 32 * kb + 8 * g;
                    const int bidx = 31 * (r0 + w - r + 7) + (kc0 - qcol + 15);
#pragma unroll
                    for (int j = 0; j < 8; ++j) { const int kc = kc0 + j; const bool ok = kc >= c0 && kc < c0 + 16;
                        const int bi = min(max(bidx + j, 0), 464); x[j] = ok ? x[j] + bias_s[bi] : -1e30f; }
                }
                float mx = fmaxf(fmaxf(fmaxf(x[0], x[1]), fmaxf(x[2], x[3])), fmaxf(fmaxf(x[4], x[5]), fmaxf(x[6], x[7])));
                mx = fmaxf(mx, __shfl_xor(mx, 16)); mx = fmaxf(mx, __shfl_xor(mx, 32));
                const float mn = fmaxf(m[nq], mx), alpha = __builtin_amdgcn_exp2f(m[nq] - mn);
                float ps = 0.f;
#pragma unroll
                for (int j = 0; j < 8; ++j) { x[j] = __builtin_amdgcn_exp2f(x[j] - mn); ps += x[j]; }
                l[nq] = l[nq] * alpha + ps; m[nq] = mn;
#pragma unroll
                for (int db = 0; db < 4; ++db) O[nq][db] = O[nq][db] * alpha;
                u32x4 pw; pw.x = cvt_pk_bf16(x[0], x[1]); pw.y = cvt_pk_bf16(x[2], x[3]); pw.z = cvt_pk_bf16(x[4], x[5]); pw.w = cvt_pk_bf16(x[6], x[7]);
                Pf[nq] = __builtin_bit_cast(bf16x8, pw);
            }
#pragma unroll
            for (int nq = 0; nq < 4; ++nq)
#pragma unroll
                for (int db = 0; db < 4; ++db) O[nq][db] = MFMA16(Vf[db], Pf[nq], O[nq][db]);
        }
#undef NA_KADDR
#pragma unroll
        for (int nq = 0; nq < 4; ++nq) { float lt = l[nq]; lt += __shfl_xor(lt, 16); lt += __shfl_xor(lt, 32); const float inv = 1.f / lt;
#pragma unroll
            for (int db = 0; db < 4; ++db) { const f32x4 o = O[nq][db] * inv; u32x2 wv; wv.x = cvt_pk_bf16(o[0], o[1]); wv.y = cvt_pk_bf16(o[2], o[3]);
                *(u32x2*)(AO + (size_t)(qrow0 + 16 * nq + fr) * 1024 + h * 64 + 16 * db + 4 * g) = wv; } }
        __builtin_amdgcn_s_waitcnt(0); __builtin_amdgcn_wave_barrier();
    }
}

namespace ga {
constexpr int D_ = 128, NW = 8, QBLK = 32, KVBLK = 64;
constexpr float SCALE = 0.088388347648318440f, THR = 8.f;
constexpr int SDEPTH = 1;
constexpr int LDQ = 1280, LDK = 512, LDO = 1024;
constexpr size_t SHM_V = KVBLK * D_ * 2, SHM_K = KVBLK * D_ * 2, SHM_ATTN = 2 * SHM_V + 2 * SHM_K + NW * 64 * 4;
typedef short s16x4 __attribute__((ext_vector_type(4)));
typedef float f32x16 __attribute__((ext_vector_type(16)));
#define GA_KSWZ(row, colB) ((row) * 256 + ((colB) ^ (((row) & 7) << 4)))
#define GA_SBAR() __builtin_amdgcn_sched_barrier(0)
__device__ __forceinline__ int crow(int r, int hi) { return (r & 3) + 8 * (r >> 2) + 4 * hi; }
__device__ __forceinline__ unsigned cvtpk(float lo, float hi) { unsigned r; asm volatile("v_cvt_pk_bf16_f32 %0, %1, %2" : "=v"(r) : "v"(lo), "v"(hi)); return r; }
__device__ __forceinline__ bf16x8 ld8(const bf16_t* p) { return *reinterpret_cast<const bf16x8*>(p); }
__device__ __forceinline__ void partialSM(f32x16& p0, f32x16& p1, float& m_reg, float& mn, float& alpha) {
  constexpr float C = SCALE * 1.4426950408889634f;
  float pmax = p0[0];
#pragma unroll
  for (int r = 1; r < 16; ++r) pmax = fmaxf(pmax, p0[r]);
#pragma unroll
  for (int r = 0; r < 16; ++r) pmax = fmaxf(pmax, p1[r]);
  { auto rr = __builtin_amdgcn_permlane32_swap(__float_as_uint(pmax), __float_as_uint(pmax), false, false);
    pmax = fmaxf(__uint_as_float(rr[0]), __uint_as_float(rr[1])); }
  if (__builtin_expect(__all(pmax - m_reg <= THR / SCALE), 1)) { mn = m_reg; alpha = 1.f; }
  else { mn = fmaxf(m_reg, pmax); alpha = __builtin_amdgcn_exp2f((m_reg - mn) * C); m_reg = mn; }
  float mnC = -mn * C;
#pragma unroll
  for (int r = 0; r < 16; ++r) p0[r] = fmaf(p0[r], C, mnC);
#pragma unroll
  for (int r = 0; r < 16; ++r) p1[r] = fmaf(p1[r], C, mnC);
#pragma unroll
  for (int r = 0; r < 16; ++r) p0[r] = __builtin_amdgcn_exp2f(p0[r]);
}
__device__ __forceinline__ void finishSM(f32x16& p0, f32x16& p1, float alpha, float& l_reg, bf16x8& pa0, bf16x8& pa1, bf16x8& pa2, bf16x8& pa3) {
#pragma unroll
  for (int r = 0; r < 16; ++r) p1[r] = __builtin_amdgcn_exp2f(p1[r]);
  float ps = 0;
#pragma unroll
  for (int r = 0; r < 16; ++r) ps += p0[r];
#pragma unroll
  for (int r = 0; r < 16; ++r) ps += p1[r];
  { auto rr = __builtin_amdgcn_permlane32_swap(__float_as_uint(ps), __float_as_uint(ps), false, false);
    ps = __uint_as_float(rr[0]) + __uint_as_float(rr[1]); }
  l_reg = l_reg * alpha + ps;
#define GA_PK4(P_, BASE, OUT) do { unsigned a0 = cvtpk(P_[BASE + 0], P_[BASE + 1]), a1 = cvtpk(P_[BASE + 2], P_[BASE + 3]);   \
    unsigned b0 = cvtpk(P_[BASE + 4], P_[BASE + 5]), b1 = cvtpk(P_[BASE + 6], P_[BASE + 7]);                              \
    auto r0 = __builtin_amdgcn_permlane32_swap(a0, b0, false, false); auto r1 = __builtin_amdgcn_permlane32_swap(a1, b1, false, false); \
    u32x4 w = {r0[0], r1[0], r0[1], r1[1]}; OUT = __builtin_bit_cast(bf16x8, w); } while (0)
  GA_PK4(p0, 0, pa0); GA_PK4(p0, 8, pa1); GA_PK4(p1, 0, pa2); GA_PK4(p1, 8, pa3);
#undef GA_PK4
}
__device__ __forceinline__ void qkt(f32x16& p0, f32x16& p1, const char* Ks, const bf16x8* qr, int r32, int hi) {
  p0 = f32x16{}; p1 = f32x16{};
#pragma unroll
  for (int d0 = 0; d0 < 8; ++d0) { int cb = (d0 * 16 + hi * 8) * 2;
    bf16x8 b0 = *reinterpret_cast<const bf16x8*>(Ks + GA_KSWZ(r32, cb));
    bf16x8 b1 = *reinterpret_cast<const bf16x8*>(Ks + GA_KSWZ(32 + r32, cb));
    p0 = __builtin_amdgcn_mfma_f32_32x32x16_bf16(b0, qr[d0], p0, 0, 0, 0);
    p1 = __builtin_amdgcn_mfma_f32_32x32x16_bf16(b1, qr[d0], p1, 0, 0, 0); }
}
__device__ __forceinline__ int v_st(int k, int c) { const int kk = (k & ~0xC) | ((k & 4) << 1) | ((k & 8) >> 1); return ((kk >> 3) * 4 + (c >> 5)) * 512 + ((kk & 7) * 32 + (c & 31)) * 2; }
__device__ __forceinline__ int v_rd_base(int lane) { return ((lane & 3) << 3) | (((lane >> 2) & 3) << 6) | (((lane >> 4) & 1) << 5) | (((lane >> 5) & 1) << 8); }
constexpr int v_rd_off(int d0, int ks, int half) { return d0 * 512 + ks * 4096 + half * 2048; }
template <int OFF> __device__ __forceinline__ s16x4 tr_read(int vb) {
  s16x4 r; asm volatile("ds_read_b64_tr_b16 %0, %1 offset:%2" : "=&v"(r) : "v"(vb), "i"(OFF) : "memory"); return r;
}
template <int D0> __device__ __forceinline__ void pv_one(f32x16& od, int vb, bf16x8 pa0, bf16x8 pa1, bf16x8 pa2, bf16x8 pa3) {
  const s16x4 l0 = tr_read<v_rd_off(D0, 0, 0)>(vb), h0 = tr_read<v_rd_off(D0, 0, 1)>(vb), l1 = tr_read<v_rd_off(D0, 1, 0)>(vb), h1 = tr_read<v_rd_off(D0, 1, 1)>(vb);
  const s16x4 l2 = tr_read<v_rd_off(D0, 2, 0)>(vb), h2 = tr_read<v_rd_off(D0, 2, 1)>(vb), l3 = tr_read<v_rd_off(D0, 3, 0)>(vb), h3 = tr_read<v_rd_off(D0, 3, 1)>(vb);
  asm volatile("s_waitcnt lgkmcnt(0)" ::: "memory"); GA_SBAR();
#define GA_PK(L, H) (bf16x8){L[0], L[1], L[2], L[3], H[0], H[1], H[2], H[3]}
  od = __builtin_amdgcn_mfma_f32_32x32x16_bf16(pa0, GA_PK(l0, h0), od, 0, 0, 0);
  od = __builtin_amdgcn_mfma_f32_32x32x16_bf16(pa1, GA_PK(l1, h1), od, 0, 0, 0);
  od = __builtin_amdgcn_mfma_f32_32x32x16_bf16(pa2, GA_PK(l2, h2), od, 0, 0, 0);
  od = __builtin_amdgcn_mfma_f32_32x32x16_bf16(pa3, GA_PK(l3, h3), od, 0, 0, 0);
#undef GA_PK
}
__device__ __forceinline__ void pv_d0(f32x16* o, int vb, bf16x8 pa0, bf16x8 pa1, bf16x8 pa2, bf16x8 pa3) {
  pv_one<0>(o[0], vb, pa0, pa1, pa2, pa3); pv_one<1>(o[1], vb, pa0, pa1, pa2, pa3); pv_one<2>(o[2], vb, pa0, pa1, pa2, pa3); pv_one<3>(o[3], vb, pa0, pa1, pa2, pa3);
}
__device__ __forceinline__ void attn_dense_body(const bf16_t* __restrict__ Qb, const bf16_t* __restrict__ Kh, const bf16_t* __restrict__ Vh, bf16_t* __restrict__ Ob, int seq, char* lds, int tid) {
  const int wid = tid >> 6, lane = tid & 63, r32 = lane & 31, hi = lane >> 5;
  char* V_lds = lds; char* K_lds = lds + 2 * SHM_V;
  float* wsf = (float*)(lds + 2 * SHM_V + 2 * SHM_K) + wid * 64; float* li_l = wsf; float* al_l = wsf + 32;
  float m_reg = -1e30f, l_reg = 0; f32x16 o[4] = {}; bf16x8 qr[8];
  const bf16_t* Qw = Qb + (long)(wid * QBLK + r32) * LDQ + hi * 8;
#pragma unroll
  for (int d0 = 0; d0 < 8; ++d0) qr[d0] = ld8(Qw + d0 * 16);
  const int sr = tid >> 4, sc = (tid & 15) * 8, vst0 = v_st(sr, sc), vst1 = v_st(32 + sr, sc);
  const int vb0 = (int)(uintptr_t)V_lds + v_rd_base(lane);
  struct { bf16x8 vs0, vs1, ks0, ks1; } sr_[SDEPTH];
#define GA_SLOAD(i, k0) do { sr_[i].vs0 = ld8(&Vh[(long)((k0) + sr) * LDK + sc]); sr_[i].vs1 = ld8(&Vh[(long)((k0) + 32 + sr) * LDK + sc]); \
    sr_[i].ks0 = ld8(&Kh[(long)((k0) + sr) * LDK + sc]); sr_[i].ks1 = ld8(&Kh[(long)((k0) + 32 + sr) * LDK + sc]); } while (0)
#define GA_SWRITE(b, i) do { *(bf16x8*)(V_lds + (b) * SHM_V + vst0) = sr_[i].vs0;          \
    *(bf16x8*)(V_lds + (b) * SHM_V + vst1) = sr_[i].vs1; int kc = sc * 2;               \
    *(bf16x8*)(K_lds + (b) * SHM_K + GA_KSWZ(sr, kc)) = sr_[i].ks0;                       \
    *(bf16x8*)(K_lds + (b) * SHM_K + GA_KSWZ(32 + sr, kc)) = sr_[i].ks1; } while (0)
#define GA_SWAIT() do { if (SDEPTH == 2) asm volatile("s_waitcnt vmcnt(4)" ::: "memory"); else asm volatile("s_waitcnt vmcnt(0)" ::: "memory"); } while (0)
#define GA_RESC(a) do { if (__any((a) < 1.f)) { if (hi == 0) al_l[r32] = (a); asm volatile("s_waitcnt lgkmcnt(0)" ::: "memory"); \
    _Pragma("unroll") for (int d = 0; d < 4; ++d) _Pragma("unroll") for (int r = 0; r < 16; ++r) o[d][r] *= al_l[crow(r, hi)]; } } while (0)
  f32x16 pA0, pA1, pB0, pB1; float mnA, mnB, alA, alB; bf16x8 pa0, pa1, pa2, pa3; const int NT = seq / KVBLK;
  constexpr int SE = 0, SO = SDEPTH - 1;
  GA_SLOAD(SE, 0); asm volatile("s_waitcnt vmcnt(0)" ::: "memory"); GA_SWRITE(0, SE); __syncthreads();
  qkt(pA0, pA1, K_lds, qr, r32, hi); partialSM(pA0, pA1, m_reg, mnA, alA);
  GA_SLOAD(SO, KVBLK); if (SDEPTH == 2) { if (2 < NT) GA_SLOAD(SE, 2 * KVBLK); }
  GA_SWAIT(); GA_SWRITE(1, SO); __syncthreads();
  for (int j = 1; j + 1 < NT; j += 2) {
    GA_SBAR(); qkt(pB0, pB1, K_lds + SHM_K, qr, r32, hi);
    finishSM(pA0, pA1, alA, l_reg, pa0, pa1, pa2, pa3); GA_SBAR();
    GA_SLOAD(SO, (j + SDEPTH) * KVBLK); GA_SBAR();
    pv_d0(o, vb0, pa0, pa1, pa2, pa3); partialSM(pB0, pB1, m_reg, mnB, alB);
    __syncthreads(); GA_SWAIT(); GA_SWRITE(0, SE);
    GA_RESC(alB); __syncthreads();
    GA_SBAR(); qkt(pA0, pA1, K_lds, qr, r32, hi);
    finishSM(pB0, pB1, alB, l_reg, pa0, pa1, pa2, pa3); GA_SBAR();
    if (SDEPTH == 1 || j + 3 < NT) GA_SLOAD(SE, (j + 1 + SDEPTH) * KVBLK); GA_SBAR();
    pv_d0(o, vb0 + (int)SHM_V, pa0, pa1, pa2, pa3); partialSM(pA0, pA1, m_reg, mnA, alA);
    __syncthreads(); GA_SWAIT(); GA_SWRITE(1, SO);
    GA_RESC(alA); __syncthreads();
  }
  GA_SBAR(); qkt(pB0, pB1, K_lds + SHM_K, qr, r32, hi);
  finishSM(pA0, pA1, alA, l_reg, pa0, pa1, pa2, pa3); GA_SBAR();
  pv_d0(o, vb0, pa0, pa1, pa2, pa3); partialSM(pB0, pB1, m_reg, mnB, alB);
  __syncthreads(); GA_RESC(alB);
  finishSM(pB0, pB1, alB, l_reg, pa0, pa1, pa2, pa3); GA_SBAR();
  pv_d0(o, vb0 + (int)SHM_V, pa0, pa1, pa2, pa3);
  if (hi == 0) li_l[r32] = l_reg; asm volatile("s_waitcnt lgkmcnt(0)" ::: "memory");
  float rli[16];
#pragma unroll
  for (int r = 0; r < 16; ++r) rli[r] = __builtin_amdgcn_rcpf(li_l[crow(r, hi)]);
  bf16_t* Ow = Ob + (long)(wid * QBLK) * LDO;
#pragma unroll
  for (int r = 0; r < 16; ++r) { int orow = crow(r, hi);
#pragma unroll
    for (int d0 = 0; d0 < 4; ++d0) Ow[(long)orow * LDO + d0 * 32 + r32] = (bf16_t)f2bf(o[d0][r] * rli[r]); }
  asm volatile("s_waitcnt vmcnt(0) lgkmcnt(0)" ::: "memory"); __syncthreads();
#undef GA_SLOAD
#undef GA_SWRITE
#undef GA_SWAIT
#undef GA_RESC
}
}
__device__ __forceinline__ void ph_gqa2(const Ctx& F, const bf16_t* QKN, const bf16_t* KVGb, bf16_t* CO, bool with_ctx, char* lds_generic) {
    const int nunits = 256 + (with_ctx ? 32 : 0);
    for (int u = F.bid; u < nunits; u += F.nb) {
        const bool lat = u < 256;
        int b, hq, qrow0, tok0, seq;
        if (lat) { b = u >> 6; hq = (u >> 3) & 7; qrow0 = b * S + (u & 7) * 256; tok0 = 0; seq = S + LC; }
        else { const int v = u - 256; b = v >> 3; hq = v & 7; qrow0 = NL + b * LC; tok0 = S; seq = LC; }
        const bf16_t* Kh = KVGb + ((size_t)b * 2304 + tok0) * 512 + (hq >> 2) * 128;
        ga::attn_dense_body(QKN + (size_t)qrow0 * 1280 + hq * 128, Kh, Kh + 256, CO + (size_t)qrow0 * 1024 + hq * 128, seq, lds_generic, F.tid);
    }
}
__device__ __forceinline__ void gla_unit_rows(int b, int c, int& row0, int& tok0) { if (c < 4) { row0 = NL + b * LC + 64 * c; tok0 = S + 64 * c; } else { row0 = b * S + 64 * (c - 4); tok0 = 64 * (c - 4); } }
__device__ __forceinline__ void ph_gla_a(const Ctx& F, const bf16_t* P, const bf16_t* VT, const float* LG, float* OG, bf16_t* QT, bf16_t* KVb, float* DEC) {
    const int lane = F.lane, fr = lane & 15, g = lane >> 4, tid = F.tid, w = F.wave;
    LAS float* Gs = (LAS float*)F.lds;
    LAS unsigned char* Qt = F.lds + 32768;
    LAS unsigned char* Kt = F.lds + 50176;
    LAS unsigned char* KhT = F.lds + 67584;
    LAS unsigned char* Pfr = F.lds + 86016;
    LAS float* Seg = (LAS float*)(F.lds + 94208);
    for (int u = F.bid; u < 1152; u += F.nb) {
        const int c = u % 36, h = (u / 36) & 3, b = (u / 144) & 3, dir = u / 576;
        int row0, tok0; gla_unit_rows(b, c, row0, tok0);
        __syncthreads();
        bf16x8 Vf[2][2];
#pragma unroll
        for (int db = 0; db < 2; ++db)
#pragma unroll
            for (int jb = 0; jb < 2; ++jb) Vf[db][jb] = *(const bf16x8*)(VT + ((size_t)b * 2304 + 1024 + h * 256 + 32 * w + 16 * db + fr) * 2304 + tok0 + 32 * jb + 8 * g);
        {
            const int col = tid & 127, seg = tid >> 7;
            float v[16];
#pragma unroll
            for (int i = 0; i < 16; ++i) v[i] = LG[((size_t)dir * NR + row0 + seg * 16 + i) * 512 + h * 128 + col];
            if (dir == 0) {
#pragma unroll
                for (int i = 1; i < 16; ++i) v[i] += v[i - 1];
                Seg[seg * 128 + col] = v[15];
            } else {
#pragma unroll
                for (int i = 14; i >= 0; --i) v[i] += v[i + 1];
                Seg[seg * 128 + col] = v[0];
            }
            __syncthreads();
            float off = 0.f;
            if (dir == 0) { for (int s2 = 0; s2 < seg; ++s2) off += Seg[s2 * 128 + col]; }
            else { for (int s2 = 3; s2 > seg; --s2) off += Seg[s2 * 128 + col]; }
#pragma unroll
            for (int i = 0; i < 16; ++i) Gs[(seg * 16 + i) * 128 + col] = v[i] + off;
        }
        __syncthreads();
        {
            const int tok = tid >> 3, d0 = (tid & 7) * 16;
            const bf16_t* pr = P + (size_t)(row0 + tok) * PW;
            const u32x4 q0 = *(const u32x4*)(pr + O_GLQ + h * 128 + d0), q1 = *(const u32x4*)(pr + O_GLQ + h * 128 + d0 + 8);
            const u32x4 k0 = *(const u32x4*)(pr + O_GLK + h * 128 + d0), k1 = *(const u32x4*)(pr + O_GLK + h * 128 + d0 + 8);
            const unsigned qw[8] = {q0.x, q0.y, q0.z, q0.w, q1.x, q1.y, q1.z, q1.w}, kw[8] = {k0.x, k0.y, k0.z, k0.w, k1.x, k1.y, k1.z, k1.w};
            const int glast = dir == 0 ? 63 : 0;
            unsigned qo[8], ko[8];
#pragma unroll
            for (int p2 = 0; p2 < 8; ++p2) {
                float qt[2], kt[2], kh[2];
#pragma unroll
                for (int e = 0; e < 2; ++e) { const int dk = d0 + 2 * p2 + e;
                    const float gg = Gs[tok * 128 + dk], GG = Gs[glast * 128 + dk];
                    const float qv = e ? __uint_as_float(qw[p2] & 0xffff0000u) : __uint_as_float(qw[p2] << 16), kv = e ? __uint_as_float(kw[p2] & 0xffff0000u) : __uint_as_float(kw[p2] << 16);
                    qt[e] = qv * 0.08838834764831845f * __builtin_amdgcn_exp2f(gg * LOG2E); kt[e] = kv * __builtin_amdgcn_exp2f(-gg * LOG2E); kh[e] = kv * __builtin_amdgcn_exp2f((GG - gg) * LOG2E);
                    *(LAS bf16_t*)(KhT + dk * 144 + tok * 2) = (bf16_t)f2bf(kh[e]); }
                qo[p2] = cvt_pk_bf16(qt[0], qt[1]); ko[p2] = cvt_pk_bf16(kt[0], kt[1]);
            }
            *(LAS u32x4*)(Qt + tok * 272 + d0 * 2) = (u32x4){qo[0], qo[1], qo[2], qo[3]}; *(LAS u32x4*)(Qt + tok * 272 + d0 * 2 + 16) = (u32x4){qo[4], qo[5], qo[6], qo[7]};
            *(LAS u32x4*)(Kt + tok * 272 + d0 * 2) = (u32x4){ko[0], ko[1], ko[2], ko[3]}; *(LAS u32x4*)(Kt + tok * 272 + d0 * 2 + 16) = (u32x4){ko[4], ko[5], ko[6], ko[7]};
            bf16_t* qg = QT + ((size_t)dir * NR + row0 + tok) * 512 + h * 128 + d0;
            *(u32x4*)qg = (u32x4){qo[0], qo[1], qo[2], qo[3]}; *(u32x4*)(qg + 8) = (u32x4){qo[4], qo[5], qo[6], qo[7]};
            if (tid < 128) DEC[(size_t)u * 128 + tid] = __builtin_amdgcn_exp2f(Gs[glast * 128 + tid] * LOG2E);
        }
        __syncthreads();
        {
            const int ib = w & 3, jb = w >> 2;
            f32x4 s0 = (f32x4){0.f, 0.f, 0.f, 0.f}, s1 = (f32x4){0.f, 0.f, 0.f, 0.f};
            const int jr = 32 * jb + 8 * (fr >> 2) + (fr & 3);
#pragma unroll
            for (int ks = 0; ks < 4; ++ks) {
                const bf16x8 qf = *(const LAS bf16x8*)(Qt + (16 * ib + fr) * 272 + (32 * ks + 8 * g) * 2);
                const bf16x8 k0f = *(const LAS bf16x8*)(Kt + jr * 272 + (32 * ks + 8 * g) * 2), k1f = *(const LAS bf16x8*)(Kt + (jr + 4) * 272 + (32 * ks + 8 * g) * 2);
                s0 = MFMA16(k0f, qf, s0); s1 = MFMA16(k1f, qf, s1);
            }
            const int i = 16 * ib + fr, j0 = 32 * jb + 8 * g;
            float x[8];
#pragma unroll
            for (int e = 0; e < 4; ++e) { x[e] = s0[e]; x[4 + e] = s1[e]; }
#pragma unroll
            for (int e = 0; e < 8; ++e) { const int j = j0 + e; const bool keep = dir == 0 ? (j <= i) : (j >= i); x[e] = keep ? x[e] : 0.f; }
            u32x4 pw; pw.x = cvt_pk_bf16(x[0], x[1]); pw.y = cvt_pk_bf16(x[2], x[3]); pw.z = cvt_pk_bf16(x[4], x[5]); pw.w = cvt_pk_bf16(x[6], x[7]);
            *(LAS u32x4*)(Pfr + (jb * 4 + ib) * 1024 + lane * 16) = pw;
        }
        __syncthreads();
        {
#pragma unroll
            for (int ib = 0; ib < 4; ++ib) {
                const bf16x8 p0 = *(const LAS bf16x8*)(Pfr + (0 * 4 + ib) * 1024 + lane * 16), p1 = *(const LAS bf16x8*)(Pfr + (1 * 4 + ib) * 1024 + lane * 16);
#pragma unroll
                for (int db = 0; db < 2; ++db) {
                    f32x4 o = (f32x4){0.f, 0.f, 0.f, 0.f};
                    o = MFMA16(Vf[db][0], p0, o); o = MFMA16(Vf[db][1], p1, o);
                    *(f32x4*)(OG + ((size_t)dir * NR + row0 + 16 * ib + fr) * 1024 + h * 256 + 32 * w + 16 * db + 4 * g) = o;
                }
            }
#pragma unroll
            for (int dkb = 0; dkb < 8; ++dkb) {
                const bf16x8 kh0 = *(const LAS bf16x8*)(KhT + (16 * dkb + fr) * 144 + (8 * g) * 2), kh1 = *(const LAS bf16x8*)(KhT + (16 * dkb + fr) * 144 + (32 + 8 * g) * 2);
#pragma unroll
                for (int db = 0; db < 2; ++db) {
                    f32x4 o = (f32x4){0.f, 0.f, 0.f, 0.f};
                    o = MFMA16(Vf[db][0], kh0, o); o = MFMA16(Vf[db][1], kh1, o);
                    bf16_t* dst = KVb + ((size_t)u * 256 + 32 * w + 16 * db + 4 * g) * 128 + 16 * dkb + fr;
#pragma unroll
                    for (int e = 0; e < 4; ++e) dst[e * 128] = (bf16_t)f2bf(o[e]);
                }
            }
        }
    }
    __syncthreads();
}
__device__ __forceinline__ void ph_gla_scan(const Ctx& F, const bf16_t* KVb, bf16_t* KVs, const float* DEC) {
    typedef float f32x2 __attribute__((ext_vector_type(2)));
    for (int e = F.bid * NTHR + F.tid; e < 32 * 16384; e += F.nb * NTHR) {
        const int chain = e >> 14, pe = e & 16383, dv = pe >> 6, dk2 = (pe & 63) * 2, dir = chain >> 4;
        unsigned kv[36]; f32x2 dd[36];
#pragma unroll
        for (int n = 0; n < 36; ++n) {
            const int c = dir == 0 ? n : (n < 4 ? 3 - n : 39 - n);
            const size_t u = (size_t)chain * 36 + c;
            kv[n] = *(const unsigned*)(KVb + (u * 256 + dv) * 128 + dk2); dd[n] = *(const f32x2*)(DEC + u * 128 + dk2);
        }
        float s0 = 0.f, s1 = 0.f;
#pragma unroll
        for (int n = 0; n < 36; ++n) {
            const int c = dir == 0 ? n : (n < 4 ? 3 - n : 39 - n);
            const size_t u = (size_t)chain * 36 + c;
            *(unsigned*)(KVs + (u * 256 + dv) * 128 + dk2) = pk2(s0, s1);
            s0 = dd[n].x * s0 + __uint_as_float(kv[n] << 16); s1 = dd[n].y * s1 + __uint_as_float(kv[n] & 0xffff0000u);
        }
    }
}
__device__ __forceinline__ void ph_gla_c(const Ctx& F, const bf16_t* P, const float* OG, const bf16_t* QT, const bf16_t* KVb, const float* ng, bf16_t* BO, bool with_ctx) {
    const int lane = F.lane, fr = lane & 15, g = lane >> 4, w = F.wave, ib = w & 3, dh = w >> 2;
    const int c_lo = with_ctx ? 0 : 4, nc = 36 - c_lo, nun = NB * nc * 4;
    LAS float* part = (LAS float*)F.lds;
    for (int uu = F.bid; uu < nun; uu += F.nb) {
        const int h = uu & 3, c = c_lo + (uu >> 2) % nc, b = (uu >> 2) / nc;
        int row0, tok0; gla_unit_rows(b, c, row0, tok0);
        const size_t r = (size_t)(row0 + 16 * ib + fr);
        const int dvb = h * 256 + 128 * dh + 4 * g;
        f32x4 acc[8];
#pragma unroll
        for (int db = 0; db < 8; ++db) acc[db] = *(const f32x4*)(OG + r * 1024 + dvb + 16 * db) + *(const f32x4*)(OG + ((size_t)NR + r) * 1024 + dvb + 16 * db);
#pragma unroll 1
        for (int dir = 0; dir < 2; ++dir) {
            const size_t ud = (size_t)((dir * 4 + b) * 4 + h) * 36 + c;
            bf16x8 Qf[4], Sf[8][4];
#pragma unroll
            for (int ks = 0; ks < 4; ++ks) Qf[ks] = *(const bf16x8*)(QT + ((size_t)dir * NR + r) * 512 + h * 128 + 32 * ks + 8 * g);
#pragma unroll
            for (int db = 0; db < 8; ++db)
#pragma unroll
                for (int ks = 0; ks < 4; ++ks) Sf[db][ks] = *(const bf16x8*)(KVb + (ud * 256 + 128 * dh + 16 * db + fr) * 128 + 32 * ks + 8 * g);
#pragma unroll
            for (int db = 0; db < 8; ++db)
#pragma unroll
                for (int ks = 0; ks < 4; ++ks) acc[db] = MFMA16(Sf[db][ks], Qf[ks], acc[db]);
        }
        float ss = 0.f;
#pragma unroll
        for (int db = 0; db < 8; ++db) ss += acc[db][0] * acc[db][0] + acc[db][1] * acc[db][1] + acc[db][2] * acc[db][2] + acc[db][3] * acc[db][3];
        ss += __shfl_xor(ss, 16); ss += __shfl_xor(ss, 32);
        __syncthreads();
        if (g == 0) part[(dh * 4 + ib) * 16 + fr] = ss;
        __syncthreads();
        const float rs = rsqrtf((part[ib * 16 + fr] + part[(4 + ib) * 16 + fr]) * (1.f / 256.f) + EPS);
#pragma unroll
        for (int db = 0; db < 8; ++db) { const int dv = 128 * dh + 16 * db + 4 * g;
            const u32x2 og = *(const u32x2*)(P + r * PW + O_GLOG + h * 256 + dv); const f32x4 gg = *(const f32x4*)(ng + dv);
            const float z0 = __uint_as_float(og.x << 16), z1 = __uint_as_float(og.x & 0xffff0000u), z2 = __uint_as_float(og.y << 16), z3 = __uint_as_float(og.y & 0xffff0000u);
            const float o0 = acc[db][0] * rs * gg[0] * z0 * fast_sigmoid(z0), o1 = acc[db][1] * rs * gg[1] * z1 * fast_sigmoid(z1);
            const float o2 = acc[db][2] * rs * gg[2] * z2 * fast_sigmoid(z2), o3 = acc[db][3] * rs * gg[3] * z3 * fast_sigmoid(z3);
            u32x2 wv; wv.x = cvt_pk_bf16(o0, o1); wv.y = cvt_pk_bf16(o2, o3);
            *(u32x2*)(BO + r * 1024 + h * 256 + dv) = wv; }
    }
    __syncthreads();
}
__device__ __forceinline__ void ph_moe_sort(const Ctx& F, const int* tok_e, int* tok_slot, const bf16_t* H, bf16_t* HS, unsigned* cnt_out, float* Y2) {
    LAS int* tot = (LAS int*)F.lds;
    LAS int* pre = tot + 8;
    LAS int* slots = pre + 8;
    __syncthreads();
    if (F.tid < 16) tot[F.tid] = 0;
    __syncthreads();
    {
        int ct[8], cp[8];
#pragma unroll
        for (int e = 0; e < 8; ++e) { ct[e] = 0; cp[e] = 0; }
        for (int i = F.tid; i < NL * 2; i += NTHR) { const int e = tok_e[i]; const bool before = i < F.bid * 64;
#pragma unroll
            for (int j = 0; j < 8; ++j) { ct[j] += (e == j); cp[j] += (e == j && before); } }
#pragma unroll
        for (int e = 0; e < 8; ++e) { const int a = (int)wave_sum((float)ct[e]), b2 = (int)wave_sum((float)cp[e]); if (F.lane == 0) { atomicAdd((int*)&tot[e], a); atomicAdd((int*)&pre[e], b2); } }
    }
    __syncthreads();
    int pstart[8]; { int acc = 0;
#pragma unroll
        for (int e = 0; e < 8; ++e) { pstart[e] = acc; acc += (tot[e] + 255) / 256 * 256; } }
    if (F.tid < 64) {
        const int ai = F.bid * 64 + F.tid; const int me = tok_e[ai];
        int rank = 0, ps_me = 0;
#pragma unroll
        for (int e = 0; e < 8; ++e) { const unsigned long long m = __ballot(me == e); if (me == e) { rank = __popcll(m & ((1ull << F.lane) - 1ull)); ps_me = pstart[e]; } }
        const int slot = ps_me + pre[me] + rank;
        tok_slot[ai] = slot; slots[F.tid] = slot;
    }
    if (F.bid == 0 && F.tid < 8) cnt_out[F.tid] = (unsigned)tot[F.tid];
    __syncthreads();
    for (int a = F.wave; a < 64; a += NWAVES) { const int t = F.bid * 32 + (a >> 1); const u32x4* sp = (const u32x4*)(H + (size_t)t * D); u32x4* d = (u32x4*)(HS + (size_t)slots[a] * D);
#pragma unroll
        for (int j = 0; j < 4; ++j) d[F.lane + 64 * j] = sp[F.lane + 64 * j]; }
    {
        int nblk = 0;
#pragma unroll
        for (int e = 0; e < 8; ++e) nblk += (tot[e] + 255) / 256;
        nblk = nblk < 72 ? nblk : 72;
        const int total = nblk * 8, nfull = (total / F.nb) * F.nb, R = total - nfull;
        for (int j = F.bid; j < R; j += F.nb) { const int L = nfull + j, pn = L % 8, pm = L / 8;
            for (int i = F.tid; i < 256 * 64; i += NTHR) { const int rr = i >> 6, c4 = i & 63; *(f32x4*)(Y2 + (size_t)(pm * 256 + rr) * D + pn * 256 + c4 * 4) = (f32x4){0.f, 0.f, 0.f, 0.f}; } }
    }
    {
        int lo = 0, hi = 0;
#pragma unroll
        for (int e = 0; e < 8; ++e) if ((F.bid & 7) == e) { lo = pstart[e] + tot[e]; hi = pstart[e] + (tot[e] + 255) / 256 * 256; }
        for (int rr = lo + (F.bid >> 3) * NWAVES + F.wave; rr < hi; rr += 32 * NWAVES) { u32x4* d = (u32x4*)(HS + (size_t)rr * D);
#pragma unroll
            for (int j = 0; j < 4; ++j) d[F.lane + 64 * j] = (u32x4){0u, 0u, 0u, 0u}; } }
    __syncthreads();
}
__device__ __forceinline__ void ph_final(const Ctx& F, const float* XR, const float* Y2, const int* tok_slot, const float* tok_w, const float* modl, const float* fg, float* out, float delta) {
    const int rstep = F.nb * NWAVES;
    f32x4 nx[8], ny0[8], ny1[8]; float nw0 = 0.f, nw1 = 0.f;
#define FIN_LOAD(row_) do { const f32x4* xr_ = (const f32x4*)(XR + (size_t)(row_) * D) + F.lane; \
        const f32x4* y0_ = (const f32x4*)(Y2 + (size_t)tok_slot[(row_) * 2] * D) + F.lane; const f32x4* y1_ = (const f32x4*)(Y2 + (size_t)tok_slot[(row_) * 2 + 1] * D) + F.lane; \
        nw0 = tok_w[(row_) * 2]; nw1 = tok_w[(row_) * 2 + 1]; \
        _Pragma("unroll") for (int j = 0; j < 8; ++j) { nx[j] = xr_[64 * j]; ny0[j] = y0_[64 * j]; ny1[j] = y1_[64 * j]; } } while (0)
    if (F.bid * NWAVES + F.wave < NL) FIN_LOAD(F.bid * NWAVES + F.wave);
    for (int row = F.bid * NWAVES + F.wave; row < NL; row += rstep) {
        const float* g2 = modl + (size_t)batch_of(row) * MOD_W + 5 * D;
        f32x4 v[8]; float ss = 0.f;
#pragma unroll
        for (int j = 0; j < 8; ++j) { const f32x4 gg = *(const f32x4*)(g2 + 4 * F.lane + 256 * j); v[j] = nx[j] + gg * (nw0 * ny0[j] + nw1 * ny1[j]);
            ss += v[j][0] * v[j][0] + v[j][1] * v[j][1] + v[j][2] * v[j][2] + v[j][3] * v[j][3]; }
        if (row + rstep < NL) FIN_LOAD(row + rstep);
        ss = wave_sum(ss);
        const float rs = rsqrtf(ss * (1.f / D) + EPS);
#pragma unroll
        for (int j = 0; j < 8; ++j) { const f32x4 gg = *(const f32x4*)(fg + 4 * F.lane + 256 * j); ((f32x4*)(out + (size_t)row * D))[F.lane + 64 * j] = v[j] * rs * gg + delta; }
    }
#undef FIN_LOAD
}

constexpr int PH_PER_LAYER = 12, PH_FINAL = 2 + 2 * PH_PER_LAYER, N_PHASES = PH_FINAL + 1;
__global__ void __launch_bounds__(NTHR, 2) mega(Params p) {
    extern __shared__ __attribute__((aligned(16))) unsigned char lds_raw[];
    LAS unsigned char* lds = (LAS unsigned char*)lds_raw;
    volatile LAS unsigned* MISC = (volatile LAS unsigned*)(lds + MISC_OFF);
    Ctx F; F.lds = lds; F.tid = threadIdx.x; F.lane = F.tid & 63; F.wave = __builtin_amdgcn_readfirstlane(F.tid >> 6); F.bid = blockIdx.x; F.nb = gridDim.x;
#define FRESH() do { int t_ = threadIdx.x; asm volatile("" : "+v"(t_)); F.tid = t_; F.lane = t_ & 63; F.wave = __builtin_amdgcn_readfirstlane(t_ >> 6); \
        int b_ = blockIdx.x; asm volatile("" : "+s"(b_)); F.bid = b_; unsigned long long w_ = (unsigned long long)ws; asm volatile("" : "+s"(w_)); ws = (unsigned char*)(GAS unsigned char*)w_; } while (0)
    unsigned char* ws = (unsigned char*)(GAS unsigned char*)p.ws;
    for (int u = F.tid; u < (LDS_BYTES - RING_BYTES) / 4; u += NTHR) ((LAS unsigned*)(lds + RING_BYTES))[u] = 0u;
    __syncthreads();
    XcdBarrier bar; bar.bar = (unsigned*)(ws + WS_CTL) + CW_BAR; bar.x = 0; bar.st = nullptr;
    if (!MK_SPLIT) bar = xcd_barrier_post((unsigned*)(ws + WS_CTL) + CW_BAR, MISC + 8);
    const int lo = p.ph_lo, hi = p.ph_hi;
#define GIN(k) ((const float*)(const GAS float*)p.in[k])
    LAS pg8::UnitRec* UTAB = (LAS pg8::UnitRec*)(lds + UTAB_OFF); LAS int* NCELL = (LAS int*)(lds + MISC_OFF + 64);
#ifndef PH_MASK
#define PH_MASK 0xffffffffu
#endif
#define IN(k) (((PH_MASK >> (((k) - 2) % PH_PER_LAYER + 2 < 2 ? (k) : (((k) < 2) ? (k) : (((k) == PH_FINAL) ? 14 : ((k) - 2) % PH_PER_LAYER + 2)))) & 1u) && lo <= (k) && (k) < hi)
#ifndef DBL_J
#define DBL_J (-1)
#define DBL_L 0
#endif
#define BG(c0, q, base) do { FRESH(); if (F.bid >= (c0)) bg_convert(F, p, (base) + (F.bid - (c0)) * (q), (q)); } while (0)
#define REP(j) for (int rep_ = 0; rep_ < ((DBL_J == (j) && layer == DBL_L) ? 2 : 1); ++rep_)
#define REP0(j) for (int rep_ = 0; rep_ < ((DBL_J == 100 + (j)) ? 2 : 1); ++rep_)
#ifdef PAD_STAMP
#define STAMP(id) do { if ((id) == 0 && threadIdx.x == 0) { const unsigned long long t_ = wall_clock64(); MISC[20] = (unsigned)t_; MISC[21] = (unsigned)(t_ >> 32); } \
        if ((id) == PAD_STAMP) { if (threadIdx.x == 0) { const unsigned long long t0_ = ((unsigned long long)MISC[21] << 32) | MISC[20]; \
            while (wall_clock64() - t0_ < (unsigned long long)(PAD_US) * 100ull) __builtin_amdgcn_s_sleep(32); } __syncthreads(); } } while (0)
#else
#define STAMP(id) do { } while (0)
#endif
#define SEAM(k) do { if (IN(k) && IN((k) + 1)) xcd_barrier(bar); FRESH(); STAMP((k) + 1); } while (0)
#define MODP ((float*)(ws + WS_MODP))
#define MOD ((float*)(ws + WS_MOD))
#define XR ((float*)(ws + WS_XR))
#define H ((bf16_t*)(ws + WS_H))
#define HS ((bf16_t*)(ws + WS_HS))
#define P ((bf16_t*)(ws + WS_P))
#define Y2 ((float*)(ws + WS_P))
#define ABF ((float*)(ws + WS_ABF))
#define LG ((float*)(ws + WS_LG))
#define OG ((float*)(ws + WS_OG))
#define AO ((bf16_t*)(ws + WS_AO))
#define BO ((bf16_t*)(ws + WS_BO))
#define CO ((bf16_t*)(ws + WS_CO))
#define MG ((bf16_t*)(ws + WS_MG))
#define ACT ((bf16_t*)(ws + WS_ACT))
#define VT ((bf16_t*)(ws + WS_VT))
#define QT ((bf16_t*)(ws + WS_QT))
#define KVB ((bf16_t*)(ws + WS_KV))
#define DEC ((float*)(ws + WS_DEC))
#define QKN ((bf16_t*)(ws + WS_QKN))
#define ROPET ((float*)(ws + WS_ROPE))
#define KVG ((bf16_t*)(ws + WS_KVG))
#define KVS ((bf16_t*)(ws + WS_ACT))
#define tok_e ((int*)(ws + WS_RT))
#define tok_w ((float*)(ws + WS_RT + (size_t)NL * 2 * 4))
#define tok_slot ((int*)(ws + WS_RT + (size_t)NL * 2 * 8))
#define ctl ((unsigned*)(ws + WS_CTL))

    STAMP(0);
    if (IN(0)) REP0(0) { ph_mod_partial(F, GIN(1), GIN(3), GIN(4), MODP); ph_rope_table(F, ROPET); }
    SEAM(0);
    if (IN(1)) REP0(1) { ph_mod_reduce(F, MODP, GIN(5), MOD); ph_convert(F, p); }
    SEAM(1);
    for (int layer = 0; layer < 2; ++layer) {
        const int pb = 2 + layer * PH_PER_LAYER;
        const bool last = layer == 1;
        const float* modl = MOD + (size_t)layer * 5 * MOD_W;
        const int MR = last ? NL : NR;
        if (IN(pb + 0)) REP(0) ph_norm<false>(F, last ? XR : GIN(0), last ? nullptr : GIN(2), GIN(6) + layer * D, modl, 0, D, H, NR, nullptr, nullptr, nullptr, nullptr);
        SEAM(pb + 0);
        if (IN(pb + 1)) REP(1) {
            pg8::InprojOrder So{(const char*)H, (const char*)((bf16_t*)(ws + WS_WIN) + (size_t)layer * NIN * D), last ? 32 : 36, last ? 4 : 0, last ? 232 : 248, F.bid, (size_t)256 * D * 2};
            pg8::EpiInproj E{P, ABF};
            { const int nu = pg8::fill_table(So, UTAB, NCELL); const pg8::TableOrder T{UTAB, nu}; pg8::gemm_phase(lds, D, D, T, E); }
            if (!last) BG(248, 130, 0); else BG(232, 130, 14928);
        }
        SEAM(pb + 1);
        if (IN(pb + 2)) REP(2) { ph_vt(F, P, VT); FRESH(); }
        if (IN(pb + 2)) REP(22) ph_prep(F, P, ROPET, QKN, KVG, ABF, GIN(13) + layer * 128, GIN(14) + layer * 128, GIN(10) + (size_t)layer * 2 * 16 * 512, GIN(11) + layer * 2 * 512, LG);
        SEAM(pb + 2);
        if (IN(pb + 3)) REP(3) {
#ifndef ATTN_SEL
#define ATTN_SEL 7
#endif
            if (ATTN_SEL & 1) REP(31) { ph_gqa2(F, QKN, KVG, CO, !last, (char*)lds_raw); FRESH(); }
            if (ATTN_SEL & 2) REP(32) { ph_na(F, P, VT, GIN(9) + (size_t)layer * 16 * 15 * 31, AO, 0, last ? 2048 : 2304); FRESH(); }
            if (ATTN_SEL & 4) REP(33) ph_gla_a(F, P, VT, LG, OG, QT, KVB, DEC);
        }
        SEAM(pb + 3);
        if (IN(pb + 4)) REP(4) ph_gla_scan(F, KVB, KVS, DEC);
        SEAM(pb + 4);
        if (IN(pb + 5)) REP(5) { ph_gla_c(F, P, OG, QT, KVS, GIN(12) + layer * 256, BO, !last); }
        SEAM(pb + 5);
        if (IN(pb + 6)) REP(6) {
            const bf16_t* wp = (const bf16_t*)(ws + WS_WP) + (size_t)layer * 3 * D * 1024;
            pg8::MergeOrder So{(const char*)AO, (size_t)(WS_BO - WS_AO), (const char*)wp, (size_t)D * 1024 * 2, MR / 256, last ? F.nb : 144, F.bid};
            static_assert(WS_CO - WS_BO == WS_BO - WS_AO, "branch outputs equally spaced");
            pg8::EpiMerge E{P, MG};
            { const int nu = pg8::fill_table(So, UTAB, NCELL); const pg8::TableOrder T{UTAB, nu}; pg8::gemm_phase(lds, 1024, 1024, T, E); }
            if (!last) BG(144, 22, 1040);
        }
        SEAM(pb + 6);
        if (IN(pb + 7)) {
            pg8::PlainOrder So{(const char*)MG, (const char*)((bf16_t*)(ws + WS_WOUT) + (size_t)layer * D * D), MR / 256, 8, last ? F.nb : 144, F.bid, (size_t)256 * D * 2};
            pg8::EpiResid E{XR, modl, 2 * D, last ? nullptr : GIN(0), last ? nullptr : GIN(2)};
            { const int nu = pg8::fill_table(So, UTAB, NCELL); const pg8::TableOrder T{UTAB, nu}; pg8::gemm_phase(lds, D, D, T, E); }
            if (!last) BG(144, 32, 3504);
        }
        SEAM(pb + 7);
        if (IN(pb + 8)) REP(8) {
            if (!last) ph_norm<false>(F, XR, nullptr, GIN(7) + layer * D, modl, 3 * D, 4 * D, H, MR, nullptr, nullptr, nullptr, nullptr);
            else ph_norm<true>(F, XR, nullptr, GIN(7) + layer * D, modl, 3 * D, 4 * D, H, MR, GIN(22), GIN(23), tok_e, tok_w);
        }
        SEAM(pb + 8);
        if (IN(pb + 9)) REP(9) { if (last) { ph_moe_sort(F, tok_e, tok_slot, H, HS, ctl + CW_CNT, Y2); BG(0, 5, 20128); } }
        if (last) SEAM(pb + 9);
        if (!last) {
            if (IN(pb + 10)) REP(10) {
                pg8::PlainOrder So{(const char*)H, (const char*)(ws + WS_DGU), MR / 256, 44, F.nb, F.bid, (size_t)256 * D * 2};
                pg8::EpiSwiglu E{ACT};
                { const int nu = pg8::fill_table(So, UTAB, NCELL); const pg8::TableOrder T{UTAB, nu}; pg8::gemm_phase(lds, D, D, T, E); }
                BG(48, 10, 18048);
            }
            SEAM(pb + 10);
            if (IN(pb + 11)) {
                pg8::PlainOrder So{(const char*)ACT, (const char*)(ws + WS_DDN), MR / 256, 8, 144, F.bid, (size_t)256 * DFF * 2};
                pg8::EpiResid E{XR, modl, 5 * D, nullptr, nullptr};
                { const int nu = pg8::fill_table(So, UTAB, NCELL); const pg8::TableOrder T{UTAB, nu}; pg8::gemm_phase(lds, DFF, DFF, T, E); }
                BG(144, 70, 7088);
            }
            SEAM(pb + 11);
        } else {
            if (IN(pb + 10)) REP(10) {
                pg8::MoeOrder So{(const char*)HS, (const char*)(ws + WS_MGU), 44, F.nb, F.bid, (size_t)256 * D * 2, (size_t)2 * DFF * D * 2, ctl + CW_CNT, 0};
                pg8::EpiSwiglu E{ACT};
                { const int nu = pg8::fill_table(So, UTAB, NCELL); const pg8::TableOrder T{UTAB, nu}; pg8::gemm_phase(lds, D, D, T, E); }
            }
            SEAM(pb + 10);
            if (IN(pb + 11)) REP(11) {
                { pg8::MoeOrder So{(const char*)ACT, (const char*)(ws + WS_MDN), 8, F.nb, F.bid, (size_t)256 * DFF * 2, (size_t)D * DFF * 2, ctl + CW_CNT, 1};
                  pg8::EpiStoreF32 E{Y2};
                  { const int nu = pg8::fill_table(So, UTAB, NCELL); const pg8::TableOrder T{UTAB, nu}; pg8::gemm_phase(lds, DFF, DFF, T, E); } }
                FRESH();
                { pg8::MoeTailOrder So{(const char*)ACT, (const char*)(ws + WS_MDN), F.nb, F.bid, (size_t)256 * DFF * 2, (size_t)D * DFF * 2, ctl + CW_CNT};
                  pg8::EpiAtomicF32 E{Y2};
                  { const int nu = pg8::fill_table(So, UTAB, NCELL); const pg8::TableOrder T{UTAB, nu}; pg8::gemm_phase(lds, 1408, DFF, T, E); } }
            }
            SEAM(pb + 11);
        }
    }
    float probe_delta = 0.f;
    if (IN(PH_FINAL)) REP0(26) ph_final(F, XR, Y2, tok_slot, tok_w, MOD + (size_t)5 * MOD_W, GIN(27), (float*)(GAS float*)p.out, probe_delta);
#undef IN
#undef SEAM
#undef MODP
#undef MOD
#undef XR
#undef H
#undef HS
#undef P
#undef Y2
#undef ABF
#undef LG
#undef OG
#undef AO
#undef BO
#undef CO
#undef MG
#undef ACT
#undef VT
#undef QT
#undef KVB
#undef DEC
#undef QKN
#undef ROPET
#undef KVG
#undef KVS
#undef tok_e
#undef tok_w
#undef tok_slot
#undef ctl
}

extern "C" void kernel_launch(void* const* d_in, const int* in_sizes, int n_in, void* d_out, int out_size, void* d_ws, size_t ws_size, hipStream_t stream) {
    static int grid = 0;
    if (grid == 0) {
        if (n_in != 28 || ws_size < WS_END) { fprintf(stderr, "kernel_launch: need 28 inputs and %zu bytes of workspace (got %d, %zu)\n", (size_t)WS_END, n_in, ws_size); grid = -1; return; }
        int dev = 0, cus = 0, per_cu = 0;
        if (hipGetDevice(&dev) != hipSuccess || hipDeviceGetAttribute(&cus, hipDeviceAttributeMultiprocessorCount, dev) != hipSuccess) { grid = -1; return; }
        if (hipFuncSetAttribute((const void*)mega, hipFuncAttributeMaxDynamicSharedMemorySize, LDS_BYTES) != hipSuccess) { fprintf(stderr, "kernel_launch: hipFuncSetAttribute failed\n"); grid = -1; return; }
        if (hipOccupancyMaxActiveBlocksPerMultiprocessor(&per_cu, (const void*)mega, NTHR, LDS_BYTES) != hipSuccess || per_cu < 1) { fprintf(stderr, "kernel_launch: occupancy query says %d\n", per_cu); }
        (void)hipGetLastError();
        grid = cus;
    }
    if (grid < 0) return;
    (void)hipMemsetAsync((char*)d_ws + WS_CTL, 0, CTL_BYTES, stream);
    Params p{};
    for (int i = 0; i < 28; ++i) p.in[i] = (const float*)d_in[i];
    p.out = (float*)d_out; p.ws = (unsigned char*)d_ws;
#if MK_SPLIT
    for (int k = 0; k < N_PHASES; ++k) { p.ph_lo = k; p.ph_hi = k + 1; hipLaunchKernelGGL(mega, dim3(grid), dim3(NTHR), LDS_BYTES, stream, p); }
#else
    p.ph_lo = 0; p.ph_hi = N_PHASES;
    hipLaunchKernelGGL(mega, dim3(grid), dim3(NTHR), LDS_BYTES, stream, p);
#endif
}
```

```cpp
#include <hip/hip_runtime.h>
#include <cstdio>
#include <cstdint>

#ifndef MK_SPLIT
#define MK_SPLIT 0
#endif

constexpr int D = 2048, NB = 4, S = 2048, LC = 256, NL = NB * S, NC = NB * LC, NR = NL + NC;
constexpr int DIN = 13856, DFF = 5632, NE = 8, GW = 64;
constexpr int S_AF = 6144;
constexpr int PW = 13824;
constexpr int O_NAQ = 0, O_NAK = 1024, O_NAV = 2048, O_GLQ = 3072, O_GLK = 3584, O_GLV = 4096, O_GLOG = 5120,
              O_GQQ = 6144, O_GQK = 7168, O_GQV = 7424, O_GA = 7680, O_GB = 9728, O_GC = 11776;
constexpr int NIN = 14080;
constexpr int MOD_W = 6 * D;
constexpr int NSLOT = 18432;
constexpr float EPS = 1e-6f;
constexpr float LOG2E = 1.4426950408889634f;
constexpr int NWAVES = 8, NTHR = 512;

#define GAS __attribute__((address_space(1)))
#define LAS __attribute__((address_space(3)))
typedef unsigned short bf16_t;
typedef short bf16x8 __attribute__((ext_vector_type(8)));
typedef float f32x4 __attribute__((ext_vector_type(4)));
typedef unsigned u32x4 __attribute__((ext_vector_type(4)));
typedef unsigned u32x2 __attribute__((ext_vector_type(2)));

__device__ __forceinline__ int batch_of(int r) { return r < NL ? (r >> 11) : 4; }
__device__ __forceinline__ float bf2f(bf16_t v) { return __uint_as_float((unsigned)v << 16); }
__device__ __forceinline__ unsigned f2bf(float f) { unsigned u = __float_as_uint(f); return (u + 0x7fffu + ((u >> 16) & 1u)) >> 16; }
__device__ __forceinline__ unsigned pk2(float lo, float hi) { return f2bf(lo) | (f2bf(hi) << 16); }
__device__ __forceinline__ unsigned cvt_pk_bf16(float lo, float hi) { unsigned r; asm volatile("v_cvt_pk_bf16_f32 %0, %1, %2" : "=v"(r) : "v"(lo), "v"(hi)); return r; }
__device__ __forceinline__ float sigmoidf_(float x) { return 1.f / (1.f + expf(-x)); }
__device__ __forceinline__ float siluf_(float x) { return x / (1.f + expf(-x)); }
__device__ __forceinline__ float fast_sigmoid(float x) { return __builtin_amdgcn_rcpf(1.f + __builtin_amdgcn_exp2f(-1.4426950408889634f * x)); }
__device__ __forceinline__ float wave_sum(float v) {
#pragma unroll
    for (int o = 1; o < 64; o <<= 1) v += __shfl_xor(v, o);
    return v;
}
__device__ __forceinline__ float wave_max(float v) {
#pragma unroll
    for (int o = 1; o < 64; o <<= 1) v = fmaxf(v, __shfl_xor(v, o));
    return v;
}

#define XB_TMO      128
#define XB_XCNT(j)  (256  + 64 * (j))
#define XB_XSUB(j)  (1280 + 64 * (j))
#define XB_XGEN(j)  (2304 + 64 * (j))
#define XB_TOP      3328
#define XB_TOPGEN   3392
#define XCD_BAR_WORDS 3456
#define XB_SPIN_CAP (1u << 18)
__device__ __forceinline__ unsigned xb_ld(unsigned* p)              { return __hip_atomic_load(p, __ATOMIC_RELAXED, __HIP_MEMORY_SCOPE_AGENT); }
__device__ __forceinline__ unsigned xb_add(unsigned* p, unsigned v) { return __hip_atomic_fetch_add(p, v, __ATOMIC_RELAXED, __HIP_MEMORY_SCOPE_AGENT); }
__device__ __forceinline__ unsigned xb_xcc_id() { return (unsigned)__builtin_amdgcn_s_getreg((3 << 11) | 20) & 0xFu; }
#define XB_SPIN(cond, bar) do { unsigned _sp = 0; while (cond) { __builtin_amdgcn_s_sleep(1); \
    if ((++_sp & 255u) == 0u) { if (xb_ld(&(bar)[XB_TMO])) break; if (_sp > XB_SPIN_CAP) { atomicAdd(&(bar)[XB_TMO], 1u); break; } } } } while (0)
struct XcdBarrier { unsigned* bar; unsigned x; volatile LAS unsigned* st; };
__device__ __forceinline__ XcdBarrier xcd_barrier_post(unsigned* bar, volatile LAS unsigned* st) {
    XcdBarrier b; b.bar = bar; b.x = xb_xcc_id(); b.st = st;
    if (threadIdx.x == 0) (void)xb_add(&bar[XB_XCNT(b.x)], 1u);
    return b;
}
__device__ __forceinline__ void xcd_barrier_complete(unsigned* bar, unsigned x, unsigned& nloc, unsigned& nx) {
    const unsigned G = gridDim.x * gridDim.y * gridDim.z;
    unsigned sum, cnt, mine, sp = 0u;
    asm volatile("" : "+s"(x));
    { unsigned long long bb = (unsigned long long)bar; asm volatile("" : "+s"(bb)); bar = (unsigned*)(GAS unsigned*)bb; }
    for (;;) {
        sum = 0u; cnt = 0u; mine = 0u;
#pragma unroll
        for (unsigned j = 0; j < 16; ++j) { const unsigned c = xb_ld(&bar[XB_XCNT(j)]); sum += c; cnt += (c > 0u) ? 1u : 0u; mine = (j == x) ? c : mine; }
        if (sum == G) break;
        __builtin_amdgcn_s_sleep(1);
        if ((++sp & 255u) == 0u) { if (xb_ld(&bar[XB_TMO])) break; if (sp > XB_SPIN_CAP) { atomicAdd(&bar[XB_TMO], 1u); break; } }
    }
    nloc = mine > 0u ? mine : 1u; nx = cnt > 0u ? cnt : 1u;
}
__device__ __forceinline__ void xcd_barrier(const XcdBarrier& b) {
    asm volatile("s_waitcnt vmcnt(0)" ::: "memory");
    __syncthreads();
    if (threadIdx.x == 0) {
        unsigned* bar = b.bar;
        __builtin_amdgcn_s_waitcnt(0);
        unsigned nloc = b.st[0], nx = b.st[1];
        if (nloc == 0u) { xcd_barrier_complete(bar, b.x, nloc, nx); b.st[0] = nloc; b.st[1] = nx; }
        const unsigned old = xb_add(&bar[XB_XSUB(b.x)], 1u);
        const unsigned gen = old / nloc;
        if (old + 1u == (gen + 1u) * nloc) {
            __builtin_amdgcn_fence(__ATOMIC_RELEASE, "agent");
            asm volatile("s_waitcnt vmcnt(0)" ::: "memory");
            const unsigned og = xb_add(&bar[XB_TOP], 1u);
            const unsigned tg = og / nx;
            if (og + 1u == (tg + 1u) * nx) xb_add(&bar[XB_TOPGEN], 1u);
            else XB_SPIN(xb_ld(&bar[XB_TOPGEN]) == tg, bar);
            __builtin_amdgcn_fence(__ATOMIC_ACQUIRE, "agent");
            xb_add(&bar[XB_XGEN(b.x)], 1u);
            asm volatile("s_waitcnt vmcnt(0)" ::: "memory");
        } else {
            XB_SPIN(xb_ld(&bar[XB_XGEN(b.x)]) == gen, bar);
            __builtin_amdgcn_fence(__ATOMIC_ACQUIRE, "agent");
            asm volatile("s_waitcnt vmcnt(0)" ::: "memory");
        }
    }
    __syncthreads();
}

namespace pg8 {
constexpr int BM = 256, BK = 64, HALF = 128, HTB = HALF * BK * 2, STAGE_BYTES = 8 * HTB, NXCD = 8, WGM = 8;
__host__ __device__ __forceinline__ int lds_byte(int r, int c) { const int st = (r >> 4) * 2 + (c >> 5), rr = r & 15, cc = c & 31, ob = rr * 64 + cc * 2; return st * 1024 + (ob ^ (((ob >> 9) & 1) << 5)); }
__host__ __device__ __forceinline__ void stage_rc(int b, int& R, int& C) { const int st = b / 1024, sb = b % 1024, swz = sb ^ (((sb >> 9) & 1) << 5); R = (st >> 1) * 16 + swz / 64; C = (st & 1) * 32 + (swz % 64) / 2; }
__host__ __device__ __forceinline__ int perm32(int rho) { const int n = rho >> 4, i = rho & 15; return 8 * (i >> 2) + 4 * n + (i & 3); }

struct Unit { const char* a; const char* b; int pm, pn, sub, aux; };

__device__ __forceinline__ void tile_of(int wgid, int nM, int nN, int& pm, int& pn) {
    const int nwg = nM * nN; { const int q = nwg / NXCD, r = nwg % NXCD, xcd = wgid % NXCD, off = wgid / NXCD; wgid = (xcd < r ? xcd * (q + 1) : r * (q + 1) + (xcd - r) * q) + off; }
    const int nig = WGM * nN, gid = wgid / nig, fm = gid * WGM, gsz = (nM - fm) < WGM ? (nM - fm) : WGM;
    pm = fm + ((wgid % nig) % gsz); pn = (wgid % nig) / gsz;
}

struct UnitRec { unsigned a_lo, a_hi, b_lo, b_hi; int pm, pn, sub, aux; };
struct TableOrder {
    const LAS UnitRec* tab; int n;
    __device__ __forceinline__ bool next(int i, Unit& u) const {
        if (i >= n) return false;
        const LAS unsigned* r = (const LAS unsigned*)(tab + i);
        const unsigned alo = __builtin_amdgcn_readfirstlane(r[0]), ahi = __builtin_amdgcn_readfirstlane(r[1]), blo = __builtin_amdgcn_readfirstlane(r[2]), bhi = __builtin_amdgcn_readfirstlane(r[3]);
        u.a = (const char*)(((unsigned long long)ahi << 32) | alo); u.b = (const char*)(((unsigned long long)bhi << 32) | blo);
        u.pm = __builtin_amdgcn_readfirstlane(r[4]); u.pn = __builtin_amdgcn_readfirstlane(r[5]); u.sub = __builtin_amdgcn_readfirstlane(r[6]); u.aux = __builtin_amdgcn_readfirstlane(r[7]);
        return true;
    }
};
template <class Epi, class Sched>
__device__ __forceinline__ void gemm_phase(LAS unsigned char* lds, const int K, const int ld, const Sched& S, const Epi& E) {
    int tid = threadIdx.x; asm volatile("" : "+v"(tid));
    const int wid = __builtin_amdgcn_readfirstlane(tid >> 6), lane = tid & 63, wr = wid >> 2, wc = wid & 3, fr = lane & 15, fq = lane >> 4;
    const int nt = K / BK;
    unsigned voffA[2], voffB[2];
#pragma unroll
    for (int i = 0; i < 2; ++i) { int R, C; stage_rc(tid * 16 + i * 8192, R, C); const int Rb = Epi::PERM ? ((R & ~31) + perm32(R & 31)) : R;
        voffA[i] = (unsigned)(R * ld + C) * 2u; voffB[i] = (unsigned)(Rb * ld + C) * 2u; }
    const size_t kstep = (size_t)(BK * 2);
    const size_t hstep = (size_t)HALF * ld * 2;
    const unsigned ldsw = (unsigned)wid * 1024u;
    const int aoff = lds_byte(wr * 64 + fr, fq * 8), boff = lds_byte(wc * 32 + fr, fq * 8);
#define PG8_SA(b, h) (((b) * 2 + (h)) * HTB)
#define PG8_SB(b, h) ((4 + (b) * 2 + (h)) * HTB)
#define PG8_STAGE(bufoff, gbase, voff) do { _Pragma("unroll") for (int _i = 0; _i < 2; ++_i) \
        __builtin_amdgcn_global_load_lds((const unsigned*)((const char*)(gbase) + (voff)[_i]), (LAS unsigned*)(lds + (bufoff) + ldsw + _i * 8192), 16, 0, 0); } while (0)
#define PG8_LDA(dst, b, h) do { _Pragma("unroll") for (int m = 0; m < 4; ++m) _Pragma("unroll") for (int k = 0; k < 2; ++k) dst[m][k] = *(const LAS bf16x8*)(lds + PG8_SA(b, h) + aoff + m * 2048 + k * 1024); } while (0)
#define PG8_LDB(dst, b, h) do { _Pragma("unroll") for (int n = 0; n < 2; ++n) _Pragma("unroll") for (int k = 0; k < 2; ++k) dst[n][k] = *(const LAS bf16x8*)(lds + PG8_SB(b, h) + boff + n * 2048 + k * 1024); } while (0)
#define PG8_MMA(ai, bj, At, Bt) do { __builtin_amdgcn_s_setprio(1); _Pragma("unroll") for (int m = 0; m < 4; ++m) _Pragma("unroll") for (int n = 0; n < 2; ++n) _Pragma("unroll") for (int k = 0; k < 2; ++k) \
        acc[ai][bj][m][n] = __builtin_amdgcn_mfma_f32_16x16x32_bf16(Bt[n][k], At[m][k], acc[ai][bj][m][n], 0, 0, 0); __builtin_amdgcn_s_setprio(0); } while (0)
#define PG8_WAIT_V(n) asm volatile("s_waitcnt vmcnt(" #n ")" ::: "memory")
#define PG8_WAIT_L(n) asm volatile("s_waitcnt lgkmcnt(" #n ")" ::: "memory")
#define PG8_BAR __builtin_amdgcn_s_barrier()
#define PG8_SCHED __builtin_amdgcn_sched_barrier(0)
    Unit cur, nxt; int ui = 0;
    if (!S.next(0, cur)) return;
    f32x4 acc[2][2][4][2];
#pragma unroll
    for (int a = 0; a < 2; ++a)
#pragma unroll
        for (int b = 0; b < 2; ++b)
#pragma unroll
            for (int m = 0; m < 4; ++m)
#pragma unroll
                for (int n = 0; n < 2; ++n) acc[a][b][m][n] = (f32x4){0.f, 0.f, 0.f, 0.f};
    bf16x8 At[4][2], B0[2][2], B1[2][2];
    const char* cA = cur.a; const char* cB = cur.b;
    PG8_STAGE(PG8_SB(0, 0), cB, voffB); PG8_STAGE(PG8_SB(0, 1), cB + hstep, voffB); PG8_STAGE(PG8_SA(0, 0), cA, voffA); PG8_STAGE(PG8_SA(0, 1), cA + hstep, voffA);
    if (wr == 1) PG8_BAR;
    PG8_WAIT_V(2); PG8_BAR;
    PG8_STAGE(PG8_SB(1, 0), cB + kstep, voffB); PG8_STAGE(PG8_SA(1, 0), cA + kstep, voffA); PG8_STAGE(PG8_SB(1, 1), cB + hstep + kstep, voffB);
    PG8_WAIT_V(6); PG8_BAR;
    for (;;) {
        const bool has_next = S.next(ui + 1, nxt);
        const char* nA = has_next ? nxt.a : cA; const char* nB = has_next ? nxt.b : cB;
        for (int t = 0; t < nt; t += 2) {
            const bool last = (t == nt - 2);
            const char* a1 = cA + (size_t)(t + 1) * kstep;
            const char* a2 = last ? nA : cA + (size_t)(t + 2) * kstep; const char* b2 = last ? nB : cB + (size_t)(t + 2) * kstep;
            const char* a3 = a2 + kstep; const char* b3 = b2 + kstep;
            PG8_LDB(B0, 0, 0); PG8_LDB(B1, 0, 1); PG8_SCHED; PG8_LDA(At, 0, 0); PG8_STAGE(PG8_SA(1, 1), a1 + hstep, voffA);
            PG8_WAIT_V(8); PG8_WAIT_L(0); PG8_BAR; PG8_MMA(0, 0, At, B0); PG8_MMA(0, 1, At, B1); PG8_BAR; PG8_SCHED;
            PG8_LDA(At, 0, 1); PG8_STAGE(PG8_SB(0, 0), b2, voffB); PG8_STAGE(PG8_SB(0, 1), b2 + hstep, voffB); PG8_STAGE(PG8_SA(0, 0), a2, voffA);
            PG8_WAIT_V(8); PG8_WAIT_L(0); PG8_BAR; PG8_MMA(1, 0, At, B0); PG8_MMA(1, 1, At, B1); PG8_BAR; PG8_SCHED;
            PG8_LDB(B0, 1, 0); PG8_LDB(B1, 1, 1); PG8_SCHED; PG8_LDA(At, 1, 0); PG8_STAGE(PG8_SA(0, 1), a2 + hstep, voffA);
            PG8_WAIT_V(8); PG8_WAIT_L(0); PG8_BAR; PG8_MMA(0, 0, At, B0); PG8_MMA(0, 1, At, B1); PG8_BAR; PG8_SCHED;
            PG8_LDA(At, 1, 1); PG8_STAGE(PG8_SB(1, 0), b3, voffB); PG8_STAGE(PG8_SB(1, 1), b3 + hstep, voffB); PG8_STAGE(PG8_SA(1, 0), a3, voffA);
            PG8_WAIT_V(8); PG8_WAIT_L(0); PG8_BAR; PG8_MMA(1, 0, At, B0); PG8_MMA(1, 1, At, B1); PG8_BAR; PG8_SCHED;
        }
        if (wr == 0) PG8_BAR;
        E(acc, cur, wr, wc, fr, fq);
        if (!has_next) break;
        cur = nxt; cA = nA; cB = nB; ++ui;
        if (wr == 1) PG8_BAR;
    }
    PG8_WAIT_V(0);
    PG8_BAR;
#undef PG8_SA
#undef PG8_SB
#undef PG8_STAGE
#undef PG8_LDA
#undef PG8_LDB
#undef PG8_MMA
#undef PG8_WAIT_V
#undef PG8_WAIT_L
#undef PG8_BAR
#undef PG8_SCHED
}
#define ACC_T f32x4 (&acc)[2][2][4][2]
#define ZERO_ACC() do { _Pragma("unroll") for (int a_ = 0; a_ < 2; ++a_) _Pragma("unroll") for (int b_ = 0; b_ < 2; ++b_) _Pragma("unroll") for (int m_ = 0; m_ < 4; ++m_) \
    _Pragma("unroll") for (int n_ = 0; n_ < 2; ++n_) acc[a_][b_][m_][n_] = (f32x4){0.f, 0.f, 0.f, 0.f}; } while (0)

struct EpiInproj {
    static constexpr bool PERM = true;
    bf16_t* P; float* ABF;
    __device__ __forceinline__ void operator()(ACC_T, const Unit& u, int wr, int wc, int fr, int fq) const {
        const int row0 = u.pm * BM + wr * 64 + fr;
        if (u.pn < 54) {
            const bool gate = u.pn >= 30;
#pragma unroll
            for (int ai = 0; ai < 2; ++ai)
#pragma unroll
                for (int m = 0; m < 4; ++m) { bf16_t* rowp = P + (size_t)(row0 + ai * HALF + m * 16) * PW + u.pn * BM + wc * 32 + 8 * fq;
#pragma unroll
                    for (int bj = 0; bj < 2; ++bj) { f32x4 v0 = acc[ai][bj][m][0], v1 = acc[ai][bj][m][1];
                        if (gate) {
#pragma unroll
                            for (int j = 0; j < 4; ++j) { v0[j] = fast_sigmoid(v0[j]); v1[j] = fast_sigmoid(v1[j]); } }
                        u32x4 w; w.x = cvt_pk_bf16(v0[0], v0[1]); w.y = cvt_pk_bf16(v0[2], v0[3]); w.z = cvt_pk_bf16(v1[0], v1[1]); w.w = cvt_pk_bf16(v1[2], v1[3]);
                        *(u32x4*)(rowp + bj * HALF) = w; } }
        } else if (wc == 0) {
#pragma unroll
            for (int ai = 0; ai < 2; ++ai)
#pragma unroll
                for (int m = 0; m < 4; ++m) { float* rp = ABF + (size_t)(row0 + ai * HALF + m * 16) * 32 + 8 * fq;
                    *(f32x4*)rp = acc[ai][0][m][0]; *(f32x4*)(rp + 4) = acc[ai][0][m][1]; }
        }
        ZERO_ACC();
    }
};
struct EpiMerge {
    static constexpr bool PERM = true;
    const bf16_t* P; bf16_t* MG;
    __device__ __forceinline__ void operator()(ACC_T, const Unit& u, int wr, int wc, int fr, int fq) const {
        const int row0 = u.pm * BM + wr * 64 + fr, col0 = u.pn * BM + wc * 32 + 8 * fq;
        const int gcur = u.sub == 0 ? O_GA : (u.sub == 1 ? O_GB : O_GC), gnext = u.sub == 0 ? O_GB : O_GC;
#pragma unroll
        for (int ai = 0; ai < 2; ++ai)
#pragma unroll
            for (int m = 0; m < 4; ++m) { const size_t r = (size_t)(row0 + ai * HALF + m * 16);
#pragma unroll
                for (int bj = 0; bj < 2; ++bj) {
                    const u32x4 gc = *(const u32x4*)(P + r * PW + gcur + col0 + bj * HALF);
                    float sc[8]; sc[0] = __uint_as_float(gc.x << 16); sc[1] = __uint_as_float(gc.x & 0xffff0000u); sc[2] = __uint_as_float(gc.y << 16); sc[3] = __uint_as_float(gc.y & 0xffff0000u);
                    sc[4] = __uint_as_float(gc.z << 16); sc[5] = __uint_as_float(gc.z & 0xffff0000u); sc[6] = __uint_as_float(gc.w << 16); sc[7] = __uint_as_float(gc.w & 0xffff0000u);
#pragma unroll
                    for (int j = 0; j < 8; ++j) sc[j] = fmaxf(sc[j], 1e-20f);
                    if (u.sub < 2) {
                        const u32x4 gn = *(const u32x4*)(P + r * PW + gnext + col0 + bj * HALF);
                        float sn[8]; sn[0] = __uint_as_float(gn.x << 16); sn[1] = __uint_as_float(gn.x & 0xffff0000u); sn[2] = __uint_as_float(gn.y << 16); sn[3] = __uint_as_float(gn.y & 0xffff0000u);
                        sn[4] = __uint_as_float(gn.z << 16); sn[5] = __uint_as_float(gn.z & 0xffff0000u); sn[6] = __uint_as_float(gn.w << 16); sn[7] = __uint_as_float(gn.w & 0xffff0000u);
#pragma unroll
                        for (int j = 0; j < 8; ++j) { const float f = sc[j] * __builtin_amdgcn_rcpf(fmaxf(sn[j], 1e-20f)); if (j < 4) acc[ai][bj][m][0][j] *= f; else acc[ai][bj][m][1][j - 4] *= f; }
                    } else {
                        f32x4 v0 = acc[ai][bj][m][0], v1 = acc[ai][bj][m][1];
#pragma unroll
                        for (int j = 0; j < 4; ++j) { v0[j] *= sc[j]; v1[j] *= sc[4 + j]; }
                        u32x4 w; w.x = cvt_pk_bf16(v0[0], v0[1]); w.y = cvt_pk_bf16(v0[2], v0[3]); w.z = cvt_pk_bf16(v1[0], v1[1]); w.w = cvt_pk_bf16(v1[2], v1[3]);
                        *(u32x4*)(MG + r * D + col0 + bj * HALF) = w;
                        acc[ai][bj][m][0] = (f32x4){0.f, 0.f, 0.f, 0.f}; acc[ai][bj][m][1] = (f32x4){0.f, 0.f, 0.f, 0.f};
                    } }
                asm volatile("" ::: "memory"); }
    }
};
struct EpiResid {
    static constexpr bool PERM = false;
    float* X; const float* modl; int goff; const float* xl; const float* xc;
    __device__ __forceinline__ void operator()(ACC_T, const Unit& u, int wr, int wc, int fr, int fq) const {
        const int row0 = u.pm * BM + wr * 64 + fr, col0 = u.pn * BM + wc * 32 + 4 * fq;
        const float* g = modl + (size_t)batch_of(u.pm * BM) * MOD_W + goff + col0;
        f32x4 gv[2][2];
#pragma unroll
        for (int bj = 0; bj < 2; ++bj)
#pragma unroll
            for (int n = 0; n < 2; ++n) gv[bj][n] = *(const f32x4*)(g + bj * HALF + n * 16);
#pragma unroll
        for (int ai = 0; ai < 2; ++ai)
#pragma unroll
            for (int m = 0; m < 4; ++m) { float* rowp = X + (size_t)(row0 + ai * HALF + m * 16) * D + col0;
#pragma unroll
                for (int bj = 0; bj < 2; ++bj)
#pragma unroll
                    for (int n = 0; n < 2; ++n) { f32x4* p = (f32x4*)(rowp + bj * HALF + n * 16); const int rr_ = row0 + ai * HALF + m * 16;
                        const f32x4* q_ = xl ? (const f32x4*)((rr_ < NL ? xl + (size_t)rr_ * D : xc + (size_t)(rr_ - NL) * D) + col0 + bj * HALF + n * 16) : (const f32x4*)p;
                        *p = *q_ + gv[bj][n] * acc[ai][bj][m][n]; } }
        ZERO_ACC();
    }
};
struct EpiSwiglu {
    static constexpr bool PERM = true;
    bf16_t* ACT;
    __device__ __forceinline__ void operator()(ACC_T, const Unit& u, int wr, int wc, int fr, int fq) const {
        const int row0 = u.pm * BM + wr * 64 + fr, col0 = u.pn * HALF + wc * 32 + 8 * fq;
#pragma unroll
        for (int ai = 0; ai < 2; ++ai)
#pragma unroll
            for (int m = 0; m < 4; ++m) { f32x4 o[2];
#pragma unroll
                for (int n = 0; n < 2; ++n)
#pragma unroll
                    for (int j = 0; j < 4; ++j) { const float gt = acc[ai][0][m][n][j]; o[n][j] = gt * fast_sigmoid(gt) * acc[ai][1][m][n][j]; }
                u32x4 w; w.x = cvt_pk_bf16(o[0][0], o[0][1]); w.y = cvt_pk_bf16(o[0][2], o[0][3]); w.z = cvt_pk_bf16(o[1][0], o[1][1]); w.w = cvt_pk_bf16(o[1][2], o[1][3]);
                *(u32x4*)(ACT + (size_t)(row0 + ai * HALF + m * 16) * DFF + col0) = w; }
        ZERO_ACC();
    }
};
struct EpiStoreF32 {
    static constexpr bool PERM = false;
    float* C;
    __device__ __forceinline__ void operator()(ACC_T, const Unit& u, int wr, int wc, int fr, int fq) const {
        const int row0 = u.pm * BM + wr * 64 + fr, col0 = u.pn * BM + wc * 32 + 4 * fq;
#pragma unroll
        for (int ai = 0; ai < 2; ++ai)
#pragma unroll
            for (int m = 0; m < 4; ++m) { float* rowp = C + (size_t)(row0 + ai * HALF + m * 16) * D + col0;
#pragma unroll
                for (int bj = 0; bj < 2; ++bj)
#pragma unroll
                    for (int n = 0; n < 2; ++n) *(f32x4*)(rowp + bj * HALF + n * 16) = acc[ai][bj][m][n]; }
        ZERO_ACC();
    }
};

struct EpiAtomicF32 {
    static constexpr bool PERM = false;
    float* C;
    __device__ __forceinline__ void operator()(ACC_T, const Unit& u, int wr, int wc, int fr, int fq) const {
        const int row0 = u.pm * BM + wr * 64 + fr, col0 = u.pn * BM + wc * 32 + 4 * fq;
#pragma unroll
        for (int ai = 0; ai < 2; ++ai)
#pragma unroll
            for (int m = 0; m < 4; ++m) { float* rowp = C + (size_t)(row0 + ai * HALF + m * 16) * D + col0;
#pragma unroll
                for (int bj = 0; bj < 2; ++bj)
#pragma unroll
                    for (int n = 0; n < 2; ++n)
#pragma unroll
                        for (int j = 0; j < 4; ++j) (void)__hip_atomic_fetch_add(rowp + bj * HALF + n * 16 + j, acc[ai][bj][m][n][j], __ATOMIC_RELAXED, __HIP_MEMORY_SCOPE_AGENT); }
        ZERO_ACC();
    }
};
struct PlainOrder {
    const char* A; const char* B; int nM, nN, G, c; size_t tstep;
    __device__ __forceinline__ bool next(int i, Unit& u) const {
        const int L = i * G + c; if (c >= G || L >= nM * nN) return false;
        tile_of(L, nM, nN, u.pm, u.pn); u.sub = 0; u.aux = 0; u.a = A + (size_t)u.pm * tstep; u.b = B + (size_t)u.pn * tstep; return true;
    }
};
struct InprojOrder {
    const char* A; const char* B; int nM1, nctx, G, c; size_t tstep;
    __device__ __forceinline__ bool next(int i, Unit& u) const {
        const int L = i * G + c, n1 = nM1 * 55; u.sub = 0; u.aux = 0;
        if (c >= G) return false;
        if (L < n1) tile_of(L, nM1, 55, u.pm, u.pn);
        else { const int r = L - n1; if (r >= nctx * 17) return false; const int j = r % 17; u.pm = 32 + r / 17;
            u.pn = j < 8 ? 4 + j : (j < 10 ? 14 + (j - 8) : (j < 14 ? 16 + (j - 10) : (j < 16 ? 28 + (j - 14) : 54))); }
        u.a = A + (size_t)u.pm * tstep; u.b = B + (size_t)u.pn * tstep; return true;
    }
};
struct MergeOrder {
    const char* A0; size_t sA; const char* B0; size_t sB; int nM, G, c;
    __device__ __forceinline__ bool next(int i, Unit& u) const {
        const int T = (i / 3) * G + c; if (c >= G || T >= nM * 8) return false;
        tile_of(T, nM, 8, u.pm, u.pn); u.sub = i % 3; u.aux = 0;
        const size_t ts = (size_t)256 * 1024 * 2;
        u.a = A0 + (size_t)u.sub * sA + (size_t)u.pm * ts; u.b = B0 + (size_t)u.sub * sB + (size_t)u.pn * ts; return true;
    }
};
struct MoeOrder {
    const char* A; const char* B; int nN, G, c; size_t tstep, estride; const unsigned* cnt; int full_only;
    __device__ __forceinline__ bool next(int i, Unit& u) const {
        int e = 0, acc = 0, nblk = 0; const int L = i * G + c; u.pn = L % nN; u.pm = L / nN; u.sub = 0;
#pragma unroll
        for (int j = 0; j < 8; ++j) { const int cj = (int)__hip_atomic_load(cnt + j, __ATOMIC_RELAXED, __HIP_MEMORY_SCOPE_AGENT); acc += (cj + 255) / 256; if (j < 7) e += (u.pm >= acc) ? 1 : 0; }
        nblk = acc < 72 ? acc : 72;
        const int total = nblk * nN, lim = full_only ? (total / G) * G : total;
        if (L >= lim) return false;
        u.aux = e; u.a = A + (size_t)u.pm * tstep; u.b = B + (size_t)e * estride + (size_t)u.pn * tstep; return true;
    }
};
struct MoeTailOrder {
    const char* A; const char* B; int G, c; size_t tstep, estride; const unsigned* cnt;
    __device__ __forceinline__ bool next(int i, Unit& u) const {
        int acc = 0; int pend[8];
#pragma unroll
        for (int j = 0; j < 8; ++j) { const int cj = (int)__hip_atomic_load(cnt + j, __ATOMIC_RELAXED, __HIP_MEMORY_SCOPE_AGENT); acc += (cj + 255) / 256; pend[j] = acc; }
        const int nblk = acc < 72 ? acc : 72, total = nblk * 8, nfull = (total / G) * G, R = total - nfull;
        const int s = i * G + c; if (s >= 4 * R) return false;
        const int L = nfull + (s >> 2), q = s & 3; u.pn = L % 8; u.pm = L / 8; u.sub = q;
        int e = 0;
#pragma unroll
        for (int j = 0; j < 7; ++j) e += (u.pm >= pend[j]) ? 1 : 0;
        u.aux = e; u.a = A + (size_t)u.pm * tstep + (size_t)q * 1408 * 2; u.b = B + (size_t)e * estride + (size_t)u.pn * tstep + (size_t)q * 1408 * 2; return true;
    }
};
template <class Order>
__device__ __forceinline__ int fill_table(const Order& O, LAS UnitRec* tab, LAS int* ncell) {
    __syncthreads();
    int ti = threadIdx.x; asm volatile("" : "+v"(ti));
    if (ti < 64) {
        Unit u; const bool ok = O.next(ti, u);
        if (ok) { UnitRec r; r.a_lo = (unsigned)(unsigned long long)u.a; r.a_hi = (unsigned)((unsigned long long)u.a >> 32); r.b_lo = (unsigned)(unsigned long long)u.b; r.b_hi = (unsigned)((unsigned long long)u.b >> 32);
            r.pm = u.pm; r.pn = u.pn; r.sub = u.sub; r.aux = u.aux; LAS unsigned* t = (LAS unsigned*)(tab + ti);
            t[0] = r.a_lo; t[1] = r.a_hi; t[2] = r.b_lo; t[3] = r.b_hi; t[4] = (unsigned)r.pm; t[5] = (unsigned)r.pn; t[6] = (unsigned)r.sub; t[7] = (unsigned)r.aux; }
        const unsigned long long m = __ballot(ok);
        if (ti == 0) *ncell = __popcll(m);
    }
    __syncthreads();
    return __builtin_amdgcn_readfirstlane(*ncell);
}
}

constexpr size_t MiB = 1u << 20;
constexpr size_t al(size_t x) { return (x + 4095) & ~(size_t)4095; }
constexpr size_t WS_CTL = 0, CTL_BYTES = 1 * MiB;
constexpr size_t WS_MODP = WS_CTL + CTL_BYTES;
constexpr size_t WS_MOD = WS_MODP + al((size_t)16 * 2 * 5 * MOD_W * 4);
constexpr size_t WS_XR = WS_MOD + al((size_t)2 * 5 * MOD_W * 4);
constexpr size_t WS_H = WS_XR + al((size_t)NR * D * 4);
constexpr size_t WS_HS = WS_H + al((size_t)NR * D * 2);
constexpr size_t WS_P = WS_HS + al((size_t)NSLOT * D * 2);
constexpr size_t WS_ABF = WS_P + al((size_t)NR * PW * 2);
constexpr size_t WS_LG = WS_ABF + al((size_t)NR * 32 * 4);
constexpr size_t WS_OG = WS_LG + al((size_t)2 * NR * 512 * 4);
constexpr size_t WS_AO = WS_OG + al((size_t)2 * NR * 1024 * 4);
constexpr size_t WS_BO = WS_AO + al((size_t)NR * 1024 * 2);
constexpr size_t WS_CO = WS_BO + al((size_t)NR * 1024 * 2);
constexpr size_t WS_MG = WS_CO + al((size_t)NR * 1024 * 2);
constexpr size_t WS_ACT = WS_MG + al((size_t)NR * D * 2);
constexpr size_t WS_RT = WS_ACT + al((size_t)NSLOT * DFF * 2);
constexpr size_t WS_WIN = WS_RT + al((size_t)NL * 2 * 4 * 3);
constexpr size_t WS_WP = WS_WIN + al((size_t)2 * NIN * D * 2);
constexpr size_t WS_WOUT = WS_WP + al((size_t)2 * 3 * D * 1024 * 2);
constexpr size_t WS_DGU = WS_WOUT + al((size_t)2 * D * D * 2);
constexpr size_t WS_DDN = WS_DGU + al((size_t)2 * DFF * D * 2);
constexpr size_t WS_MGU = WS_DDN + al((size_t)D * DFF * 2);
constexpr size_t WS_MDN = WS_MGU + al((size_t)NE * 2 * DFF * D * 2);
constexpr size_t WS_VT = WS_MDN + al((size_t)NE * D * DFF * 2);
constexpr size_t WS_QT = WS_VT + al((size_t)NB * 2304 * 2304 * 2);
constexpr size_t WS_KV = WS_QT + al((size_t)2 * NR * 512 * 2);
constexpr size_t WS_DEC = WS_KV + al((size_t)1152 * 256 * 128 * 2);
constexpr size_t WS_QKN = WS_DEC + al((size_t)1152 * 128 * 4);
constexpr size_t WS_ROPE = WS_QKN + al((size_t)NR * 1280 * 2);
constexpr size_t WS_KVG = WS_ROPE + al((size_t)S * 64 * 8);
constexpr size_t WS_END = WS_KVG + al((size_t)NB * 2304 * 512 * 2);
static_assert((size_t)1152 * 256 * 128 * 2 <= (size_t)NSLOT * DFF * 2, "KVS (scan output) aliases ACT");
static_assert((size_t)NSLOT * D * 4 <= (size_t)NR * PW * 2, "Y2 fits in P");
constexpr int CW_BAR = 4096;
constexpr int CW_CNT = 16384;

constexpr int RING_BYTES = 131072, MISC_OFF = RING_BYTES + 320, UTAB_OFF = MISC_OFF + 128, LDS_BYTES = 147456;

struct Params { const float* in[28]; float* out; unsigned char* ws; int ph_lo, ph_hi; };

struct Ctx { LAS unsigned char* lds; int tid, lane, wave, bid, nb; };

__device__ __forceinline__ void ph_mod_partial(const Ctx& F, const float* c, const float* cctx, const float* w_ada, float* MODP) {
    LAS float* ca = (LAS float*)F.lds;
    for (int i = F.tid; i < 5 * D; i += NTHR) { const int r = i / D, k = i % D; const float v = r < 4 ? c[r * D + k] : cctx[k]; ca[i] = siluf_(v); }
    __syncthreads();
    for (int u = F.bid; u < 2 * 24 * 16; u += F.nb) {
        const int kc = u % 16, cb = (u / 16) % 24, layer = u / (16 * 24);
        const int j = cb * 512 + F.tid;
        const float* w = w_ada + ((size_t)layer * D + kc * 128) * MOD_W + j;
        float acc[5] = {0.f, 0.f, 0.f, 0.f, 0.f};
#pragma unroll 8
        for (int k = 0; k < 128; ++k) { const float wv = w[(size_t)k * MOD_W];
#pragma unroll
            for (int r = 0; r < 5; ++r) acc[r] += ca[r * D + kc * 128 + k] * wv; }
#pragma unroll
        for (int r = 0; r < 5; ++r) MODP[(((size_t)kc * 2 + layer) * 5 + r) * MOD_W + j] = acc[r];
    }
    __syncthreads();
}
__device__ __forceinline__ void ph_rope_table(const Ctx& F, float* ROPE) {
    for (int i = F.bid * NTHR + F.tid; i < S * 64; i += F.nb * NTHR) {
        const int t = i >> 6, pp = i & 63, j = pp & 31; const float pos = pp < 32 ? (float)(t / GW) : (float)(t % GW);
        const float ang = pos * powf(10000.f, -(float)(2 * j) / 64.f);
        ROPE[2 * i] = cosf(ang); ROPE[2 * i + 1] = sinf(ang);
    }
}
__device__ __forceinline__ void ph_mod_reduce(const Ctx& F, const float* MODP, const float* b_ada, float* MOD) {
    for (int i = F.bid * NTHR + F.tid; i < 2 * 5 * MOD_W; i += F.nb * NTHR) {
        const int j = i % MOD_W, layer = i / (5 * MOD_W);
        float s = b_ada[layer * MOD_W + j];
        for (int kc = 0; kc < 16; ++kc) s += MODP[(size_t)kc * 2 * 5 * MOD_W + i];
        MOD[i] = s;
    }
}
struct CvtJob { const float* src; bf16_t* dst; int K, Nsrc, nblk  , map  ; const float* src2; };
__device__ __forceinline__ const float* cvt_src(const CvtJob& J, int g32  , int& col) {
    const float* src = J.src; col = g32 * 32;
    if (J.map == 1) { if (g32 < 192) col = g32 * 32; else if (g32 < 432) col = g32 * 32 + 32; else if (g32 == 432) col = S_AF; else src = nullptr; }
    else if (J.map == 2) { const int tile = g32 >> 3, j = g32 & 7; col = tile * 128 + 32 * (j & 3); if (j >= 4) src = J.src2; }
    return src;
}
__device__ __forceinline__ void cvt_load(const CvtJob& J, int kb, int nbp, int tid, f32x4 (&v)[8]) {
    const int w = tid >> 6, lane = tid & 63, kg = lane & 7, nq = lane >> 3;
    int col; const float* src = cvt_src(J, nbp * 8 + w, col);
    const int k0 = kb * 64 + kg * 8;
    if (src) {
#pragma unroll
        for (int j = 0; j < 8; ++j) v[j] = __builtin_nontemporal_load((const f32x4*)(src + (size_t)(k0 + j) * J.Nsrc + col + 4 * nq));
    } else {
#pragma unroll
        for (int j = 0; j < 8; ++j) v[j] = (f32x4){0.f, 0.f, 0.f, 0.f};
    }
}
__device__ __forceinline__ void cvt_store(const CvtJob& J, int kb, int nbp, int tid, const f32x4 (&v)[8]) {
    const int w = tid >> 6, lane = tid & 63, kg = lane & 7, nq = lane >> 3;
    const int k0 = kb * 64 + kg * 8, r0 = nbp * 256 + 32 * w + 4 * nq;
#pragma unroll
    for (int i = 0; i < 4; ++i) {
        u32x4 wv; wv.x = cvt_pk_bf16(v[0][i], v[1][i]); wv.y = cvt_pk_bf16(v[2][i], v[3][i]); wv.z = cvt_pk_bf16(v[4][i], v[5][i]); wv.w = cvt_pk_bf16(v[6][i], v[7][i]);
        __builtin_nontemporal_store(wv, (u32x4*)(J.dst + (size_t)(r0 + i) * J.K + k0));
    }
}
#define GF(k) ((const float*)(const GAS float*)p.in[k])
__device__ __forceinline__ void ph_convert(const Ctx& F, const Params& p) {
    unsigned char* ws = (unsigned char*)(GAS unsigned char*)p.ws;
    int base = 0;
#define CVT_RUN(SRC, SRC2, DST, KK, NSRC, NBLK, MAP) do { CvtJob J{SRC, DST, KK, NSRC, NBLK, MAP, SRC2}; const int nk = (KK) / 64, nit = nk * ((NBLK) / 2); \
        int it = (F.bid - base % F.nb + F.nb) % F.nb; \
        for (; it < nit; it += 2 * F.nb) { f32x4 va[8], vb[8]; const int it2 = it + F.nb; cvt_load(J, it % nk, it / nk, F.tid, va); if (it2 < nit) cvt_load(J, it2 % nk, it2 / nk, F.tid, vb); \
            cvt_store(J, it % nk, it / nk, F.tid, va); if (it2 < nit) cvt_store(J, it2 % nk, it2 / nk, F.tid, vb); } base += nit; } while (0)
    CVT_RUN(GF(8), nullptr, (bf16_t*)(ws + WS_WIN), D, DIN, NIN / 128, 1);
    CVT_RUN(GF(15), nullptr, (bf16_t*)(ws + WS_WP) + (size_t)0 * D * 1024, 1024, D, D / 128, 0);
    CVT_RUN(GF(16), nullptr, (bf16_t*)(ws + WS_WP) + (size_t)1 * D * 1024, 1024, D, D / 128, 0);
    CVT_RUN(GF(17), nullptr, (bf16_t*)(ws + WS_WP) + (size_t)2 * D * 1024, 1024, D, D / 128, 0);
    CVT_RUN(GF(18), nullptr, (bf16_t*)(ws + WS_WOUT), D, D, D / 128, 0);
#undef CVT_RUN
}
constexpr int BG_WIN = 1760, BG_WP = 128, BG_WOUT = 256, BG_MGU = 1408, BG_MDN = 704, BG_DENSE = BG_MGU + BG_MDN, BG_TOTAL = BG_DENSE + BG_WIN + 3 * BG_WP + BG_WOUT + NE * (BG_MGU + BG_MDN);
__device__ __forceinline__ void bg_item(const Params& p, int t, CvtJob& J, int& kb, int& nbp) {
    unsigned char* ws = (unsigned char*)(GAS unsigned char*)p.ws;
    if (t < BG_MGU) { J = CvtJob{GF(19), (bf16_t*)(ws + WS_DGU), D, DFF, 2 * DFF / 128, 2, GF(20)}; }
    else if ((t -= BG_MGU) < BG_MDN) { J = CvtJob{GF(21), (bf16_t*)(ws + WS_DDN), DFF, D, D / 128, 0, nullptr}; }
    else if ((t -= BG_MDN) < BG_WIN) { J = CvtJob{GF(8) + (size_t)D * DIN, (bf16_t*)(ws + WS_WIN) + (size_t)NIN * D, D, DIN, NIN / 128, 1, nullptr}; }
    else if ((t -= BG_WIN) < 3 * BG_WP) { const int br = t / BG_WP; t -= br * BG_WP;
        J = CvtJob{(br == 0 ? GF(15) : (br == 1 ? GF(16) : GF(17))) + (size_t)1024 * D, (bf16_t*)(ws + WS_WP) + (size_t)(3 + br) * D * 1024, 1024, D, D / 128, 0, nullptr}; }
    else if ((t -= 3 * BG_WP) < BG_WOUT) { J = CvtJob{GF(18) + (size_t)D * D, (bf16_t*)(ws + WS_WOUT) + (size_t)D * D, D, D, D / 128, 0, nullptr}; }
    else if ((t -= BG_WOUT) < NE * BG_MGU) { const int e = t / BG_MGU; t -= e * BG_MGU;
        J = CvtJob{GF(24) + (size_t)e * D * DFF, (bf16_t*)(ws + WS_MGU) + (size_t)e * 2 * DFF * D, D, DFF, 2 * DFF / 128, 2, GF(25) + (size_t)e * D * DFF}; }
    else { t -= NE * BG_MGU; const int e = t / BG_MDN; t -= e * BG_MDN;
        J = CvtJob{GF(26) + (size_t)e * DFF * D, (bf16_t*)(ws + WS_MDN) + (size_t)e * D * DFF, DFF, D, D / 128, 0, nullptr}; }
    const int nk = J.K / 64; kb = t % nk; nbp = t / nk;
}
__device__ __forceinline__ void bg_convert(const Ctx& F, const Params& p, int t0, int n) {
    int t1 = t0 + n; if (t1 > BG_TOTAL) t1 = BG_TOTAL;
    for (int t = t0; t < t1; t += 2) {
        CvtJob Ja, Jb; int ka, na, kb2, nb2; f32x4 va[8], vb[8];
        bg_item(p, t, Ja, ka, na); cvt_load(Ja, ka, na, F.tid, va);
        const bool two = t + 1 < t1;
        if (two) { bg_item(p, t + 1, Jb, kb2, nb2); cvt_load(Jb, kb2, nb2, F.tid, vb); }
        cvt_store(Ja, ka, na, F.tid, va);
        if (two) cvt_store(Jb, kb2, nb2, F.tid, vb);
    }
}
#undef GF
template <bool ROUTER>
__device__ __forceinline__ void ph_norm(const Ctx& F, const float* X, const float* Xc  , const float* g, const float* modl, int sh_off, int sc_off, bf16_t* H, int rows,
                                        const float* rw, const float* rb, int* tok_e, float* tok_w) {
    const int rstep = F.nb * NWAVES;
    f32x4 nx[8];
    { const int row0 = F.bid * NWAVES + F.wave; if (row0 < rows) { const f32x4* xr = (const f32x4*)((Xc && row0 >= NL) ? Xc + (size_t)(row0 - NL) * D : X + (size_t)row0 * D) + F.lane;
#pragma unroll
        for (int j = 0; j < 8; ++j) nx[j] = xr[64 * j]; } }
    for (int row = F.bid * NWAVES + F.wave; row < rows; row += rstep) {
        f32x4 v[8]; float ss = 0.f;
#pragma unroll
        for (int j = 0; j < 8; ++j) { v[j] = nx[j]; ss += v[j][0] * v[j][0] + v[j][1] * v[j][1] + v[j][2] * v[j][2] + v[j][3] * v[j][3]; }
        if (row + rstep < rows) { const int rn_ = row + rstep; const f32x4* xr = (const f32x4*)((Xc && rn_ >= NL) ? Xc + (size_t)(rn_ - NL) * D : X + (size_t)rn_ * D) + F.lane;
#pragma unroll
            for (int j = 0; j < 8; ++j) nx[j] = xr[64 * j]; }
        ss = wave_sum(ss);
        const float rs = rsqrtf(ss * (1.f / D) + EPS);
        const float* mb = modl + (size_t)batch_of(row) * MOD_W;
        float lg[8];
        if (ROUTER) {
#pragma unroll
            for (int e = 0; e < 8; ++e) lg[e] = 0.f; }
#pragma unroll
        for (int j = 0; j < 8; ++j) { const int c = 4 * F.lane + 256 * j;
            const f32x4 gg = *(const f32x4*)(g + c), sc = *(const f32x4*)(mb + sc_off + c), sh = *(const f32x4*)(mb + sh_off + c);
            f32x4 y;
#pragma unroll
            for (int i = 0; i < 4; ++i) y[i] = v[j][i] * rs * gg[i] * (1.f + sc[i]) + sh[i];
            u32x2 w; w.x = pk2(y[0], y[1]); w.y = pk2(y[2], y[3]);
            *(u32x2*)(H + (size_t)row * D + c) = w;
            if (ROUTER) {
#pragma unroll
                for (int i = 0; i < 4; ++i) { const f32x4 w0 = *(const f32x4*)(rw + (size_t)(c + i) * 8), w1 = *(const f32x4*)(rw + (size_t)(c + i) * 8 + 4);
#pragma unroll
                    for (int e = 0; e < 4; ++e) { lg[e] += y[i] * w0[e]; lg[4 + e] += y[i] * w1[e]; } } }
        }
        if (ROUTER) {
#pragma unroll
            for (int e = 0; e < 8; ++e) lg[e] = wave_sum(lg[e]) + rb[e];
            if (F.lane == 0) {
                int i0 = 0;
#pragma unroll
                for (int e = 1; e < 8; ++e) if (lg[e] > lg[i0]) i0 = e;
                int i1 = -1;
#pragma unroll
                for (int e = 0; e < 8; ++e) if (e != i0 && (i1 < 0 || lg[e] > lg[i1])) i1 = e;
                const float e1 = expf(lg[i1] - lg[i0]); const float w0 = 1.f / (1.f + e1);
                tok_e[row * 2] = i0; tok_e[row * 2 + 1] = i1; tok_w[row * 2] = w0; tok_w[row * 2 + 1] = e1 * w0;
            } }
    }
}
__device__ __forceinline__ void ph_prep(const Ctx& F, const bf16_t* P, const float* ROPE, bf16_t* QKN, bf16_t* KVGb, const float* ABF, const float* qn_g, const float* kn_g, const float* w_a2, const float* b_a, float* LG) {
    typedef float f32x2 __attribute__((ext_vector_type(2)));
    const f32x2 gq = *(const f32x2*)(qn_g + 2 * F.lane), gk = *(const f32x2*)(kn_g + 2 * F.lane);
    for (int r = F.bid * NWAVES + F.wave; r < NR; r += F.nb * NWAVES) {
        const bf16_t* pr = P + (size_t)r * PW + 2 * F.lane;
        unsigned v[10];
#pragma unroll
        for (int hh = 0; hh < 10; ++hh) v[hh] = *(const unsigned*)(pr + (hh < 8 ? O_GQQ + hh * 128 : O_GQK + (hh - 8) * 128));
        const unsigned vv0 = *(const unsigned*)(pr + O_GQV), vv1 = *(const unsigned*)(pr + O_GQV + 128);
        bf16_t* kvrow = KVGb + ((size_t)(r < NL ? (r >> 11) * 2304 + (r & (S - 1)) : ((r - NL) >> 8) * 2304 + S + ((r - NL) & (LC - 1)))) * 512;
        f32x2 cs2 = (f32x2){1.f, 0.f};
        if (r < NL) cs2 = *(const f32x2*)(ROPE + ((size_t)(r & (S - 1)) * 64 + F.lane) * 2);
#pragma unroll
        for (int hh = 0; hh < 10; ++hh) {
            float x1 = __uint_as_float(v[hh] << 16), x2 = __uint_as_float(v[hh] & 0xffff0000u);
            const float ss = wave_sum(x1 * x1 + x2 * x2);
            const float rs = rsqrtf(ss * (1.f / 128.f) + EPS);
            const f32x2 gg = hh < 8 ? gq : gk;
            x1 = x1 * rs * gg.x; x2 = x2 * rs * gg.y;
            const float o1 = x1 * cs2.x - x2 * cs2.y, o2 = x1 * cs2.y + x2 * cs2.x;
            if (hh < 8) *(unsigned*)(QKN + (size_t)r * 1280 + hh * 128 + 2 * F.lane) = pk2(o1, o2);
            else *(unsigned*)(kvrow + (hh - 8) * 128 + 2 * F.lane) = pk2(o1, o2);
        }
        *(unsigned*)(kvrow + 256 + 2 * F.lane) = vv0; *(unsigned*)(kvrow + 384 + 2 * F.lane) = vv1;
    }
    {
        const int c = F.tid;
        float w0[16], w1[16];
#pragma unroll
        for (int j = 0; j < 16; ++j) { w0[j] = w_a2[j * 512 + c]; w1[j] = w_a2[(16 + j) * 512 + c]; }
        const float b0 = b_a[c], b1 = b_a[512 + c];
        float an = 0.f;
        if (F.bid < NR) an = ABF[(size_t)F.bid * 32 + (F.lane & 31)];
        for (int r = F.bid; r < NR; r += F.nb) {
            const float a = an;
            if (r + F.nb < NR) an = ABF[(size_t)(r + F.nb) * 32 + (F.lane & 31)];
            float z0 = b0, z1 = b1;
#pragma unroll
            for (int j = 0; j < 16; ++j) { z0 += __uint_as_float(__builtin_amdgcn_readlane(__float_as_uint(a), j)) * w0[j]; z1 += __uint_as_float(__builtin_amdgcn_readlane(__float_as_uint(a), 16 + j)) * w1[j]; }
            const float l0 = fminf(z0, 0.f) - 0.6931471805599453f * __builtin_amdgcn_logf(1.f + __builtin_amdgcn_exp2f(-fabsf(z0) * LOG2E));
            const float l1 = fminf(z1, 0.f) - 0.6931471805599453f * __builtin_amdgcn_logf(1.f + __builtin_amdgcn_exp2f(-fabsf(z1) * LOG2E));
            LG[(size_t)r * 512 + c] = l0 * (1.f / 16.f); LG[((size_t)NR + r) * 512 + c] = l1 * (1.f / 16.f);
        }
    }
}
__device__ __forceinline__ void ph_vt(const Ctx& F, const bf16_t* P, bf16_t* VT) {
    LAS bf16_t* T = (LAS bf16_t*)F.lds;
    const int r = F.tid >> 3, ch = F.tid & 7;
#define VT_SRC(it_) ({ const int b_ = (it_) / (36 * 36), ct_ = ((it_) / 36) % 36, tt_ = (it_) % 36; const int c0_ = ct_ * 64, pc_ = c0_ < 1024 ? O_NAV + c0_ : (c0_ < 2048 ? O_GLV + (c0_ - 1024) : O_GQV + (c0_ - 2048)); \
        const int tok0_ = tt_ * 64, row0_ = tok0_ < S ? b_ * S + tok0_ : NL + b_ * LC + (tok0_ - S); (const u32x4*)(P + (size_t)(row0_ + r) * PW + pc_ + ch * 8); })
    u32x4 nx = (u32x4){0u, 0u, 0u, 0u};
    if (F.bid < NB * 36 * 36) nx = *VT_SRC(F.bid);
    for (int it = F.bid; it < NB * 36 * 36; it += F.nb) {
        const int b = it / (36 * 36), ct = (it / 36) % 36, tt = it % 36, c0 = ct * 64, tok0 = tt * 64;
        const u32x4 v = nx;
        if (it + F.nb < NB * 36 * 36) nx = *VT_SRC(it + F.nb);
        __syncthreads();
        *(LAS u32x4*)(T + r * 72 + ch * 8) = v;
        __syncthreads();
        { const int c = F.tid >> 3, tc = F.tid & 7; unsigned w[4];
#pragma unroll
          for (int j = 0; j < 4; ++j) w[j] = (unsigned)T[(8 * tc + 2 * j) * 72 + c] | ((unsigned)T[(8 * tc + 2 * j + 1) * 72 + c] << 16);
          *(u32x4*)(VT + ((size_t)b * 2304 + c0 + c) * 2304 + tok0 + 8 * tc) = (u32x4){w[0], w[1], w[2], w[3]}; }
    }
#undef VT_SRC
    __syncthreads();
}
#define MFMA16(a, b, c) __builtin_amdgcn_mfma_f32_16x16x32_bf16((a), (b), (c), 0, 0, 0)
__device__ __forceinline__ void ph_na(const Ctx& F, const bf16_t* P, const bf16_t* VT, const float* rpb, bf16_t* AO, int u_lo, int u_hi) {
    const int lane = F.lane, fr = lane & 15, g = lane >> 4;
    LAS float* bias_s = (LAS float*)F.lds + F.wave * 640 + 64;
    const int kperm = 8 * (fr >> 2) + (fr & 3);
    for (int u = u_lo + F.bid * NWAVES + F.wave; u < u_hi; u += F.nb * NWAVES) {
        const bool lat = u < 2048;
        int b, h, r = 0, qrow0;
        if (lat) { b = u >> 9; r = (u >> 4) & 31; h = u & 15; qrow0 = b * S + r * GW; }
        else { const int v = u - 2048; b = v >> 6; h = v & 15; qrow0 = NL + b * LC + ((v >> 4) & 3) * 64; }
        if (lat) { for (int i = lane; i < 465; i += 64) bias_s[i] = rpb[h * 465 + i] * LOG2E; }
        bf16x8 Qf[4][2];
#pragma unroll
        for (int nq = 0; nq < 4; ++nq)
#pragma unroll
            for (int ks = 0; ks < 2; ++ks) Qf[nq][ks] = *(const bf16x8*)(P + (size_t)(qrow0 + 16 * nq + fr) * PW + O_NAQ + h * 64 + 32 * ks + 8 * g);
        f32x4 O[4][4]; float m[4], l[4];
        int dcb[4], dlo[4];
#pragma unroll
        for (int nq = 0; nq < 4; ++nq) { m[nq] = -1e30f; l[nq] = 0.f; const int qcol = 16 * nq + fr, c0 = min(max(qcol - 8, 0), 48); dcb[nq] = 8 * g - qcol + 15; dlo[nq] = 8 * g - c0;
#pragma unroll
            for (int db = 0; db < 4; ++db) O[nq][db] = (f32x4){0.f, 0.f, 0.f, 0.f}; }
        const int r0 = min(max(r - 4, 0), 24);
        const int ntile = lat ? 12 : 4;
        __builtin_amdgcn_s_waitcnt(0); __builtin_amdgcn_wave_barrier();
#define NA_KADDR(s_, t_, ks_) ({ const int ti_ = (s_) >> 1, kb_ = (s_) & 1; const int kr_ = ti_ < 4 ? NL + b * LC + ti_ * 64 : b * S + (r0 + ti_ - 4) * GW; \
            (const bf16x8*)(P + (size_t)(kr_ + 32 * kb_ + kperm + 4 * (t_)) * PW + O_NAK + h * 64 + 32 * (ks_) + 8 * g); })
        const int nstep = 2 * ntile;
#define NA_VADDR(s_, db_) ({ const int ti_ = (s_) >> 1, kb_ = (s_) & 1; const int vt_ = ti_ < 4 ? S + ti_ * 64 : (r0 + ti_ - 4) * GW; \
            (const bf16x8*)(VT + ((size_t)b * 2304 + h * 64 + 16 * (db_) + fr) * 2304 + vt_ + 32 * kb_ + 8 * g); })
        bf16x8 Kn[2][2], Vn[4];
#pragma unroll
        for (int t = 0; t < 2; ++t)
#pragma unroll
            for (int ks = 0; ks < 2; ++ks) Kn[t][ks] = *NA_KADDR(0, t, ks);
#pragma unroll
        for (int db = 0; db < 4; ++db) Vn[db] = *NA_VADDR(0, db);
#pragma unroll 1
        for (int st = 0; st < nstep; ++st) {
            const int ti = st >> 1, kb = st & 1;
            const bool ctile = ti < 4; const int w = ti - 4;
            bf16x8 Kf[2][2];
#pragma unroll
            for (int t = 0; t < 2; ++t)
#pragma unroll
                for (int ks = 0; ks < 2; ++ks) Kf[t][ks] = Kn[t][ks];
            bf16x8 Vf[4];
#pragma unroll
            for (int db = 0; db < 4; ++db) Vf[db] = Vn[db];
            if (st + 1 < nstep) {
#pragma unroll
                for (int t = 0; t < 2; ++t)
#pragma unroll
                    for (int ks = 0; ks < 2; ++ks) Kn[t][ks] = *NA_KADDR(st + 1, t, ks);
#pragma unroll
                for (int db = 0; db < 4; ++db) Vn[db] = *NA_VADDR(st + 1, db);
            }
            const int trow = 31 * (r0 + w - r + 7) + 32 * kb;
#pragma unroll
            for (int nq = 0; nq < 4; ++nq) {
                if (!ctile && ((nq == 0 && kb == 1) || (nq == 3 && kb == 0))) continue;
                f32x4 s0 = (f32x4){0.f, 0.f, 0.f, 0.f}, s1 = (f32x4){0.f, 0.f, 0.f, 0.f};
                s0 = MFMA16(Kf[0][0], Qf[nq][0], s0); s0 = MFMA16(Kf[0][1], Qf[nq][1], s0);
                s1 = MFMA16(Kf[1][0], Qf[nq][0], s1); s1 = MFMA16(Kf[1][1], Qf[nq][1], s1);
                float x[8];
                if (!ctile) {
                    const LAS float* bp = bias_s + (trow + dcb[nq]);
                    float bv[8];
#pragma unroll
                    for (int j = 0; j < 8; ++j) bv[j] = bp[j];
                    const int dl = dlo[nq] + 32 * kb;
#pragma unroll
                    for (int j = 0; j < 8; ++j) { const float sv = j < 4 ? s0[j] : s1[j - 4]; const float t_ = __builtin_fmaf(sv, 0.125f * LOG2E, bv[j]); x[j] = ((unsigned)(dl + j) < 16u) ? t_ : -1e30f; }
                } else {
#pragma unroll
                    for (int i = 0; i < 4; ++i) { x[i] = s0[i] * (0.125f * LOG2E); x[4 + i] = s1[i] * (0.125f * LOG2E); }
                }
                float mx = fmaxf(fmaxf(fmaxf(x[0], x[1]), fmaxf(x[2], x[3])), fmaxf(fmaxf(x[4], x[5]), fmaxf(x[6], x[7])));
                mx = fmaxf(mx, __shfl_xor(mx, 16)); mx = fmaxf(mx, __shfl_xor(mx, 32));
                const float mn = fmaxf(m[nq], mx);
                if (!__all(mn == m[nq])) {
                    const float alpha = __builtin_amdgcn_exp2f(m[nq] - mn);
                    l[nq] *= alpha; m[nq] = mn;
#pragma unroll
                    for (int db = 0; db < 4; ++db) O[nq][db] = O[nq][db] * alpha;
                }
#pragma unroll
                for (int j = 0; j < 8; ++j) x[j] = __builtin_amdgcn_exp2f(x[j] - mn);
                l[nq] += ((x[0] + x[1]) + (x[2] + x[3])) + ((x[4] + x[5]) + (x[6] + x[7]));
                u32x4 pw; pw.x = cvt_pk_bf16(x[0], x[1]); pw.y = cvt_pk_bf16(x[2], x[3]); pw.z = cvt_pk_bf16(x[4], x[5]); pw.w = cvt_pk_bf16(x[6], x[7]);
                const bf16x8 Pq = __builtin_bit_cast(bf16x8, pw);
#pragma unroll
                for (int db = 0; db < 4; ++db) O[nq][db] = MFMA16(Vf[db], Pq, O[nq][db]);
            }
        }
#undef NA_KADDR
#undef NA_VADDR
#pragma unroll
        for (int nq = 0; nq < 4; ++nq) { float lt = l[nq]; lt += __shfl_xor(lt, 16); lt += __shfl_xor(lt, 32); const float inv = 1.f / lt;
#pragma unroll
            for (int db = 0; db < 4; ++db) { const f32x4 o = O[nq][db] * inv; u32x2 wv; wv.x = cvt_pk_bf16(o[0], o[1]); wv.y = cvt_pk_bf16(o[2], o[3]);
                *(u32x2*)(AO + (size_t)(qrow0 + 16 * nq + fr) * 1024 + h * 64 + 16 * db + 4 * g) = wv; } }
        __builtin_amdgcn_s_waitcnt(0); __builtin_amdgcn_wave_barrier();
    }
}
namespace ga {
constexpr int D_ = 128, NW = 8, QBLK = 32, KVBLK = 64;
constexpr float SCALE = 0.088388347648318440f, THR = 8.f;
constexpr int SDEPTH = 1;
constexpr int LDQ = 1280, LDK = 512, LDO = 1024;
constexpr size_t SHM_V = KVBLK * D_ * 2, SHM_K = KVBLK * D_ * 2, SHM_ATTN = 2 * SHM_V + 2 * SHM_K + NW * 64 * 4;
typedef short s16x4 __attribute__((ext_vector_type(4)));
typedef float f32x16 __attribute__((ext_vector_type(16)));
#define GA_KSWZ(row, colB) ((row) * 256 + ((colB) ^ (((row) & 7) << 4)))
#define GA_SBAR() __builtin_amdgcn_sched_barrier(0)
__device__ __forceinline__ int crow(int r, int hi) { return (r & 3) + 8 * (r >> 2) + 4 * hi; }
__device__ __forceinline__ unsigned cvtpk(float lo, float hi) { unsigned r; asm volatile("v_cvt_pk_bf16_f32 %0, %1, %2" : "=v"(r) : "v"(lo), "v"(hi)); return r; }
__device__ __forceinline__ bf16x8 ld8(const bf16_t* p) { return *reinterpret_cast<const bf16x8*>(p); }
__device__ __forceinline__ void partialSM(f32x16& p0, f32x16& p1, float& m_reg, float& mn, float& alpha) {
  constexpr float C = SCALE * 1.4426950408889634f;
  float pmax = p0[0];
#pragma unroll
  for (int r = 1; r < 16; ++r) pmax = fmaxf(pmax, p0[r]);
#pragma unroll
  for (int r = 0; r < 16; ++r) pmax = fmaxf(pmax, p1[r]);
  { auto rr = __builtin_amdgcn_permlane32_swap(__float_as_uint(pmax), __float_as_uint(pmax), false, false);
    pmax = fmaxf(__uint_as_float(rr[0]), __uint_as_float(rr[1])); }
  if (__builtin_expect(__all(pmax - m_reg <= THR / SCALE), 1)) { mn = m_reg; alpha = 1.f; }
  else { mn = fmaxf(m_reg, pmax); alpha = __builtin_amdgcn_exp2f((m_reg - mn) * C); m_reg = mn; }
  float mnC = -mn * C;
#pragma unroll
  for (int r = 0; r < 16; ++r) p0[r] = fmaf(p0[r], C, mnC);
#pragma unroll
  for (int r = 0; r < 16; ++r) p1[r] = fmaf(p1[r], C, mnC);
#pragma unroll
  for (int r = 0; r < 16; ++r) p0[r] = __builtin_amdgcn_exp2f(p0[r]);
}
__device__ __forceinline__ void finishSM(f32x16& p0, f32x16& p1, float alpha, float& l_reg, bf16x8& pa0, bf16x8& pa1, bf16x8& pa2, bf16x8& pa3) {
#pragma unroll
  for (int r = 0; r < 16; ++r) p1[r] = __builtin_amdgcn_exp2f(p1[r]);
  float ps = 0;
#pragma unroll
  for (int r = 0; r < 16; ++r) ps += p0[r];
#pragma unroll
  for (int r = 0; r < 16; ++r) ps += p1[r];
  { auto rr = __builtin_amdgcn_permlane32_swap(__float_as_uint(ps), __float_as_uint(ps), false, false);
    ps = __uint_as_float(rr[0]) + __uint_as_float(rr[1]); }
  l_reg = l_reg * alpha + ps;
#define GA_PK4(P_, BASE, OUT) do { unsigned a0 = cvtpk(P_[BASE + 0], P_[BASE + 1]), a1 = cvtpk(P_[BASE + 2], P_[BASE + 3]);   \
    unsigned b0 = cvtpk(P_[BASE + 4], P_[BASE + 5]), b1 = cvtpk(P_[BASE + 6], P_[BASE + 7]);                              \
    auto r0 = __builtin_amdgcn_permlane32_swap(a0, b0, false, false); auto r1 = __builtin_amdgcn_permlane32_swap(a1, b1, false, false); \
    u32x4 w = {r0[0], r1[0], r0[1], r1[1]}; OUT = __builtin_bit_cast(bf16x8, w); } while (0)
  GA_PK4(p0, 0, pa0); GA_PK4(p0, 8, pa1); GA_PK4(p1, 0, pa2); GA_PK4(p1, 8, pa3);
#undef GA_PK4
}
__device__ __forceinline__ void qkt(f32x16& p0, f32x16& p1, const char* Ks, const bf16x8* qr, int r32, int hi) {
  p0 = f32x16{}; p1 = f32x16{};
#pragma unroll
  for (int d0 = 0; d0 < 8; ++d0) { int cb = (d0 * 16 + hi * 8) * 2;
    bf16x8 b0 = *reinterpret_cast<const bf16x8*>(Ks + GA_KSWZ(r32, cb));
    bf16x8 b1 = *reinterpret_cast<const bf16x8*>(Ks + GA_KSWZ(32 + r32, cb));
    p0 = __builtin_amdgcn_mfma_f32_32x32x16_bf16(b0, qr[d0], p0, 0, 0, 0);
    p1 = __builtin_amdgcn_mfma_f32_32x32x16_bf16(b1, qr[d0], p1, 0, 0, 0); }
}
__device__ __forceinline__ int v_st(int k, int c) { const int kk = (k & ~0xC) | ((k & 4) << 1) | ((k & 8) >> 1); return ((kk >> 3) * 4 + (c >> 5)) * 512 + ((kk & 7) * 32 + (c & 31)) * 2; }
__device__ __forceinline__ int v_rd_base(int lane) { return ((lane & 3) << 3) | (((lane >> 2) & 3) << 6) | (((lane >> 4) & 1) << 5) | (((lane >> 5) & 1) << 8); }
constexpr int v_rd_off(int d0, int ks, int half) { return d0 * 512 + ks * 4096 + half * 2048; }
template <int OFF> __device__ __forceinline__ s16x4 tr_read(int vb) {
  s16x4 r; asm volatile("ds_read_b64_tr_b16 %0, %1 offset:%2" : "=&v"(r) : "v"(vb), "i"(OFF) : "memory"); return r;
}
template <int D0> __device__ __forceinline__ void pv_one(f32x16& od, int vb, bf16x8 pa0, bf16x8 pa1, bf16x8 pa2, bf16x8 pa3) {
  const s16x4 l0 = tr_read<v_rd_off(D0, 0, 0)>(vb), h0 = tr_read<v_rd_off(D0, 0, 1)>(vb), l1 = tr_read<v_rd_off(D0, 1, 0)>(vb), h1 = tr_read<v_rd_off(D0, 1, 1)>(vb);
  const s16x4 l2 = tr_read<v_rd_off(D0, 2, 0)>(vb), h2 = tr_read<v_rd_off(D0, 2, 1)>(vb), l3 = tr_read<v_rd_off(D0, 3, 0)>(vb), h3 = tr_read<v_rd_off(D0, 3, 1)>(vb);
  asm volatile("s_waitcnt lgkmcnt(0)" ::: "memory"); GA_SBAR();
#define GA_PK(L, H) (bf16x8){L[0], L[1], L[2], L[3], H[0], H[1], H[2], H[3]}
  od = __builtin_amdgcn_mfma_f32_32x32x16_bf16(pa0, GA_PK(l0, h0), od, 0, 0, 0);
  od = __builtin_amdgcn_mfma_f32_32x32x16_bf16(pa1, GA_PK(l1, h1), od, 0, 0, 0);
  od = __builtin_amdgcn_mfma_f32_32x32x16_bf16(pa2, GA_PK(l2, h2), od, 0, 0, 0);
  od = __builtin_amdgcn_mfma_f32_32x32x16_bf16(pa3, GA_PK(l3, h3), od, 0, 0, 0);
#undef GA_PK
}
__device__ __forceinline__ void pv_d0(f32x16* o, int vb, bf16x8 pa0, bf16x8 pa1, bf16x8 pa2, bf16x8 pa3) {
  pv_one<0>(o[0], vb, pa0, pa1, pa2, pa3); pv_one<1>(o[1], vb, pa0, pa1, pa2, pa3); pv_one<2>(o[2], vb, pa0, pa1, pa2, pa3); pv_one<3>(o[3], vb, pa0, pa1, pa2, pa3);
}
__device__ __forceinline__ void attn_dense_body(const bf16_t* __restrict__ Qb, const bf16_t* __restrict__ Kh, const bf16_t* __restrict__ Vh, bf16_t* __restrict__ Ob, int seq, char* lds, int tid) {
  const int wid = tid >> 6, lane = tid & 63, r32 = lane & 31, hi = lane >> 5;
  char* V_lds = lds; char* K_lds = lds + 2 * SHM_V;
  float* wsf = (float*)(lds + 2 * SHM_V + 2 * SHM_K) + wid * 64; float* li_l = wsf; float* al_l = wsf + 32;
  float m_reg = -1e30f, l_reg = 0; f32x16 o[4] = {}; bf16x8 qr[8];
  const bf16_t* Qw = Qb + (long)(wid * QBLK + r32) * LDQ + hi * 8;
#pragma unroll
  for (int d0 = 0; d0 < 8; ++d0) qr[d0] = ld8(Qw + d0 * 16);
  const int sr = tid >> 4, sc = (tid & 15) * 8, vst0 = v_st(sr, sc), vst1 = v_st(32 + sr, sc);
  const int vb0 = (int)(uintptr_t)V_lds + v_rd_base(lane);
  struct { bf16x8 vs0, vs1, ks0, ks1; } sr_[SDEPTH];
#define GA_SLOAD(i, k0) do { sr_[i].vs0 = ld8(&Vh[(long)((k0) + sr) * LDK + sc]); sr_[i].vs1 = ld8(&Vh[(long)((k0) + 32 + sr) * LDK + sc]); \
    sr_[i].ks0 = ld8(&Kh[(long)((k0) + sr) * LDK + sc]); sr_[i].ks1 = ld8(&Kh[(long)((k0) + 32 + sr) * LDK + sc]); } while (0)
#define GA_SWRITE(b, i) do { *(bf16x8*)(V_lds + (b) * SHM_V + vst0) = sr_[i].vs0;          \
    *(bf16x8*)(V_lds + (b) * SHM_V + vst1) = sr_[i].vs1; int kc = sc * 2;               \
    *(bf16x8*)(K_lds + (b) * SHM_K + GA_KSWZ(sr, kc)) = sr_[i].ks0;                       \
    *(bf16x8*)(K_lds + (b) * SHM_K + GA_KSWZ(32 + sr, kc)) = sr_[i].ks1; } while (0)
#define GA_SWAIT() do { if (SDEPTH == 2) asm volatile("s_waitcnt vmcnt(4)" ::: "memory"); else asm volatile("s_waitcnt vmcnt(0)" ::: "memory"); } while (0)
#define GA_RESC(a) do { if (__any((a) < 1.f)) { if (hi == 0) al_l[r32] = (a); asm volatile("s_waitcnt lgkmcnt(0)" ::: "memory"); \
    _Pragma("unroll") for (int d = 0; d < 4; ++d) _Pragma("unroll") for (int r = 0; r < 16; ++r) o[d][r] *= al_l[crow(r, hi)]; } } while (0)
  f32x16 pA0, pA1, pB0, pB1; float mnA, mnB, alA, alB; bf16x8 pa0, pa1, pa2, pa3; const int NT = seq / KVBLK;
  constexpr int SE = 0, SO = SDEPTH - 1;
  GA_SLOAD(SE, 0); asm volatile("s_waitcnt vmcnt(0)" ::: "memory"); GA_SWRITE(0, SE); __syncthreads();
  qkt(pA0, pA1, K_lds, qr, r32, hi); partialSM(pA0, pA1, m_reg, mnA, alA);
  GA_SLOAD(SO, KVBLK); if (SDEPTH == 2) { if (2 < NT) GA_SLOAD(SE, 2 * KVBLK); }
  GA_SWAIT(); GA_SWRITE(1, SO); __syncthreads();
  for (int j = 1; j + 1 < NT; j += 2) {
    GA_SBAR(); qkt(pB0, pB1, K_lds + SHM_K, qr, r32, hi);
    finishSM(pA0, pA1, alA, l_reg, pa0, pa1, pa2, pa3); GA_SBAR();
    GA_SLOAD(SO, (j + SDEPTH) * KVBLK); GA_SBAR();
    pv_d0(o, vb0, pa0, pa1, pa2, pa3); partialSM(pB0, pB1, m_reg, mnB, alB);
    __syncthreads(); GA_SWAIT(); GA_SWRITE(0, SE);
    GA_RESC(alB); __syncthreads();
    GA_SBAR(); qkt(pA0, pA1, K_lds, qr, r32, hi);
    finishSM(pB0, pB1, alB, l_reg, pa0, pa1, pa2, pa3); GA_SBAR();
    if (SDEPTH == 1 || j + 3 < NT) GA_SLOAD(SE, (j + 1 + SDEPTH) * KVBLK); GA_SBAR();
    pv_d0(o, vb0 + (int)SHM_V, pa0, pa1, pa2, pa3); partialSM(pA0, pA1, m_reg, mnA, alA);
    __syncthreads(); GA_SWAIT(); GA_SWRITE(1, SO);
    GA_RESC(alA); __syncthreads();
  }
  GA_SBAR(); qkt(pB0, pB1, K_lds + SHM_K, qr, r32, hi);
  finishSM(pA0, pA1, alA, l_reg, pa0, pa1, pa2, pa3); GA_SBAR();
  pv_d0(o, vb0, pa0, pa1, pa2, pa3); partialSM(pB0, pB1, m_reg, mnB, alB);
  __syncthreads(); GA_RESC(alB);
  finishSM(pB0, pB1, alB, l_reg, pa0, pa1, pa2, pa3); GA_SBAR();
  pv_d0(o, vb0 + (int)SHM_V, pa0, pa1, pa2, pa3);
  if (hi == 0) li_l[r32] = l_reg; asm volatile("s_waitcnt lgkmcnt(0)" ::: "memory");
  float rli[16];
#pragma unroll
  for (int r = 0; r < 16; ++r) rli[r] = __builtin_amdgcn_rcpf(li_l[crow(r, hi)]);
  bf16_t* Ow = Ob + (long)(wid * QBLK) * LDO;
#pragma unroll
  for (int r = 0; r < 16; ++r) { int orow = crow(r, hi);
#pragma unroll
    for (int d0 = 0; d0 < 4; ++d0) Ow[(long)orow * LDO + d0 * 32 + r32] = (bf16_t)f2bf(o[d0][r] * rli[r]); }
  asm volatile("s_waitcnt vmcnt(0) lgkmcnt(0)" ::: "memory"); __syncthreads();
#undef GA_SLOAD
#undef GA_SWRITE
#undef GA_SWAIT
#undef GA_RESC
}
}
__device__ __forceinline__ void ph_gqa2(const Ctx& F, const bf16_t* QKN, const bf16_t* KVGb, bf16_t* CO, bool with_ctx, char* lds_generic) {
    const int nunits = 256 + (with_ctx ? 32 : 0);
    for (int u = F.bid; u < nunits; u += F.nb) {
        const bool lat = u < 256;
        int b, hq, qrow0, tok0, seq;
        if (lat) { b = u >> 6; hq = (u >> 3) & 7; qrow0 = b * S + (u & 7) * 256; tok0 = 0; seq = S + LC; }
        else { const int v = u - 256; b = v >> 3; hq = v & 7; qrow0 = NL + b * LC; tok0 = S; seq = LC; }
        const bf16_t* Kh = KVGb + ((size_t)b * 2304 + tok0) * 512 + (hq >> 2) * 128;
        ga::attn_dense_body(QKN + (size_t)qrow0 * 1280 + hq * 128, Kh, Kh + 256, CO + (size_t)qrow0 * 1024 + hq * 128, seq, lds_generic, F.tid);
    }
}
__device__ __forceinline__ void gla_unit_rows(int b, int c, int& row0, int& tok0) { if (c < 4) { row0 = NL + b * LC + 64 * c; tok0 = S + 64 * c; } else { row0 = b * S + 64 * (c - 4); tok0 = 64 * (c - 4); } }
__device__ __forceinline__ void ph_gla_a(const Ctx& F, const bf16_t* P, const bf16_t* VT, const float* LG, float* OG, bf16_t* QT, bf16_t* KVb, float* DEC) {
    const int lane = F.lane, fr = lane & 15, g = lane >> 4, tid = F.tid, w = F.wave;
    LAS float* Gs = (LAS float*)F.lds;
    LAS unsigned char* Qt = F.lds + 32768;
    LAS unsigned char* Kt = F.lds + 50176;
    LAS unsigned char* KhT = F.lds + 67584;
    LAS unsigned char* Pfr = F.lds + 86016;
    LAS float* Seg = (LAS float*)(F.lds + 94208);
    for (int u = F.bid; u < 1152; u += F.nb) {
        const int c = u % 36, h = (u / 36) & 3, b = (u / 144) & 3, dir = u / 576;
        int row0, tok0; gla_unit_rows(b, c, row0, tok0);
        __syncthreads();
        bf16x8 Vf[2][2];
#pragma unroll
        for (int db = 0; db < 2; ++db)
#pragma unroll
            for (int jb = 0; jb < 2; ++jb) Vf[db][jb] = *(const bf16x8*)(VT + ((size_t)b * 2304 + 1024 + h * 256 + 32 * w + 16 * db + fr) * 2304 + tok0 + 32 * jb + 8 * g);
        {
            const int col = tid & 127, seg = tid >> 7;
            float v[16];
#pragma unroll
            for (int i = 0; i < 16; ++i) v[i] = LG[((size_t)dir * NR + row0 + seg * 16 + i) * 512 + h * 128 + col];
            if (dir == 0) {
#pragma unroll
                for (int i = 1; i < 16; ++i) v[i] += v[i - 1];
                Seg[seg * 128 + col] = v[15];
            } else {
#pragma unroll
                for (int i = 14; i >= 0; --i) v[i] += v[i + 1];
                Seg[seg * 128 + col] = v[0];
            }
            __syncthreads();
            float off = 0.f;
            if (dir == 0) { for (int s2 = 0; s2 < seg; ++s2) off += Seg[s2 * 128 + col]; }
            else { for (int s2 = 3; s2 > seg; --s2) off += Seg[s2 * 128 + col]; }
#pragma unroll
            for (int i = 0; i < 16; ++i) Gs[(seg * 16 + i) * 128 + col] = v[i] + off;
        }
        __syncthreads();
        {
            const int tok = tid >> 3, d0 = (tid & 7) * 16;
            const bf16_t* pr = P + (size_t)(row0 + tok) * PW;
            const u32x4 q0 = *(const u32x4*)(pr + O_GLQ + h * 128 + d0), q1 = *(const u32x4*)(pr + O_GLQ + h * 128 + d0 + 8);
            const u32x4 k0 = *(const u32x4*)(pr + O_GLK + h * 128 + d0), k1 = *(const u32x4*)(pr + O_GLK + h * 128 + d0 + 8);
            const unsigned qw[8] = {q0.x, q0.y, q0.z, q0.w, q1.x, q1.y, q1.z, q1.w}, kw[8] = {k0.x, k0.y, k0.z, k0.w, k1.x, k1.y, k1.z, k1.w};
            const int glast = dir == 0 ? 63 : 0;
            unsigned qo[8], ko[8];
#pragma unroll
            for (int p2 = 0; p2 < 8; ++p2) {
                float qt[2], kt[2], kh[2];
#pragma unroll
                for (int e = 0; e < 2; ++e) { const int dk = d0 + 2 * p2 + e;
                    const float gg = Gs[tok * 128 + dk], GG = Gs[glast * 128 + dk];
                    const float qv = e ? __uint_as_float(qw[p2] & 0xffff0000u) : __uint_as_float(qw[p2] << 16), kv = e ? __uint_as_float(kw[p2] & 0xffff0000u) : __uint_as_float(kw[p2] << 16);
                    qt[e] = qv * 0.08838834764831845f * __builtin_amdgcn_exp2f(gg * LOG2E); kt[e] = kv * __builtin_amdgcn_exp2f(-gg * LOG2E); kh[e] = kv * __builtin_amdgcn_exp2f((GG - gg) * LOG2E);
                    *(LAS bf16_t*)(KhT + dk * 144 + tok * 2) = (bf16_t)f2bf(kh[e]); }
                qo[p2] = cvt_pk_bf16(qt[0], qt[1]); ko[p2] = cvt_pk_bf16(kt[0], kt[1]);
            }
            *(LAS u32x4*)(Qt + tok * 272 + d0 * 2) = (u32x4){qo[0], qo[1], qo[2], qo[3]}; *(LAS u32x4*)(Qt + tok * 272 + d0 * 2 + 16) = (u32x4){qo[4], qo[5], qo[6], qo[7]};
            *(LAS u32x4*)(Kt + tok * 272 + d0 * 2) = (u32x4){ko[0], ko[1], ko[2], ko[3]}; *(LAS u32x4*)(Kt + tok * 272 + d0 * 2 + 16) = (u32x4){ko[4], ko[5], ko[6], ko[7]};
            bf16_t* qg = QT + ((size_t)dir * NR + row0 + tok) * 512 + h * 128 + d0;
            *(u32x4*)qg = (u32x4){qo[0], qo[1], qo[2], qo[3]}; *(u32x4*)(qg + 8) = (u32x4){qo[4], qo[5], qo[6], qo[7]};
            if (tid < 128) DEC[(size_t)u * 128 + tid] = __builtin_amdgcn_exp2f(Gs[glast * 128 + tid] * LOG2E);
        }
        __syncthreads();
        {
            const int ib = w & 3, jb = w >> 2;
            f32x4 s0 = (f32x4){0.f, 0.f, 0.f, 0.f}, s1 = (f32x4){0.f, 0.f, 0.f, 0.f};
            const int jr = 32 * jb + 8 * (fr >> 2) + (fr & 3);
#pragma unroll
            for (int ks = 0; ks < 4; ++ks) {
                const bf16x8 qf = *(const LAS bf16x8*)(Qt + (16 * ib + fr) * 272 + (32 * ks + 8 * g) * 2);
                const bf16x8 k0f = *(const LAS bf16x8*)(Kt + jr * 272 + (32 * ks + 8 * g) * 2), k1f = *(const LAS bf16x8*)(Kt + (jr + 4) * 272 + (32 * ks + 8 * g) * 2);
                s0 = MFMA16(k0f, qf, s0); s1 = MFMA16(k1f, qf, s1);
            }
            const int i = 16 * ib + fr, j0 = 32 * jb + 8 * g;
            float x[8];
#pragma unroll
            for (int e = 0; e < 4; ++e) { x[e] = s0[e]; x[4 + e] = s1[e]; }
#pragma unroll
            for (int e = 0; e < 8; ++e) { const int j = j0 + e; const bool keep = dir == 0 ? (j <= i) : (j >= i); x[e] = keep ? x[e] : 0.f; }
            u32x4 pw; pw.x = cvt_pk_bf16(x[0], x[1]); pw.y = cvt_pk_bf16(x[2], x[3]); pw.z = cvt_pk_bf16(x[4], x[5]); pw.w = cvt_pk_bf16(x[6], x[7]);
            *(LAS u32x4*)(Pfr + (jb * 4 + ib) * 1024 + lane * 16) = pw;
        }
        __syncthreads();
        {
#pragma unroll
            for (int ib = 0; ib < 4; ++ib) {
                const bf16x8 p0 = *(const LAS bf16x8*)(Pfr + (0 * 4 + ib) * 1024 + lane * 16), p1 = *(const LAS bf16x8*)(Pfr + (1 * 4 + ib) * 1024 + lane * 16);
#pragma unroll
                for (int db = 0; db < 2; ++db) {
                    f32x4 o = (f32x4){0.f, 0.f, 0.f, 0.f};
                    o = MFMA16(Vf[db][0], p0, o); o = MFMA16(Vf[db][1], p1, o);
                    *(f32x4*)(OG + ((size_t)dir * NR + row0 + 16 * ib + fr) * 1024 + h * 256 + 32 * w + 16 * db + 4 * g) = o;
                }
            }
#pragma unroll
            for (int dkb = 0; dkb < 8; ++dkb) {
                const bf16x8 kh0 = *(const LAS bf16x8*)(KhT + (16 * dkb + fr) * 144 + (8 * g) * 2), kh1 = *(const LAS bf16x8*)(KhT + (16 * dkb + fr) * 144 + (32 + 8 * g) * 2);
#pragma unroll
                for (int db = 0; db < 2; ++db) {
                    f32x4 o = (f32x4){0.f, 0.f, 0.f, 0.f};
                    o = MFMA16(Vf[db][0], kh0, o); o = MFMA16(Vf[db][1], kh1, o);
                    bf16_t* dst = KVb + ((size_t)u * 256 + 32 * w + 16 * db + 4 * g) * 128 + 16 * dkb + fr;
#pragma unroll
                    for (int e = 0; e < 4; ++e) dst[e * 128] = (bf16_t)f2bf(o[e]);
                }
            }
        }
    }
    __syncthreads();
}
__device__ __forceinline__ void ph_gla_scan(const Ctx& F, const bf16_t* KVb, bf16_t* KVs, const float* DEC) {
    typedef float f32x2 __attribute__((ext_vector_type(2)));
    for (int e = F.bid * NTHR + F.tid; e < 32 * 16384; e += F.nb * NTHR) {
        const int chain = e >> 14, pe = e & 16383, dv = pe >> 6, dk2 = (pe & 63) * 2, dir = chain >> 4;
        unsigned kv[36]; f32x2 dd[36];
#pragma unroll
        for (int n = 0; n < 36; ++n) {
            const int c = dir == 0 ? n : (n < 4 ? 3 - n : 39 - n);
            const size_t u = (size_t)chain * 36 + c;
            kv[n] = *(const unsigned*)(KVb + (u * 256 + dv) * 128 + dk2); dd[n] = *(const f32x2*)(DEC + u * 128 + dk2);
        }
        float s0 = 0.f, s1 = 0.f;
#pragma unroll
        for (int n = 0; n < 36; ++n) {
            const int c = dir == 0 ? n : (n < 4 ? 3 - n : 39 - n);
            const size_t u = (size_t)chain * 36 + c;
            *(unsigned*)(KVs + (u * 256 + dv) * 128 + dk2) = pk2(s0, s1);
            s0 = dd[n].x * s0 + __uint_as_float(kv[n] << 16); s1 = dd[n].y * s1 + __uint_as_float(kv[n] & 0xffff0000u);
        }
    }
}
__device__ __forceinline__ void ph_gla_c(const Ctx& F, const bf16_t* P, const float* OG, const bf16_t* QT, const bf16_t* KVb, const float* ng, bf16_t* BO, bool with_ctx) {
    const int lane = F.lane, fr = lane & 15, g = lane >> 4, w = F.wave, ib = w & 3, dh = w >> 2;
    const int c_lo = with_ctx ? 0 : 4, nc = 36 - c_lo, nun = NB * nc * 4;
    LAS float* part = (LAS float*)F.lds;
    for (int uu = F.bid; uu < nun; uu += F.nb) {
        const int h = uu & 3, c = c_lo + (uu >> 2) % nc, b = (uu >> 2) / nc;
        int row0, tok0; gla_unit_rows(b, c, row0, tok0);
        const size_t r = (size_t)(row0 + 16 * ib + fr);
        const int dvb = h * 256 + 128 * dh + 4 * g;
        f32x4 acc[8];
#pragma unroll
        for (int db = 0; db < 8; ++db) acc[db] = *(const f32x4*)(OG + r * 1024 + dvb + 16 * db) + *(const f32x4*)(OG + ((size_t)NR + r) * 1024 + dvb + 16 * db);
#pragma unroll 1
        for (int dir = 0; dir < 2; ++dir) {
            const size_t ud = (size_t)((dir * 4 + b) * 4 + h) * 36 + c;
            bf16x8 Qf[4], Sf[8][4];
#pragma unroll
            for (int ks = 0; ks < 4; ++ks) Qf[ks] = *(const bf16x8*)(QT + ((size_t)dir * NR + r) * 512 + h * 128 + 32 * ks + 8 * g);
#pragma unroll
            for (int db = 0; db < 8; ++db)
#pragma unroll
                for (int ks = 0; ks < 4; ++ks) Sf[db][ks] = *(const bf16x8*)(KVb + (ud * 256 + 128 * dh + 16 * db + fr) * 128 + 32 * ks + 8 * g);
#pragma unroll
            for (int db = 0; db < 8; ++db)
#pragma unroll
                for (int ks = 0; ks < 4; ++ks) acc[db] = MFMA16(Sf[db][ks], Qf[ks], acc[db]);
        }
        float ss = 0.f;
#pragma unroll
        for (int db = 0; db < 8; ++db) ss += acc[db][0] * acc[db][0] + acc[db][1] * acc[db][1] + acc[db][2] * acc[db][2] + acc[db][3] * acc[db][3];
        ss += __shfl_xor(ss, 16); ss += __shfl_xor(ss, 32);
        __syncthreads();
        if (g == 0) part[(dh * 4 + ib) * 16 + fr] = ss;
        __syncthreads();
        const float rs = rsqrtf((part[ib * 16 + fr] + part[(4 + ib) * 16 + fr]) * (1.f / 256.f) + EPS);
#pragma unroll
        for (int db = 0; db < 8; ++db) { const int dv = 128 * dh + 16 * db + 4 * g;
            const u32x2 og = *(const u32x2*)(P + r * PW + O_GLOG + h * 256 + dv); const f32x4 gg = *(const f32x4*)(ng + dv);
            const float z0 = __uint_as_float(og.x << 16), z1 = __uint_as_float(og.x & 0xffff0000u), z2 = __uint_as_float(og.y << 16), z3 = __uint_as_float(og.y & 0xffff0000u);
            const float o0 = acc[db][0] * rs * gg[0] * z0 * fast_sigmoid(z0), o1 = acc[db][1] * rs * gg[1] * z1 * fast_sigmoid(z1);
            const float o2 = acc[db][2] * rs * gg[2] * z2 * fast_sigmoid(z2), o3 = acc[db][3] * rs * gg[3] * z3 * fast_sigmoid(z3);
            u32x2 wv; wv.x = cvt_pk_bf16(o0, o1); wv.y = cvt_pk_bf16(o2, o3);
            *(u32x2*)(BO + r * 1024 + h * 256 + dv) = wv; }
    }
    __syncthreads();
}
__device__ __forceinline__ void ph_moe_sort(const Ctx& F, const int* tok_e, int* tok_slot, const bf16_t* H, bf16_t* HS, unsigned* cnt_out, float* Y2) {
    LAS int* tot = (LAS int*)F.lds;
    LAS int* pre = tot + 8;
    LAS int* slots = pre + 8;
    __syncthreads();
    if (F.tid < 16) tot[F.tid] = 0;
    __syncthreads();
    {
        int ct[8], cp[8];
#pragma unroll
        for (int e = 0; e < 8; ++e) { ct[e] = 0; cp[e] = 0; }
        for (int i = F.tid; i < NL * 2; i += NTHR) { const int e = tok_e[i]; const bool before = i < F.bid * 64;
#pragma unroll
            for (int j = 0; j < 8; ++j) { ct[j] += (e == j); cp[j] += (e == j && before); } }
#pragma unroll
        for (int e = 0; e < 8; ++e) { const int a = (int)wave_sum((float)ct[e]), b2 = (int)wave_sum((float)cp[e]); if (F.lane == 0) { atomicAdd((int*)&tot[e], a); atomicAdd((int*)&pre[e], b2); } }
    }
    __syncthreads();
    int pstart[8]; { int acc = 0;
#pragma unroll
        for (int e = 0; e < 8; ++e) { pstart[e] = acc; acc += (tot[e] + 255) / 256 * 256; } }
    if (F.tid < 64) {
        const int ai = F.bid * 64 + F.tid; const int me = tok_e[ai];
        int rank = 0, ps_me = 0;
#pragma unroll
        for (int e = 0; e < 8; ++e) { const unsigned long long m = __ballot(me == e); if (me == e) { rank = __popcll(m & ((1ull << F.lane) - 1ull)); ps_me = pstart[e]; } }
        const int slot = ps_me + pre[me] + rank;
        tok_slot[ai] = slot; slots[F.tid] = slot;
    }
    if (F.bid == 0 && F.tid < 8) cnt_out[F.tid] = (unsigned)tot[F.tid];
    __syncthreads();
    for (int a = F.wave; a < 64; a += NWAVES) { const int t = F.bid * 32 + (a >> 1); const u32x4* sp = (const u32x4*)(H + (size_t)t * D); u32x4* d = (u32x4*)(HS + (size_t)slots[a] * D);
#pragma unroll
        for (int j = 0; j < 4; ++j) d[F.lane + 64 * j] = sp[F.lane + 64 * j]; }
    {
        int nblk = 0;
#pragma unroll
        for (int e = 0; e < 8; ++e) nblk += (tot[e] + 255) / 256;
        nblk = nblk < 72 ? nblk : 72;
        const int total = nblk * 8, nfull = (total / F.nb) * F.nb, R = total - nfull;
        for (int j = F.bid; j < R; j += F.nb) { const int L = nfull + j, pn = L % 8, pm = L / 8;
            for (int i = F.tid; i < 256 * 64; i += NTHR) { const int rr = i >> 6, c4 = i & 63; *(f32x4*)(Y2 + (size_t)(pm * 256 + rr) * D + pn * 256 + c4 * 4) = (f32x4){0.f, 0.f, 0.f, 0.f}; } }
    }
    {
        int lo = 0, hi = 0;
#pragma unroll
        for (int e = 0; e < 8; ++e) if ((F.bid & 7) == e) { lo = pstart[e] + tot[e]; hi = pstart[e] + (tot[e] + 255) / 256 * 256; }
        for (int rr = lo + (F.bid >> 3) * NWAVES + F.wave; rr < hi; rr += 32 * NWAVES) { u32x4* d = (u32x4*)(HS + (size_t)rr * D);
#pragma unroll
            for (int j = 0; j < 4; ++j) d[F.lane + 64 * j] = (u32x4){0u, 0u, 0u, 0u}; } }
    __syncthreads();
}
__device__ __forceinline__ void ph_final(const Ctx& F, const float* XR, const float* Y2, const int* tok_slot, const float* tok_w, const float* modl, const float* fg, float* out, float delta) {
    const int rstep = F.nb * NWAVES;
    f32x4 nx[8], ny0[8], ny1[8]; float nw0 = 0.f, nw1 = 0.f;
#define FIN_LOAD(row_) do { const f32x4* xr_ = (const f32x4*)(XR + (size_t)(row_) * D) + F.lane; \
        const f32x4* y0_ = (const f32x4*)(Y2 + (size_t)tok_slot[(row_) * 2] * D) + F.lane; const f32x4* y1_ = (const f32x4*)(Y2 + (size_t)tok_slot[(row_) * 2 + 1] * D) + F.lane; \
        nw0 = tok_w[(row_) * 2]; nw1 = tok_w[(row_) * 2 + 1]; \
        _Pragma("unroll") for (int j = 0; j < 8; ++j) { nx[j] = xr_[64 * j]; ny0[j] = y0_[64 * j]; ny1[j] = y1_[64 * j]; } } while (0)
    if (F.bid * NWAVES + F.wave < NL) FIN_LOAD(F.bid * NWAVES + F.wave);
    for (int row = F.bid * NWAVES + F.wave; row < NL; row += rstep) {
        const float* g2 = modl + (size_t)batch_of(row) * MOD_W + 5 * D;
        f32x4 v[8]; float ss = 0.f;
#pragma unroll
        for (int j = 0; j < 8; ++j) { const f32x4 gg = *(const f32x4*)(g2 + 4 * F.lane + 256 * j); v[j] = nx[j] + gg * (nw0 * ny0[j] + nw1 * ny1[j]);
            ss += v[j][0] * v[j][0] + v[j][1] * v[j][1] + v[j][2] * v[j][2] + v[j][3] * v[j][3]; }
        if (row + rstep < NL) FIN_LOAD(row + rstep);
        ss = wave_sum(ss);
        const float rs = rsqrtf(ss * (1.f / D) + EPS);
#pragma unroll
        for (int j = 0; j < 8; ++j) { const f32x4 gg = *(const f32x4*)(fg + 4 * F.lane + 256 * j); ((f32x4*)(out + (size_t)row * D))[F.lane + 64 * j] = v[j] * rs * gg + delta; }
    }
#undef FIN_LOAD
}

constexpr int PH_PER_LAYER = 12, PH_FINAL = 2 + 2 * PH_PER_LAYER, N_PHASES = PH_FINAL + 1;
__global__ void __launch_bounds__(NTHR, 2) mega(Params p) {
    extern __shared__ __attribute__((aligned(16))) unsigned char lds_raw[];
    LAS unsigned char* lds = (LAS unsigned char*)lds_raw;
    volatile LAS unsigned* MISC = (volatile LAS unsigned*)(lds + MISC_OFF);
    Ctx F; F.lds = lds; F.tid = threadIdx.x; F.lane = F.tid & 63; F.wave = __builtin_amdgcn_readfirstlane(F.tid >> 6); F.bid = blockIdx.x; F.nb = gridDim.x;
#define FRESH() do { int t_ = threadIdx.x; asm volatile("" : "+v"(t_)); F.tid = t_; F.lane = t_ & 63; F.wave = __builtin_amdgcn_readfirstlane(t_ >> 6); \
        int b_ = blockIdx.x; asm volatile("" : "+s"(b_)); F.bid = b_; unsigned long long w_ = (unsigned long long)ws; asm volatile("" : "+s"(w_)); ws = (unsigned char*)(GAS unsigned char*)w_; } while (0)
    unsigned char* ws = (unsigned char*)(GAS unsigned char*)p.ws;
    for (int u = F.tid; u < (LDS_BYTES - RING_BYTES) / 4; u += NTHR) ((LAS unsigned*)(lds + RING_BYTES))[u] = 0u;
    __syncthreads();
    XcdBarrier bar; bar.bar = (unsigned*)(ws + WS_CTL) + CW_BAR; bar.x = 0; bar.st = nullptr;
    if (!MK_SPLIT) bar = xcd_barrier_post((unsigned*)(ws + WS_CTL) + CW_BAR, MISC + 8);
    const int lo = p.ph_lo, hi = p.ph_hi;
#define GIN(k) ((const float*)(const GAS float*)p.in[k])
    LAS pg8::UnitRec* UTAB = (LAS pg8::UnitRec*)(lds + UTAB_OFF); LAS int* NCELL = (LAS int*)(lds + MISC_OFF + 64);
#ifndef PH_MASK
#define PH_MASK 0xffffffffu
#endif
#define IN(k) (((PH_MASK >> (((k) - 2) % PH_PER_LAYER + 2 < 2 ? (k) : (((k) < 2) ? (k) : (((k) == PH_FINAL) ? 14 : ((k) - 2) % PH_PER_LAYER + 2)))) & 1u) && lo <= (k) && (k) < hi)
#ifndef DBL_J
#define DBL_J (-1)
#define DBL_L 0
#endif
#define BG(c0, q, base) do { FRESH(); if (F.bid >= (c0)) bg_convert(F, p, (base) + (F.bid - (c0)) * (q), (q)); } while (0)
#define REP(j) for (int rep_ = 0; rep_ < ((DBL_J == (j) && layer == DBL_L) ? 2 : 1); ++rep_)
#define REP0(j) for (int rep_ = 0; rep_ < ((DBL_J == 100 + (j)) ? 2 : 1); ++rep_)
#ifdef PAD_STAMP
#define STAMP(id) do { if ((id) == 0 && threadIdx.x == 0) { const unsigned long long t_ = wall_clock64(); MISC[20] = (unsigned)t_; MISC[21] = (unsigned)(t_ >> 32); } \
        if ((id) == PAD_STAMP) { if (threadIdx.x == 0) { const unsigned long long t0_ = ((unsigned long long)MISC[21] << 32) | MISC[20]; \
            while (wall_clock64() - t0_ < (unsigned long long)(PAD_US) * 100ull) __builtin_amdgcn_s_sleep(32); } __syncthreads(); } } while (0)
#else
#define STAMP(id) do { } while (0)
#endif
#define SEAM(k) do { if (IN(k) && IN((k) + 1)) xcd_barrier(bar); FRESH(); STAMP((k) + 1); } while (0)
#define MODP ((float*)(ws + WS_MODP))
#define MOD ((float*)(ws + WS_MOD))
#define XR ((float*)(ws + WS_XR))
#define H ((bf16_t*)(ws + WS_H))
#define HS ((bf16_t*)(ws + WS_HS))
#define P ((bf16_t*)(ws + WS_P))
#define Y2 ((float*)(ws + WS_P))
#define ABF ((float*)(ws + WS_ABF))
#define LG ((float*)(ws + WS_LG))
#define OG ((float*)(ws + WS_OG))
#define AO ((bf16_t*)(ws + WS_AO))
#define BO ((bf16_t*)(ws + WS_BO))
#define CO ((bf16_t*)(ws + WS_CO))
#define MG ((bf16_t*)(ws + WS_MG))
#define ACT ((bf16_t*)(ws + WS_ACT))
#define VT ((bf16_t*)(ws + WS_VT))
#define QT ((bf16_t*)(ws + WS_QT))
#define KVB ((bf16_t*)(ws + WS_KV))
#define DEC ((float*)(ws + WS_DEC))
#define QKN ((bf16_t*)(ws + WS_QKN))
#define ROPET ((float*)(ws + WS_ROPE))
#define KVG ((bf16_t*)(ws + WS_KVG))
#define KVS ((bf16_t*)(ws + WS_ACT))
#define tok_e ((int*)(ws + WS_RT))
#define tok_w ((float*)(ws + WS_RT + (size_t)NL * 2 * 4))
#define tok_slot ((int*)(ws + WS_RT + (size_t)NL * 2 * 8))
#define ctl ((unsigned*)(ws + WS_CTL))

    STAMP(0);
    if (IN(0)) REP0(0) { ph_mod_partial(F, GIN(1), GIN(3), GIN(4), MODP); ph_rope_table(F, ROPET); }
    SEAM(0);
    if (IN(1)) REP0(1) { ph_mod_reduce(F, MODP, GIN(5), MOD); ph_convert(F, p); }
    SEAM(1);
    for (int layer = 0; layer < 2; ++layer) {
        const int pb = 2 + layer * PH_PER_LAYER;
        const bool last = layer == 1;
        const float* modl = MOD + (size_t)layer * 5 * MOD_W;
        const int MR = last ? NL : NR;
        if (IN(pb + 0)) REP(0) ph_norm<false>(F, last ? XR : GIN(0), last ? nullptr : GIN(2), GIN(6) + layer * D, modl, 0, D, H, NR, nullptr, nullptr, nullptr, nullptr);
        SEAM(pb + 0);
        if (IN(pb + 1)) REP(1) {
            pg8::InprojOrder So{(const char*)H, (const char*)((bf16_t*)(ws + WS_WIN) + (size_t)layer * NIN * D), last ? 32 : 36, last ? 4 : 0, last ? 232 : 248, F.bid, (size_t)256 * D * 2};
            pg8::EpiInproj E{P, ABF};
            { const int nu = pg8::fill_table(So, UTAB, NCELL); const pg8::TableOrder T{UTAB, nu}; pg8::gemm_phase(lds, D, D, T, E); }
            if (!last) BG(248, 130, 0); else BG(232, 130, 14928);
        }
        SEAM(pb + 1);
        if (IN(pb + 2)) REP(2) { ph_vt(F, P, VT); FRESH(); }
        if (IN(pb + 2)) REP(22) ph_prep(F, P, ROPET, QKN, KVG, ABF, GIN(13) + layer * 128, GIN(14) + layer * 128, GIN(10) + (size_t)layer * 2 * 16 * 512, GIN(11) + layer * 2 * 512, LG);
        SEAM(pb + 2);
        if (IN(pb + 3)) REP(3) {
#ifndef ATTN_SEL
#define ATTN_SEL 7
#endif
            if ((F.bid >> 3) & 1) { ph_gla_a(F, P, VT, LG, OG, QT, KVB, DEC); FRESH(); }
            if (ATTN_SEL & 1) REP(31) { ph_gqa2(F, QKN, KVG, CO, !last, (char*)lds_raw); FRESH(); }
            if (ATTN_SEL & 2) REP(32) { ph_na(F, P, VT, GIN(9) + (size_t)layer * 16 * 15 * 31, AO, 0, last ? 2048 : 2304); FRESH(); }
            if (!((F.bid >> 3) & 1)) { ph_gla_a(F, P, VT, LG, OG, QT, KVB, DEC); FRESH(); }
        }
        SEAM(pb + 3);
        if (IN(pb + 4)) REP(4) ph_gla_scan(F, KVB, KVS, DEC);
        SEAM(pb + 4);
        if (IN(pb + 5)) REP(5) { ph_gla_c(F, P, OG, QT, KVS, GIN(12) + layer * 256, BO, !last); }
        SEAM(pb + 5);
        if (IN(pb + 6)) REP(6) {
            const bf16_t* wp = (const bf16_t*)(ws + WS_WP) + (size_t)layer * 3 * D * 1024;
            pg8::MergeOrder So{(const char*)AO, (size_t)(WS_BO - WS_AO), (const char*)wp, (size_t)D * 1024 * 2, MR / 256, last ? F.nb : 144, F.bid};
            static_assert(WS_CO - WS_BO == WS_BO - WS_AO, "branch outputs equally spaced");
            pg8::EpiMerge E{P, MG};
            { const int nu = pg8::fill_table(So, UTAB, NCELL); const pg8::TableOrder T{UTAB, nu}; pg8::gemm_phase(lds, 1024, 1024, T, E); }
            if (!last) BG(144, 22, 1040);
        }
        SEAM(pb + 6);
        if (IN(pb + 7)) {
            pg8::PlainOrder So{(const char*)MG, (const char*)((bf16_t*)(ws + WS_WOUT) + (size_t)layer * D * D), MR / 256, 8, last ? F.nb : 144, F.bid, (size_t)256 * D * 2};
            pg8::EpiResid E{XR, modl, 2 * D, last ? nullptr : GIN(0), last ? nullptr : GIN(2)};
            { const int nu = pg8::fill_table(So, UTAB, NCELL); const pg8::TableOrder T{UTAB, nu}; pg8::gemm_phase(lds, D, D, T, E); }
            if (!last) BG(144, 32, 3504);
        }
        SEAM(pb + 7);
        if (IN(pb + 8)) REP(8) {
            if (!last) ph_norm<false>(F, XR, nullptr, GIN(7) + layer * D, modl, 3 * D, 4 * D, H, MR, nullptr, nullptr, nullptr, nullptr);
            else ph_norm<true>(F, XR, nullptr, GIN(7) + layer * D, modl, 3 * D, 4 * D, H, MR, GIN(22), GIN(23), tok_e, tok_w);
        }
        SEAM(pb + 8);
        if (IN(pb + 9)) REP(9) { if (last) { ph_moe_sort(F, tok_e, tok_slot, H, HS, ctl + CW_CNT, Y2); BG(0, 5, 20128); } }
        if (last) SEAM(pb + 9);
        if (!last) {
            if (IN(pb + 10)) REP(10) {
                pg8::PlainOrder So{(const char*)H, (const char*)(ws + WS_DGU), MR / 256, 44, F.nb, F.bid, (size_t)256 * D * 2};
                pg8::EpiSwiglu E{ACT};
                { const int nu = pg8::fill_table(So, UTAB, NCELL); const pg8::TableOrder T{UTAB, nu}; pg8::gemm_phase(lds, D, D, T, E); }
                BG(48, 10, 18048);
            }
            SEAM(pb + 10);
            if (IN(pb + 11)) {
                pg8::PlainOrder So{(const char*)ACT, (const char*)(ws + WS_DDN), MR / 256, 8, 144, F.bid, (size_t)256 * DFF * 2};
                pg8::EpiResid E{XR, modl, 5 * D, nullptr, nullptr};
                { const int nu = pg8::fill_table(So, UTAB, NCELL); const pg8::TableOrder T{UTAB, nu}; pg8::gemm_phase(lds, DFF, DFF, T, E); }
                BG(144, 70, 7088);
            }
            SEAM(pb + 11);
        } else {
            if (IN(pb + 10)) REP(10) {
                pg8::MoeOrder So{(const char*)HS, (const char*)(ws + WS_MGU), 44, F.nb, F.bid, (size_t)256 * D * 2, (size_t)2 * DFF * D * 2, ctl + CW_CNT, 0};
                pg8::EpiSwiglu E{ACT};
                { const int nu = pg8::fill_table(So, UTAB, NCELL); const pg8::TableOrder T{UTAB, nu}; pg8::gemm_phase(lds, D, D, T, E); }
            }
            SEAM(pb + 10);
            if (IN(pb + 11)) REP(11) {
                { pg8::MoeOrder So{(const char*)ACT, (const char*)(ws + WS_MDN), 8, F.nb, F.bid, (size_t)256 * DFF * 2, (size_t)D * DFF * 2, ctl + CW_CNT, 1};
                  pg8::EpiStoreF32 E{Y2};
                  { const int nu = pg8::fill_table(So, UTAB, NCELL); const pg8::TableOrder T{UTAB, nu}; pg8::gemm_phase(lds, DFF, DFF, T, E); } }
                FRESH();
                { pg8::MoeTailOrder So{(const char*)ACT, (const char*)(ws + WS_MDN), F.nb, F.bid, (size_t)256 * DFF * 2, (size_t)D * DFF * 2, ctl + CW_CNT};
                  pg8::EpiAtomicF32 E{Y2};
                  { const int nu = pg8::fill_table(So, UTAB, NCELL); const pg8::TableOrder T{UTAB, nu}; pg8::gemm_phase(lds, 1408, DFF, T, E); } }
            }
            SEAM(pb + 11);
        }
    }
    float probe_delta = 0.f;
    if (IN(PH_FINAL)) REP0(26) ph_final(F, XR, Y2, tok_slot, tok_w, MOD + (size_t)5 * MOD_W, GIN(27), (float*)(GAS float*)p.out, probe_delta);
#undef IN
#undef SEAM
#undef MODP
#undef MOD
#undef XR
#undef H
#undef HS
#undef P
#undef Y2
#undef ABF
#undef LG
#undef OG
#undef AO
#undef BO
#undef CO
#undef MG
#undef ACT
#undef VT
#undef QT
#undef KVB
#undef DEC
#undef QKN
#undef ROPET
#undef KVG
#undef KVS
#undef tok_e
#undef tok_w
#undef tok_slot
#undef ctl
}

extern "C" void kernel_launch(void* const* d_in, const int* in_sizes, int n_in, void* d_out, int out_size, void* d_ws, size_t ws_size, hipStream_t stream) {
    static int grid = 0;
    if (grid == 0) {
        if (n_in != 28 || ws_size < WS_END) { fprintf(stderr, "kernel_launch: need 28 inputs and %zu bytes of workspace (got %d, %zu)\n", (size_t)WS_END, n_in, ws_size); grid = -1; return; }
        int dev = 0, cus = 0, per_cu = 0;
        if (hipGetDevice(&dev) != hipSuccess || hipDeviceGetAttribute(&cus, hipDeviceAttributeMultiprocessorCount, dev) != hipSuccess) { grid = -1; return; }
        if (hipFuncSetAttribute((const void*)mega, hipFuncAttributeMaxDynamicSharedMemorySize, LDS_BYTES) != hipSuccess) { fprintf(stderr, "kernel_launch: hipFuncSetAttribute failed\n"); grid = -1; return; }
        if (hipOccupancyMaxActiveBlocksPerMultiprocessor(&per_cu, (const void*)mega, NTHR, LDS_BYTES) != hipSuccess || per_cu < 1) { fprintf(stderr, "kernel_launch: occupancy query says %d\n", per_cu); }
        (void)hipGetLastError();
        grid = cus;
    }
    if (grid < 0) return;
    (void)hipMemsetAsync((char*)d_ws + WS_CTL, 0, CTL_BYTES, stream);
    Params p{};
    for (int i = 0; i < 28; ++i) p.in[i] = (const float*)d_in[i];
    p.out = (float*)d_out; p.ws = (unsigned char*)d_ws;
#if MK_SPLIT
    for (int k = 0; k < N_PHASES; ++k) { p.ph_lo = k; p.ph_hi = k + 1; hipLaunchKernelGGL(mega, dim3(grid), dim3(NTHR), LDS_BYTES, stream, p); }
#else
    p.ph_lo = 0; p.ph_hi = N_PHASES;
    hipLaunchKernelGGL(mega, dim3(grid), dim3(NTHR), LDS_BYTES, stream, p);
#endif
}
```

```cpp
#include <hip/hip_runtime.h>
#include <cstdio>
#include <cstdint>

#ifndef MK_SPLIT
#define MK_SPLIT 0
#endif

constexpr int D = 2048, NB = 4, S = 2048, LC = 256, NL = NB * S, NC = NB * LC, NR = NL + NC;
constexpr int DIN = 13856, DFF = 5632, NE = 8, GW = 64;
constexpr int S_AF = 6144;
constexpr int PW = 13824;
constexpr int O_NAQ = 0, O_NAK = 1024, O_NAV = 2048, O_GLQ = 3072, O_GLK = 3584, O_GLV = 4096, O_GLOG = 5120,
              O_GQQ = 6144, O_GQK = 7168, O_GQV = 7424, O_GA = 7680, O_GB = 9728, O_GC = 11776;
constexpr int NIN = 14080;
constexpr int MOD_W = 6 * D;
constexpr int NSLOT = 18432;
constexpr float EPS = 1e-6f;
constexpr float LOG2E = 1.4426950408889634f;
constexpr int NWAVES = 8, NTHR = 512;

#define GAS __attribute__((address_space(1)))
#define LAS __attribute__((address_space(3)))
typedef unsigned short bf16_t;
#ifndef DDN_G
#define DDN_G 144
#endif
#ifndef BGQ_MERGE
#define BGQ_MERGE 60
#endif
#ifndef BGQ_OUT
#define BGQ_OUT 32
#endif
#ifndef BGQ_INP0
#define BGQ_INP0 95
#endif
#ifndef BGQ_UP0
#define BGQ_UP0 14
#endif
#ifndef BG_INP1
#define BG_INP1 16448
#endif
typedef short bf16x8 __attribute__((ext_vector_type(8)));
typedef float f32x4 __attribute__((ext_vector_type(4)));
typedef unsigned u32x4 __attribute__((ext_vector_type(4)));
typedef int i32x4 __attribute__((ext_vector_type(4)));
typedef unsigned u32x2 __attribute__((ext_vector_type(2)));

__device__ __forceinline__ int batch_of(int r) { return r < NL ? (r >> 11) : 4; }
__device__ __forceinline__ float bf2f(bf16_t v) { return __uint_as_float((unsigned)v << 16); }
__device__ __forceinline__ unsigned f2bf(float f) { unsigned u = __float_as_uint(f); return (u + 0x7fffu + ((u >> 16) & 1u)) >> 16; }
__device__ __forceinline__ unsigned pk2(float lo, float hi) { return f2bf(lo) | (f2bf(hi) << 16); }
typedef __bf16 bf16v2_t __attribute__((ext_vector_type(2)));
typedef float f32v2_t __attribute__((ext_vector_type(2)));
__device__ __forceinline__ unsigned cvt_pk_bf16(float lo, float hi) { return __builtin_bit_cast(unsigned, __builtin_convertvector((f32v2_t){lo, hi}, bf16v2_t)); }
__device__ __forceinline__ unsigned pk_fp8x4(float a, float b, float c, float d) { int w = __builtin_amdgcn_cvt_pk_fp8_f32(a, b, 0, false); w = __builtin_amdgcn_cvt_pk_fp8_f32(c, d, w, true); return (unsigned)w; }
__device__ __forceinline__ float sigmoidf_(float x) { return 1.f / (1.f + expf(-x)); }
__device__ __forceinline__ float siluf_(float x) { return x / (1.f + expf(-x)); }
__device__ __forceinline__ float fast_sigmoid(float x) { return __builtin_amdgcn_rcpf(1.f + __builtin_amdgcn_exp2f(-1.4426950408889634f * x)); }
__device__ __forceinline__ int lane_now() { int l; asm volatile("v_mbcnt_lo_u32_b32 %0, -1, 0\n\tv_mbcnt_hi_u32_b32 %0, -1, %0" : "=v"(l)); return l; }
template <int M> __device__ __forceinline__ float xshfl(float v) { return __uint_as_float((unsigned)__builtin_amdgcn_ds_swizzle((int)__float_as_uint(v), (M << 10) | 0x1f)); }
__device__ __forceinline__ float sum_x32(float v) { auto r = __builtin_amdgcn_permlane32_swap(__float_as_uint(v), __float_as_uint(v), false, false); return __uint_as_float(r[0]) + __uint_as_float(r[1]); }
__device__ __forceinline__ float max_x32(float v) { auto r = __builtin_amdgcn_permlane32_swap(__float_as_uint(v), __float_as_uint(v), false, false); return fmaxf(__uint_as_float(r[0]), __uint_as_float(r[1])); }
__device__ __forceinline__ float wave_sum(float v) {
    v += xshfl<1>(v); v += xshfl<2>(v); v += xshfl<4>(v); v += xshfl<8>(v); v += xshfl<16>(v);
    return sum_x32(v);
}
__device__ __forceinline__ float wave_max(float v) {
    v = fmaxf(v, xshfl<1>(v)); v = fmaxf(v, xshfl<2>(v)); v = fmaxf(v, xshfl<4>(v)); v = fmaxf(v, xshfl<8>(v)); v = fmaxf(v, xshfl<16>(v));
    return max_x32(v);
}

#define XB_TMO      128
#define XB_XCNT(j)  (256  + 64 * (j))
#define XB_XSUB(j)  (1280 + 64 * (j))
#define XB_XGEN(j)  (2304 + 64 * (j))
#define XB_TOP      3328
#define XB_TOPGEN   3392
#define XCD_BAR_WORDS 3456
#define XB_SPIN_CAP (1u << 18)
__device__ __forceinline__ unsigned xb_ld(unsigned* p)              { return __hip_atomic_load(p, __ATOMIC_RELAXED, __HIP_MEMORY_SCOPE_AGENT); }
__device__ __forceinline__ unsigned xb_add(unsigned* p, unsigned v) { return __hip_atomic_fetch_add(p, v, __ATOMIC_RELAXED, __HIP_MEMORY_SCOPE_AGENT); }
__device__ __forceinline__ unsigned xb_xcc_id() { return (unsigned)__builtin_amdgcn_s_getreg((3 << 11) | 20) & 0xFu; }
#define XB_SPIN(cond, bar) do { unsigned _sp = 0; while (cond) { __builtin_amdgcn_s_sleep(1); \
    if ((++_sp & 255u) == 0u) { if (xb_ld(&(bar)[XB_TMO])) break; if (_sp > XB_SPIN_CAP) { atomicAdd(&(bar)[XB_TMO], 1u); break; } } } } while (0)
struct XcdBarrier { unsigned* bar; unsigned x; volatile LAS unsigned* st; };
__device__ __forceinline__ XcdBarrier xcd_barrier_post(unsigned* bar, volatile LAS unsigned* st, int tid) {
    XcdBarrier b; b.bar = bar; b.x = xb_xcc_id(); b.st = st;
    if (tid == 0) (void)xb_add(&bar[XB_XCNT(b.x)], 1u);
    return b;
}
__device__ __forceinline__ void xcd_barrier_complete(unsigned* bar, unsigned x, unsigned& nloc, unsigned& nx) {
    const unsigned G = gridDim.x * gridDim.y * gridDim.z;
    unsigned sum, cnt, mine, sp = 0u;
    asm volatile("" : "+s"(x));
    { unsigned long long bb = (unsigned long long)bar; asm volatile("" : "+s"(bb)); bar = (unsigned*)(GAS unsigned*)bb; }
    for (;;) {
        sum = 0u; cnt = 0u; mine = 0u;
#pragma unroll
        for (unsigned j = 0; j < 16; ++j) { const unsigned c = xb_ld(&bar[XB_XCNT(j)]); sum += c; cnt += (c > 0u) ? 1u : 0u; mine = (j == x) ? c : mine; }
        if (sum == G) break;
        __builtin_amdgcn_s_sleep(1);
        if ((++sp & 255u) == 0u) { if (xb_ld(&bar[XB_TMO])) break; if (sp > XB_SPIN_CAP) { atomicAdd(&bar[XB_TMO], 1u); break; } }
    }
    nloc = mine > 0u ? mine : 1u; nx = cnt > 0u ? cnt : 1u;
}
__device__ __forceinline__ void xcd_barrier(const XcdBarrier& b, int tid) {
    asm volatile("s_waitcnt vmcnt(0)" ::: "memory");
    __syncthreads();
    if (tid == 0) {
        unsigned* bar = b.bar;
        __builtin_amdgcn_s_waitcnt(0);
        unsigned nloc = b.st[0], nx = b.st[1];
        if (nloc == 0u) { xcd_barrier_complete(bar, b.x, nloc, nx); b.st[0] = nloc; b.st[1] = nx; }
        const unsigned old = xb_add(&bar[XB_XSUB(b.x)], 1u);
        const unsigned gen = old / nloc;
        if (old + 1u == (gen + 1u) * nloc) {
            __builtin_amdgcn_fence(__ATOMIC_RELEASE, "agent");
            asm volatile("s_waitcnt vmcnt(0)" ::: "memory");
            const unsigned og = xb_add(&bar[XB_TOP], 1u);
            const unsigned tg = og / nx;
            if (og + 1u == (tg + 1u) * nx) xb_add(&bar[XB_TOPGEN], 1u);
            else XB_SPIN(xb_ld(&bar[XB_TOPGEN]) == tg, bar);
            __builtin_amdgcn_fence(__ATOMIC_ACQUIRE, "agent");
            xb_add(&bar[XB_XGEN(b.x)], 1u);
            asm volatile("s_waitcnt vmcnt(0)" ::: "memory");
        } else {
            XB_SPIN(xb_ld(&bar[XB_XGEN(b.x)]) == gen, bar);
            __builtin_amdgcn_fence(__ATOMIC_ACQUIRE, "agent");
            asm volatile("s_waitcnt vmcnt(0)" ::: "memory");
        }
    }
    __syncthreads();
}

namespace pg8 {
constexpr int BM = 256, BK = 64, HALF = 128, HTB = HALF * BK * 2, STAGE_BYTES = 8 * HTB, NXCD = 8, WGM = 8;
__host__ __device__ __forceinline__ int lds_byte(int r, int c) { const int st = (r >> 4) * 2 + (c >> 5), rr = r & 15, cc = c & 31, ob = rr * 64 + cc * 2; return st * 1024 + (ob ^ (((ob >> 9) & 1) << 5)); }
__host__ __device__ __forceinline__ void stage_rc(int b, int& R, int& C) { const int st = b / 1024, sb = b % 1024, swz = sb ^ (((sb >> 9) & 1) << 5); R = (st >> 1) * 16 + swz / 64; C = (st & 1) * 32 + (swz % 64) / 2; }
__host__ __device__ __forceinline__ int perm32(int rho) { const int n = rho >> 4, i = rho & 15; return 8 * (i >> 2) + 4 * n + (i & 3); }

struct Unit { const char* a; const char* b; int pm, pn, sub, aux; };

__device__ __forceinline__ void tile_of(int wgid, int nM, int nN, int& pm, int& pn) {
    const int nwg = nM * nN; { const int q = nwg / NXCD, r = nwg % NXCD, xcd = wgid % NXCD, off = wgid / NXCD; wgid = (xcd < r ? xcd * (q + 1) : r * (q + 1) + (xcd - r) * q) + off; }
    const int nig = WGM * nN, gid = wgid / nig, fm = gid * WGM, gsz = (nM - fm) < WGM ? (nM - fm) : WGM;
    pm = fm + ((wgid % nig) % gsz); pn = (wgid % nig) / gsz;
}

struct UnitRec { unsigned a_lo, a_hi, b_lo, b_hi; int pm, pn, sub, aux; };
struct TableOrder {
    const LAS UnitRec* tab; int n;
    __device__ __forceinline__ bool next(int i, Unit& u) const {
        if (i >= n) return false;
        const LAS unsigned* r = (const LAS unsigned*)(tab + i);
        const unsigned alo = __builtin_amdgcn_readfirstlane(r[0]), ahi = __builtin_amdgcn_readfirstlane(r[1]), blo = __builtin_amdgcn_readfirstlane(r[2]), bhi = __builtin_amdgcn_readfirstlane(r[3]);
        u.a = (const char*)(((unsigned long long)ahi << 32) | alo); u.b = (const char*)(((unsigned long long)bhi << 32) | blo);
        u.pm = __builtin_amdgcn_readfirstlane(r[4]); u.pn = __builtin_amdgcn_readfirstlane(r[5]); u.sub = __builtin_amdgcn_readfirstlane(r[6]); u.aux = __builtin_amdgcn_readfirstlane(r[7]);
        return true;
    }
};
template <bool F8 = false, bool UNT = false, class Epi, class Sched>
__device__ __forceinline__ void gemm_phase(LAS unsigned char* lds, const int K, const int ld, const Sched& S, const Epi& E, int tid) {
    asm volatile("" : "+v"(tid));
    const int wid = __builtin_amdgcn_readfirstlane(tid >> 6), lane = tid & 63, wr = wid >> 2, wc = wid & 3, fr = lane & 15, fq = lane >> 4;
    const int nt = F8 ? K / (2 * BK) : K / BK;
    constexpr unsigned ES = F8 ? 1u : 2u;
    unsigned voffA[2], voffB[2];
#pragma unroll
    for (int i = 0; i < 2; ++i) { int R, C; stage_rc(tid * 16 + i * 8192, R, C); const int Rb = Epi::PERM ? ((R & ~31) + perm32(R & 31)) : R;
        voffA[i] = (unsigned)(R * ld) * ES + (unsigned)C * 2u; voffB[i] = (unsigned)(Rb * ld) * ES + (unsigned)C * 2u; }
    const size_t kstep = (size_t)(BK * 2);
    const size_t hstep = (size_t)HALF * ld * ES;
    const unsigned ldsw = (unsigned)wid * 1024u;
    const int aoff = lds_byte(wr * 64 + fr, fq * 8), boff = lds_byte(wc * 32 + fr, fq * 8);
#define PG8_SA(b, h) (((b) * 2 + (h)) * HTB)
#define PG8_SB(b, h) ((4 + (b) * 2 + (h)) * HTB)
#define PG8_STAGE(bufoff, gbase, voff) do { _Pragma("unroll") for (int _i = 0; _i < 2; ++_i) { unsigned _vo = (voff)[_i]; asm volatile("" : "+v"(_vo));     \
        __builtin_amdgcn_global_load_lds((const unsigned*)((const char*)(gbase) + _vo), (LAS unsigned*)(lds + (bufoff) + ldsw + _i * 8192), 16, 0, 0); } } while (0)
#define PG8_LDA(dst, b, h) do { _Pragma("unroll") for (int m = 0; m < 4; ++m) _Pragma("unroll") for (int k = 0; k < 2; ++k) dst[m][k] = *(const LAS bf16x8*)(lds + PG8_SA(b, h) + aoff + m * 2048 + k * 1024); } while (0)
#define PG8_LDB(dst, b, h) do { _Pragma("unroll") for (int n = 0; n < 2; ++n) _Pragma("unroll") for (int k = 0; k < 2; ++k) dst[n][k] = *(const LAS bf16x8*)(lds + PG8_SB(b, h) + boff + n * 2048 + k * 1024); } while (0)
#define PG8_MMA(ai, bj, At, Bt) do { __builtin_amdgcn_s_setprio(1); _Pragma("unroll") for (int m = 0; m < 4; ++m) _Pragma("unroll") for (int n = 0; n < 2; ++n) _Pragma("unroll") for (int k = 0; k < 2; ++k) \
        acc[ai][bj][m][n] = __builtin_amdgcn_mfma_f32_16x16x32_bf16(Bt[n][k], At[m][k], acc[ai][bj][m][n], 0, 0, 0); __builtin_amdgcn_s_setprio(0); } while (0)
#define PG8_CAT(x) __builtin_shufflevector(__builtin_bit_cast(i32x4, x[0]), __builtin_bit_cast(i32x4, x[1]), 0, 1, 2, 3, 4, 5, 6, 7)
#define PG8_MMA8(ai, bj, At, Bt) do { __builtin_amdgcn_s_setprio(1); _Pragma("unroll") for (int m = 0; m < 4; ++m) _Pragma("unroll") for (int n = 0; n < 2; ++n) \
        acc[ai][bj][m][n] = __builtin_amdgcn_mfma_scale_f32_16x16x128_f8f6f4(PG8_CAT(Bt[n]), PG8_CAT(At[m]), acc[ai][bj][m][n], 0, 0, 0, 0, 0, 0); __builtin_amdgcn_s_setprio(0); } while (0)
#define PG8_MM(ai, bj, At, Bt) do { if constexpr (F8) PG8_MMA8(ai, bj, At, Bt); else PG8_MMA(ai, bj, At, Bt); } while (0)
#define PG8_WAIT_V(n) asm volatile("s_waitcnt vmcnt(" #n ")" ::: "memory")
#define PG8_WAIT_L(n) asm volatile("s_waitcnt lgkmcnt(" #n ")" ::: "memory")
#define PG8_BAR __builtin_amdgcn_s_barrier()
#define PG8_SCHED __builtin_amdgcn_sched_barrier(0)
    Unit cur, nxt; int ui = 0;
    if (!S.next(0, cur)) return;
    f32x4 acc[2][2][4][2];
#pragma unroll
    for (int a = 0; a < 2; ++a)
#pragma unroll
        for (int b = 0; b < 2; ++b)
#pragma unroll
            for (int m = 0; m < 4; ++m)
#pragma unroll
                for (int n = 0; n < 2; ++n) acc[a][b][m][n] = (f32x4){0.f, 0.f, 0.f, 0.f};
    bf16x8 At[4][2], B0[2][2], B1[2][2];
    const char* cA = cur.a; const char* cB = cur.b;
    PG8_STAGE(PG8_SB(0, 0), cB, voffB); PG8_STAGE(PG8_SB(0, 1), cB + hstep, voffB); PG8_STAGE(PG8_SA(0, 0), cA, voffA); PG8_STAGE(PG8_SA(0, 1), cA + hstep, voffA);
    if (wr == 1) PG8_BAR;
    PG8_WAIT_V(2); PG8_BAR;
    PG8_STAGE(PG8_SB(1, 0), cB + kstep, voffB); PG8_STAGE(PG8_SA(1, 0), cA + kstep, voffA); PG8_STAGE(PG8_SB(1, 1), cB + hstep + kstep, voffB);
    PG8_WAIT_V(6); PG8_BAR;
    for (;;) {
        const bool has_next = S.next(ui + 1, nxt);
        const char* nA = has_next ? nxt.a : cA; const char* nB = has_next ? nxt.b : cB;
        const int ntu = UNT ? cur.aux : nt;
        for (int t = 0; t < ntu; t += 2) {
            const bool last = (t == ntu - 2);
            const char* a1 = cA + (size_t)(t + 1) * kstep;
            const char* a2 = last ? nA : cA + (size_t)(t + 2) * kstep; const char* b2 = last ? nB : cB + (size_t)(t + 2) * kstep;
            const char* a3 = a2 + kstep; const char* b3 = b2 + kstep;
            PG8_LDB(B0, 0, 0); PG8_LDB(B1, 0, 1); PG8_SCHED; PG8_LDA(At, 0, 0); PG8_STAGE(PG8_SA(1, 1), a1 + hstep, voffA);
            PG8_WAIT_V(8); PG8_WAIT_L(0); PG8_BAR; PG8_MM(0, 0, At, B0); PG8_MM(0, 1, At, B1); PG8_BAR; PG8_SCHED;
            PG8_LDA(At, 0, 1); PG8_STAGE(PG8_SB(0, 0), b2, voffB); PG8_STAGE(PG8_SB(0, 1), b2 + hstep, voffB); PG8_STAGE(PG8_SA(0, 0), a2, voffA);
            PG8_WAIT_V(8); PG8_WAIT_L(0); PG8_BAR; PG8_MM(1, 0, At, B0); PG8_MM(1, 1, At, B1); PG8_BAR; PG8_SCHED;
            PG8_LDB(B0, 1, 0); PG8_LDB(B1, 1, 1); PG8_SCHED; PG8_LDA(At, 1, 0); PG8_STAGE(PG8_SA(0, 1), a2 + hstep, voffA);
            PG8_WAIT_V(8); PG8_WAIT_L(0); PG8_BAR; PG8_MM(0, 0, At, B0); PG8_MM(0, 1, At, B1); PG8_BAR; PG8_SCHED;
            PG8_LDA(At, 1, 1); PG8_STAGE(PG8_SB(1, 0), b3, voffB); PG8_STAGE(PG8_SB(1, 1), b3 + hstep, voffB); PG8_STAGE(PG8_SA(1, 0), a3, voffA);
            PG8_WAIT_V(8); PG8_WAIT_L(0); PG8_BAR; PG8_MM(1, 0, At, B0); PG8_MM(1, 1, At, B1); PG8_BAR; PG8_SCHED;
        }
        if (wr == 0) PG8_BAR;
        E(acc, cur, wr, wc, fr, fq);
        if (!has_next) break;
        cur = nxt; cA = nA; cB = nB; ++ui;
        if (wr == 1) PG8_BAR;
    }
    PG8_WAIT_V(0);
    PG8_BAR;
#undef PG8_SA
#undef PG8_SB
#undef PG8_STAGE
#undef PG8_LDA
#undef PG8_LDB
#undef PG8_MMA
#undef PG8_MMA8
#undef PG8_MM
#undef PG8_CAT
#undef PG8_WAIT_V
#undef PG8_WAIT_L
#undef PG8_BAR
#undef PG8_SCHED
}
#define ACC_T f32x4 (&acc)[2][2][4][2]
#define ZERO_ACC() do { _Pragma("unroll") for (int a_ = 0; a_ < 2; ++a_) _Pragma("unroll") for (int b_ = 0; b_ < 2; ++b_) _Pragma("unroll") for (int m_ = 0; m_ < 4; ++m_) \
    _Pragma("unroll") for (int n_ = 0; n_ < 2; ++n_) acc[a_][b_][m_][n_] = (f32x4){0.f, 0.f, 0.f, 0.f}; } while (0)

template <int KIND>
struct EpiInproj {
    static constexpr bool PERM = true;
    bf16_t* P; float* ABF; float sc;
    __device__ __forceinline__ void operator()(ACC_T, const Unit& u, int wr, int wc, int fr, int fq) const {
        const int row0 = u.pm * BM + wr * 64 + fr;
        if (KIND == 1 || u.pn < 54) {
            const bool gate = KIND == 1;
#pragma unroll
            for (int ai = 0; ai < 2; ++ai)
#pragma unroll
                for (int m = 0; m < 4; ++m) { bf16_t* rowp = P + (size_t)(row0 + ai * HALF + m * 16) * PW + u.pn * BM + wc * 32 + 8 * fq;
#pragma unroll
                    for (int bj = 0; bj < 2; ++bj) { f32x4 v0 = sc * acc[ai][bj][m][0], v1 = sc * acc[ai][bj][m][1];
                        if (gate) {
#pragma unroll
                            for (int j = 0; j < 4; ++j) { v0[j] = fast_sigmoid(v0[j]); v1[j] = fast_sigmoid(v1[j]); } }
                        u32x4 w; w.x = cvt_pk_bf16(v0[0], v0[1]); w.y = cvt_pk_bf16(v0[2], v0[3]); w.z = cvt_pk_bf16(v1[0], v1[1]); w.w = cvt_pk_bf16(v1[2], v1[3]);
                        *(u32x4*)(rowp + bj * HALF) = w; } }
        } else if (wc == 0) {
#pragma unroll
            for (int ai = 0; ai < 2; ++ai)
#pragma unroll
                for (int m = 0; m < 4; ++m) { float* rp = ABF + (size_t)(row0 + ai * HALF + m * 16) * 32 + 8 * fq;
                    *(f32x4*)rp = sc * acc[ai][0][m][0]; *(f32x4*)(rp + 4) = sc * acc[ai][0][m][1]; }
        }
        ZERO_ACC();
    }
};
struct EpiMerge {
    static constexpr bool PERM = true;
    const bf16_t* P; bf16_t* MG;
    __device__ __forceinline__ void operator()(ACC_T, const Unit& u, int wr, int wc, int fr, int fq) const {
        const int row0 = u.pm * BM + wr * 64 + fr, col0 = u.pn * BM + wc * 32 + 8 * fq;
        const int gcur = u.sub == 0 ? O_GA : (u.sub == 1 ? O_GB : O_GC), gnext = u.sub == 0 ? O_GB : O_GC;
        u32x4 G[3][2][2];
#define EM_LOAD(g, b) do { const size_t r_ = (size_t)(row0 + ((g) >> 2) * HALF + ((g) & 3) * 16); _Pragma("unroll") for (int bj = 0; bj < 2; ++bj) { \
            G[b][bj][0] = *(const u32x4*)(P + r_ * PW + gcur + col0 + bj * HALF); G[b][bj][1] = *(const u32x4*)(P + r_ * PW + gnext + col0 + bj * HALF); } } while (0)
        EM_LOAD(0, 0); EM_LOAD(1, 1);
#pragma unroll
        for (int g = 0; g < 8; ++g) { const int ai = g >> 2, m = g & 3; const size_t r = (size_t)(row0 + ai * HALF + m * 16);
            if (g + 2 < 8) EM_LOAD(g + 2, (g + 2) % 3);
#pragma unroll
            for (int bj = 0; bj < 2; ++bj) {
                const u32x4 gc = G[g % 3][bj][0];
                float sc[8]; sc[0] = __uint_as_float(gc.x << 16); sc[1] = __uint_as_float(gc.x & 0xffff0000u); sc[2] = __uint_as_float(gc.y << 16); sc[3] = __uint_as_float(gc.y & 0xffff0000u);
                sc[4] = __uint_as_float(gc.z << 16); sc[5] = __uint_as_float(gc.z & 0xffff0000u); sc[6] = __uint_as_float(gc.w << 16); sc[7] = __uint_as_float(gc.w & 0xffff0000u);
#pragma unroll
                for (int j = 0; j < 8; ++j) sc[j] = fmaxf(sc[j], 1e-20f);
                if (u.sub < 2) {
                    const u32x4 gn = G[g % 3][bj][1];
                    float sn[8]; sn[0] = __uint_as_float(gn.x << 16); sn[1] = __uint_as_float(gn.x & 0xffff0000u); sn[2] = __uint_as_float(gn.y << 16); sn[3] = __uint_as_float(gn.y & 0xffff0000u);
                    sn[4] = __uint_as_float(gn.z << 16); sn[5] = __uint_as_float(gn.z & 0xffff0000u); sn[6] = __uint_as_float(gn.w << 16); sn[7] = __uint_as_float(gn.w & 0xffff0000u);
#pragma unroll
                    for (int j = 0; j < 8; ++j) { const float f = sc[j] * __builtin_amdgcn_rcpf(fmaxf(sn[j], 1e-20f)); if (j < 4) acc[ai][bj][m][0][j] *= f; else acc[ai][bj][m][1][j - 4] *= f; }
                } else {
                    f32x4 v0 = acc[ai][bj][m][0], v1 = acc[ai][bj][m][1];
#pragma unroll
                    for (int j = 0; j < 4; ++j) { v0[j] *= sc[j]; v1[j] *= sc[4 + j]; }
                    u32x4 w; w.x = cvt_pk_bf16(v0[0], v0[1]); w.y = cvt_pk_bf16(v0[2], v0[3]); w.z = cvt_pk_bf16(v1[0], v1[1]); w.w = cvt_pk_bf16(v1[2], v1[3]);
                    *(u32x4*)(MG + r * D + col0 + bj * HALF) = w;
                    acc[ai][bj][m][0] = (f32x4){0.f, 0.f, 0.f, 0.f}; acc[ai][bj][m][1] = (f32x4){0.f, 0.f, 0.f, 0.f};
                } }
            asm volatile("" ::: "memory"); }
#undef EM_LOAD
    }
};
struct EpiResid {
    static constexpr bool PERM = false;
    float* X; const float* modl; int goff; const float* xl; const float* xc; float sc;
    __device__ __forceinline__ void operator()(ACC_T, const Unit& u, int wr, int wc, int fr, int fq) const {
        const int row0 = u.pm * BM + wr * 64 + fr, col0 = u.pn * BM + wc * 32 + 4 * fq;
        const float* g = modl + (size_t)batch_of(u.pm * BM) * MOD_W + goff + col0;
        f32x4 gv[2][2];
#pragma unroll
        for (int bj = 0; bj < 2; ++bj)
#pragma unroll
            for (int n = 0; n < 2; ++n) gv[bj][n] = sc * *(const f32x4*)(g + bj * HALF + n * 16);
#pragma unroll
        for (int ai = 0; ai < 2; ++ai)
#pragma unroll
            for (int m = 0; m < 4; ++m) { float* rowp = X + (size_t)(row0 + ai * HALF + m * 16) * D + col0;
#pragma unroll
                for (int bj = 0; bj < 2; ++bj)
#pragma unroll
                    for (int n = 0; n < 2; ++n) { f32x4* p = (f32x4*)(rowp + bj * HALF + n * 16); const int rr_ = row0 + ai * HALF + m * 16;
                        const f32x4* q_ = xl ? (const f32x4*)((rr_ < NL ? xl + (size_t)rr_ * D : xc + (size_t)(rr_ - NL) * D) + col0 + bj * HALF + n * 16) : (const f32x4*)p;
                        *p = *q_ + gv[bj][n] * acc[ai][bj][m][n]; } }
        ZERO_ACC();
    }
};
struct EpiSwiglu {
    static constexpr bool PERM = true;
    bf16_t* ACT; float sc;
    __device__ __forceinline__ void operator()(ACC_T, const Unit& u, int wr, int wc, int fr, int fq) const {
        const int row0 = u.pm * BM + wr * 64 + fr, col0 = u.pn * HALF + wc * 32 + 8 * fq;
#pragma unroll
        for (int ai = 0; ai < 2; ++ai)
#pragma unroll
            for (int m = 0; m < 4; ++m) { f32x4 o[2];
#pragma unroll
                for (int n = 0; n < 2; ++n)
#pragma unroll
                    for (int j = 0; j < 4; ++j) { const float gt = sc * acc[ai][0][m][n][j]; o[n][j] = gt * fast_sigmoid(gt) * (sc * acc[ai][1][m][n][j]); }
                u32x4 w; w.x = cvt_pk_bf16(o[0][0], o[0][1]); w.y = cvt_pk_bf16(o[0][2], o[0][3]); w.z = cvt_pk_bf16(o[1][0], o[1][1]); w.w = cvt_pk_bf16(o[1][2], o[1][3]);
                *(u32x4*)(ACT + (size_t)(row0 + ai * HALF + m * 16) * DFF + col0) = w; }
        ZERO_ACC();
    }
};
struct EpiSwiglu8 {
    static constexpr bool PERM = true;
    unsigned char* ACT; float sc;
    __device__ __forceinline__ void operator()(ACC_T, const Unit& u, int wr, int wc, int fr, int fq) const {
        const int row0 = u.pm * BM + wr * 64 + fr, col0 = u.pn * HALF + wc * 32 + 8 * fq;
#pragma unroll
        for (int ai = 0; ai < 2; ++ai)
#pragma unroll
            for (int m = 0; m < 4; ++m) { f32x4 o[2];
#pragma unroll
                for (int n = 0; n < 2; ++n)
#pragma unroll
                    for (int j = 0; j < 4; ++j) { const float gt = sc * acc[ai][0][m][n][j]; o[n][j] = gt * fast_sigmoid(gt) * (sc * acc[ai][1][m][n][j]); }
                u32x2 w; w.x = pk_fp8x4(o[0][0], o[0][1], o[0][2], o[0][3]); w.y = pk_fp8x4(o[1][0], o[1][1], o[1][2], o[1][3]);
                *(u32x2*)(ACT + (size_t)(row0 + ai * HALF + m * 16) * DFF + col0) = w; }
        ZERO_ACC();
    }
};
struct EpiStoreBF16 {
    static constexpr bool PERM = true;
    bf16_t* C; float sc;
    __device__ __forceinline__ void operator()(ACC_T, const Unit& u, int wr, int wc, int fr, int fq) const {
        const int row0 = u.pm * BM + wr * 64 + fr, col0 = u.pn * BM + wc * 32 + 8 * fq;
#pragma unroll
        for (int ai = 0; ai < 2; ++ai)
#pragma unroll
            for (int m = 0; m < 4; ++m) { bf16_t* rowp = C + (size_t)(row0 + ai * HALF + m * 16) * D + col0;
#pragma unroll
                for (int bj = 0; bj < 2; ++bj) { const f32x4 v0 = sc * acc[ai][bj][m][0], v1 = sc * acc[ai][bj][m][1];
                    u32x4 w; w.x = cvt_pk_bf16(v0[0], v0[1]); w.y = cvt_pk_bf16(v0[2], v0[3]); w.z = cvt_pk_bf16(v1[0], v1[1]); w.w = cvt_pk_bf16(v1[2], v1[3]);
                    *(u32x4*)(rowp + bj * HALF) = w; } }
        ZERO_ACC();
    }
};

struct EpiTailF32 {
    static constexpr bool PERM = true;
    bf16_t* C; float* CB; int row_tail0; float sc;
    __device__ __forceinline__ void operator()(ACC_T, const Unit& u, int wr, int wc, int fr, int fq) const {
        const int row0 = u.pm * BM + wr * 64 + fr, col0 = u.pn * BM + wc * 32 + 8 * fq;
        if (u.sub == 0) {
#pragma unroll
            for (int ai = 0; ai < 2; ++ai)
#pragma unroll
                for (int m = 0; m < 4; ++m) { bf16_t* rowp = C + (size_t)(row0 + ai * HALF + m * 16) * D + col0;
#pragma unroll
                    for (int bj = 0; bj < 2; ++bj) { const f32x4 v0 = sc * acc[ai][bj][m][0], v1 = sc * acc[ai][bj][m][1];
                        u32x4 w; w.x = cvt_pk_bf16(v0[0], v0[1]); w.y = cvt_pk_bf16(v0[2], v0[3]); w.z = cvt_pk_bf16(v1[0], v1[1]); w.w = cvt_pk_bf16(v1[2], v1[3]);
                        *(u32x4*)(rowp + bj * HALF) = w; } }
        } else {
            float* base = CB + ((size_t)(u.sub - 1) * (NSLOT - row_tail0) - (size_t)row_tail0) * D;
#pragma unroll
            for (int ai = 0; ai < 2; ++ai)
#pragma unroll
                for (int m = 0; m < 4; ++m) { float* rowp = base + (size_t)(row0 + ai * HALF + m * 16) * D + col0;
#pragma unroll
                    for (int bj = 0; bj < 2; ++bj)
#pragma unroll
                        for (int n = 0; n < 2; ++n) *(f32x4*)(rowp + bj * HALF + n * 4) = sc * acc[ai][bj][m][n]; }
        }
        ZERO_ACC();
    }
};
struct PlainOrder {
    const char* A; const char* B; int nM, nN, G, c; size_t tstep;
    __device__ __forceinline__ bool next(int i, Unit& u) const {
        const int L = i * G + c; if (c >= G || L >= nM * nN) return false;
        tile_of(L, nM, nN, u.pm, u.pn); u.sub = 0; u.aux = 0; u.a = A + (size_t)u.pm * tstep; u.b = B + (size_t)u.pn * tstep; return true;
    }
};
struct InprojOrder {
    const char* A; const char* B; int nM1, nctx, G, c; size_t tstep;
    __device__ __forceinline__ bool next(int i, Unit& u) const {
        const int L = i * G + c, n1 = nM1 * 55; u.sub = 0; u.aux = 0;
        if (c >= G) return false;
        if (L < n1) tile_of(L, nM1, 55, u.pm, u.pn);
        else { const int r = L - n1; if (r >= nctx * 17) return false; const int j = r % 17; u.pm = 32 + r / 17;
            u.pn = j < 8 ? 4 + j : (j < 10 ? 14 + (j - 8) : (j < 14 ? 16 + (j - 10) : (j < 16 ? 28 + (j - 14) : 54))); }
        u.a = A + (size_t)u.pm * tstep; u.b = B + (size_t)u.pn * tstep; return true;
    }
};
struct InprojSplitOrder {
    const char* A; const char* B; int nM1, nctx, G, c, kind; size_t tstep;
    __device__ __forceinline__ bool next(int i, Unit& u) const {
        u.sub = 0; u.aux = 0;
        if (c >= G) return false;
        if (kind == 0) { const int L = i * G + c, n1 = nM1 * 31;
            if (L < n1) { int j; tile_of(L, nM1, 31, u.pm, j); u.pn = j < 30 ? j : 54; }
            else { const int r = L - n1; if (r >= nctx * 17) return false; const int j = r % 17; u.pm = 32 + r / 17;
                u.pn = j < 8 ? 4 + j : (j < 10 ? 14 + (j - 8) : (j < 14 ? 16 + (j - 10) : (j < 16 ? 28 + (j - 14) : 54))); }
        } else { const int L = i * G + (G - 1 - c); if (L >= nM1 * 24) return false; int j; tile_of(L, nM1, 24, u.pm, j); u.pn = 30 + j; }
        u.a = A + (size_t)u.pm * tstep; u.b = B + (size_t)u.pn * tstep; return true;
    }
};
struct MergeOrder {
    const char* A0; size_t sA; const char* B0; size_t sB; int nM, G, c;
    __device__ __forceinline__ bool next(int i, Unit& u) const {
        const int T = (i / 3) * G + c; if (c >= G || T >= nM * 8) return false;
        tile_of(T, nM, 8, u.pm, u.pn); u.sub = i % 3; u.aux = 0;
        const size_t ts = (size_t)256 * 1024 * 2;
        u.a = A0 + (size_t)u.sub * sA + (size_t)u.pm * ts; u.b = B0 + (size_t)u.sub * sB + (size_t)u.pn * ts; return true;
    }
};
struct MoeOrder {
    const char* A; const char* B; int nN, G, c; size_t tstep, estride; const unsigned* cnt; int full_only;
    __device__ __forceinline__ bool next(int i, Unit& u) const {
        int e = 0, acc = 0, nblk = 0; const int L = i * G + c; u.pn = L % nN; u.pm = L / nN; u.sub = 0;
#pragma unroll
        for (int j = 0; j < 8; ++j) { const int cj = (int)__hip_atomic_load(cnt + j, __ATOMIC_RELAXED, __HIP_MEMORY_SCOPE_AGENT); acc += (cj + 255) / 256; if (j < 7) e += (u.pm >= acc) ? 1 : 0; }
        nblk = acc < 72 ? acc : 72;
        const int total = nblk * nN, lim = full_only ? (total / G) * G : total;
        if (L >= lim) return false;
        u.aux = e; u.a = A + (size_t)u.pm * tstep; u.b = B + (size_t)e * estride + (size_t)u.pn * tstep; return true;
    }
};
struct MoeTailOrder {
    const char* A; const char* B; int G, c; size_t tstep, estride; const unsigned* cnt;
    __device__ __forceinline__ bool next(int i, Unit& u) const {
        int acc = 0; int pend[8];
#pragma unroll
        for (int j = 0; j < 8; ++j) { const int cj = (int)__hip_atomic_load(cnt + j, __ATOMIC_RELAXED, __HIP_MEMORY_SCOPE_AGENT); acc += (cj + 255) / 256; pend[j] = acc; }
        const int nblk = acc < 72 ? acc : 72, total = nblk * 8, nfull = (total / G) * G, R = total - nfull;
        const int s = i * G + c; if (s >= 4 * R) return false;
        const int L = nfull + (s >> 2), q = s & 3; u.pn = L % 8; u.pm = L / 8; u.sub = q;
        int e = 0;
#pragma unroll
        for (int j = 0; j < 7; ++j) e += (u.pm >= pend[j]) ? 1 : 0;
        const int koff = (11 * q + (q & 1)) * 128;
        u.aux = 12 - 2 * (q & 1); u.a = A + (size_t)u.pm * tstep + (size_t)koff; u.b = B + (size_t)e * estride + (size_t)u.pn * tstep + (size_t)koff; return true;
    }
};
template <class Order>
__device__ __forceinline__ int fill_table(const Order& O, LAS UnitRec* tab, LAS int* ncell, int ti) {
    __syncthreads();
    asm volatile("" : "+v"(ti));
    if (ti < 64) {
        Unit u; const bool ok = O.next(ti, u);
        if (ok) { UnitRec r; r.a_lo = (unsigned)(unsigned long long)u.a; r.a_hi = (unsigned)((unsigned long long)u.a >> 32); r.b_lo = (unsigned)(unsigned long long)u.b; r.b_hi = (unsigned)((unsigned long long)u.b >> 32);
            r.pm = u.pm; r.pn = u.pn; r.sub = u.sub; r.aux = u.aux; LAS unsigned* t = (LAS unsigned*)(tab + ti);
            t[0] = r.a_lo; t[1] = r.a_hi; t[2] = r.b_lo; t[3] = r.b_hi; t[4] = (unsigned)r.pm; t[5] = (unsigned)r.pn; t[6] = (unsigned)r.sub; t[7] = (unsigned)r.aux; }
        const unsigned long long m = __ballot(ok);
        if (ti == 0) *ncell = __popcll(m);
    }
    __syncthreads();
    return __builtin_amdgcn_readfirstlane(*ncell);
}
}

constexpr size_t MiB = 1u << 20;
constexpr size_t al(size_t x) { return (x + 4095) & ~(size_t)4095; }
constexpr size_t WS_CTL = 0, CTL_BYTES = 1 * MiB;
constexpr size_t WS_MODP = WS_CTL + CTL_BYTES;
constexpr size_t WS_MOD = WS_MODP + al((size_t)16 * 2 * 5 * MOD_W * 4);
constexpr size_t WS_XR = WS_MOD + al((size_t)2 * 5 * MOD_W * 4);
constexpr size_t WS_H = WS_XR + al((size_t)NR * D * 4);
constexpr size_t WS_HS = WS_H + al((size_t)NR * D * 2);
constexpr size_t WS_P = WS_HS + al((size_t)NSLOT * D * 2);
constexpr size_t WS_ABF = WS_P + al((size_t)NR * PW * 2);
constexpr size_t WS_LG = WS_ABF + al((size_t)NR * 32 * 4);
constexpr size_t WS_OG = WS_LG + al((size_t)2 * NR * 512 * 4);
constexpr size_t WS_AO = WS_OG + al((size_t)2 * NR * 1024 * 4);
constexpr size_t WS_BO = WS_AO + al((size_t)NR * 1024 * 2);
constexpr size_t WS_CO = WS_BO + al((size_t)NR * 1024 * 2);
constexpr size_t WS_MG = WS_CO + al((size_t)NR * 1024 * 2);
constexpr size_t WS_ACT = WS_MG + al((size_t)NR * D * 2);
constexpr size_t WS_RT = WS_ACT + al((size_t)NSLOT * DFF * 2);
constexpr size_t WS_WIN = WS_RT + al((size_t)NL * 2 * 4 * 3);
constexpr size_t WS_WP = WS_WIN + al((size_t)2 * NIN * D * 2);
constexpr size_t WS_WOUT = WS_WP + al((size_t)2 * 3 * D * 1024 * 2);
constexpr size_t WS_DGU = WS_WOUT + al((size_t)2 * D * D * 2);
constexpr size_t WS_DDN = WS_DGU + al((size_t)2 * DFF * D * 2);
constexpr size_t WS_MGU = WS_DDN + al((size_t)D * DFF * 2);
constexpr size_t WS_MDN = WS_MGU + al((size_t)NE * 2 * DFF * D * 2);
constexpr size_t WS_VT = WS_MDN + al((size_t)NE * D * DFF * 2);
constexpr size_t WS_QT = WS_VT + al((size_t)NB * 2304 * 2304 * 2);
constexpr size_t WS_KV = WS_QT + al((size_t)2 * NR * 512 * 2);
constexpr size_t WS_DEC = WS_KV + al((size_t)1152 * 256 * 128 * 2);
constexpr size_t WS_QKN = WS_DEC + al((size_t)1152 * 128 * 4);
constexpr size_t WS_ROPE = WS_QKN + al((size_t)NR * 1280 * 2);
constexpr size_t WS_KVG = WS_ROPE + al((size_t)S * 64 * 8);
constexpr size_t WS_END = WS_KVG + al((size_t)NB * 2304 * 512 * 2);
static_assert((size_t)1152 * 256 * 128 * 2 <= (size_t)NSLOT * DFF * 2, "KVS (scan output) aliases ACT");
static_assert((size_t)NSLOT * D * 4 <= (size_t)NR * PW * 2, "Y2 fits in P");
constexpr int CW_BAR = 4096;
constexpr int CW_CNT = 16384;

constexpr int RING_BYTES = 131072, MISC_OFF = RING_BYTES + 320, UTAB_OFF = MISC_OFF + 128, LDS_BYTES = 147456;

struct Params { const float* in[28]; float* out; unsigned char* ws; int ph_lo, ph_hi; };

struct Ctx { LAS unsigned char* lds; int tid, lane, wave, bid, nb; };

__device__ __forceinline__ void ph_mod_partial(const Ctx& F, const float* c, const float* cctx, const float* w_ada, float* MODP) {
    LAS float* ca = (LAS float*)F.lds;
    for (int i = F.tid; i < 5 * D; i += NTHR) { const int r = i / D, k = i % D; const float v = r < 4 ? c[r * D + k] : cctx[k]; ca[i] = siluf_(v); }
    __syncthreads();
    for (int u = F.bid; u < 2 * 24 * 16; u += F.nb) {
        const int kc = u % 16, cb = (u / 16) % 24, layer = u / (16 * 24);
        const int j = cb * 512 + F.tid;
        const float* w = w_ada + ((size_t)layer * D + kc * 128) * MOD_W + j;
        float acc[5] = {0.f, 0.f, 0.f, 0.f, 0.f};
#pragma unroll 8
        for (int k = 0; k < 128; ++k) { const float wv = w[(size_t)k * MOD_W];
#pragma unroll
            for (int r = 0; r < 5; ++r) acc[r] += ca[r * D + kc * 128 + k] * wv; }
#pragma unroll
        for (int r = 0; r < 5; ++r) MODP[(((size_t)kc * 2 + layer) * 5 + r) * MOD_W + j] = acc[r];
    }
    __syncthreads();
}
__device__ __forceinline__ void ph_rope_table(const Ctx& F, float* ROPE) {
    for (int i = F.bid * NTHR + F.tid; i < S * 64; i += F.nb * NTHR) {
        const int t = i >> 6, pp = i & 63, j = pp & 31; const float pos = pp < 32 ? (float)(t / GW) : (float)(t % GW);
        const float ang = pos * powf(10000.f, -(float)(2 * j) / 64.f);
        ROPE[2 * i] = cosf(ang); ROPE[2 * i + 1] = sinf(ang);
    }
}
__device__ __forceinline__ void ph_mod_reduce(const Ctx& F, const float* MODP, const float* b_ada, float* MOD) {
    for (int i = F.bid * NTHR + F.tid; i < 2 * 5 * MOD_W; i += F.nb * NTHR) {
        const int j = i % MOD_W, layer = i / (5 * MOD_W);
        float s = b_ada[layer * MOD_W + j];
        for (int kc = 0; kc < 16; ++kc) s += MODP[(size_t)kc * 2 * 5 * MOD_W + i];
        MOD[i] = s;
    }
}
struct CvtJob { const float* src; bf16_t* dst; int K, Nsrc, nblk  , map  ; const float* src2; int f8  ; };
__device__ __forceinline__ const float* cvt_src(const CvtJob& J, int g32  , int& col) {
    const float* src = J.src; col = g32 * 32;
    if (J.map == 1) { if (g32 < 192) col = g32 * 32; else if (g32 < 432) col = g32 * 32 + 32; else if (g32 == 432) col = S_AF; else src = nullptr; }
    else if (J.map == 2) { const int tile = g32 >> 3, j = g32 & 7; col = tile * 128 + 32 * (j & 3); if (j >= 4) src = J.src2; }
    return src;
}
__device__ __forceinline__ void cvt_load(const CvtJob& J, int kb, int nbp, int tid, f32x4 (&v)[8]) {
    const int w = tid >> 6, lane = tid & 63, kg = lane & 7, nq = lane >> 3;
    int col; const float* src = cvt_src(J, nbp * 8 + w, col);
    const int k0 = kb * 64 + kg * 8;
    if (src) {
#pragma unroll
        for (int j = 0; j < 8; ++j) v[j] = __builtin_nontemporal_load((const f32x4*)(src + (size_t)(k0 + j) * J.Nsrc + col + 4 * nq));
    } else {
#pragma unroll
        for (int j = 0; j < 8; ++j) v[j] = (f32x4){0.f, 0.f, 0.f, 0.f};
    }
}
__device__ __forceinline__ void cvt_store(const CvtJob& J, int kb, int nbp, int tid, const f32x4 (&v)[8]) {
    const int w = tid >> 6, lane = tid & 63, kg = lane & 7, nq = lane >> 3;
    const int k0 = kb * 64 + kg * 8, r0 = nbp * 256 + 32 * w + 4 * nq;
    if (J.f8 == 1 || (J.f8 == 2 && r0 >= O_GA && r0 < O_GA + 3 * D)) {
        unsigned char* d8 = (unsigned char*)J.dst; const size_t pitch = J.f8 == 2 ? (size_t)2 * J.K : (size_t)J.K;
#pragma unroll
        for (int i = 0; i < 4; ++i) {
            u32x2 wv; wv.x = pk_fp8x4(32.f * v[0][i], 32.f * v[1][i], 32.f * v[2][i], 32.f * v[3][i]); wv.y = pk_fp8x4(32.f * v[4][i], 32.f * v[5][i], 32.f * v[6][i], 32.f * v[7][i]);
            __builtin_nontemporal_store(wv, (u32x2*)(d8 + (size_t)(r0 + i) * pitch + k0));
        }
        return;
    }
#pragma unroll
    for (int i = 0; i < 4; ++i) {
        u32x4 wv; wv.x = cvt_pk_bf16(v[0][i], v[1][i]); wv.y = cvt_pk_bf16(v[2][i], v[3][i]); wv.z = cvt_pk_bf16(v[4][i], v[5][i]); wv.w = cvt_pk_bf16(v[6][i], v[7][i]);
        __builtin_nontemporal_store(wv, (u32x4*)(J.dst + (size_t)(r0 + i) * J.K + k0));
    }
}
#define GF(k) ((const float*)(const GAS float*)p.in[k])
__device__ __forceinline__ void ph_convert(const Ctx& F, const Params& p) {
    unsigned char* ws = (unsigned char*)(GAS unsigned char*)p.ws;
    int base = 0;
#define CVT_RUN(SRC, SRC2, DST, KK, NSRC, NBLK, MAP, F8M) do { CvtJob J{SRC, DST, KK, NSRC, NBLK, MAP, SRC2, F8M}; const int nk = (KK) / 64, nit = nk * ((NBLK) / 2); \
        int it = (F.bid - base % F.nb + F.nb) % F.nb; \
        for (; it < nit; it += 2 * F.nb) { f32x4 va[8], vb[8]; const int it2 = it + F.nb; cvt_load(J, it % nk, it / nk, F.tid, va); if (it2 < nit) cvt_load(J, it2 % nk, it2 / nk, F.tid, vb); \
            cvt_store(J, it % nk, it / nk, F.tid, va); if (it2 < nit) cvt_store(J, it2 % nk, it2 / nk, F.tid, vb); } base += nit; } while (0)
    CVT_RUN(GF(8), nullptr, (bf16_t*)(ws + WS_WIN), D, DIN, NIN / 128, 1, 2);
    CVT_RUN(GF(15), nullptr, (bf16_t*)(ws + WS_WP) + (size_t)0 * D * 1024, 1024, D, D / 128, 0, 0);
    CVT_RUN(GF(16), nullptr, (bf16_t*)(ws + WS_WP) + (size_t)1 * D * 1024, 1024, D, D / 128, 0, 0);
    CVT_RUN(GF(17), nullptr, (bf16_t*)(ws + WS_WP) + (size_t)2 * D * 1024, 1024, D, D / 128, 0, 0);
    CVT_RUN(GF(18), nullptr, (bf16_t*)(ws + WS_WOUT), D, D, D / 128, 0, 0);
#undef CVT_RUN
}
constexpr int BG_WIN = 1760, BG_WP = 128, BG_WOUT = 256, BG_MGU = 1408, BG_MDN = 704, BG_DENSE = BG_MGU + BG_MDN, BG_TOTAL = BG_DENSE + BG_WIN + 3 * BG_WP + BG_WOUT + NE * (BG_MGU + BG_MDN);
__device__ __forceinline__ void bg_item(const Params& p, int t, CvtJob& J, int& kb, int& nbp) {
    unsigned char* ws = (unsigned char*)(GAS unsigned char*)p.ws;
    if (t < BG_MGU) { J = CvtJob{GF(19), (bf16_t*)(ws + WS_DGU), D, DFF, 2 * DFF / 128, 2, GF(20), 0}; }
    else if ((t -= BG_MGU) < BG_MDN) { J = CvtJob{GF(21), (bf16_t*)(ws + WS_DDN), DFF, D, D / 128, 0, nullptr, 1}; }
    else if ((t -= BG_MDN) < BG_WIN) { J = CvtJob{GF(8) + (size_t)D * DIN, (bf16_t*)(ws + WS_WIN) + (size_t)NIN * D, D, DIN, NIN / 128, 1, nullptr, 2}; }
    else if ((t -= BG_WIN) < 3 * BG_WP) { const int br = t / BG_WP; t -= br * BG_WP;
        J = CvtJob{(br == 0 ? GF(15) : (br == 1 ? GF(16) : GF(17))) + (size_t)1024 * D, (bf16_t*)(ws + WS_WP) + (size_t)(3 + br) * D * 1024, 1024, D, D / 128, 0, nullptr, 0}; }
    else if ((t -= 3 * BG_WP) < BG_WOUT) { J = CvtJob{GF(18) + (size_t)D * D, (bf16_t*)(ws + WS_WOUT) + (size_t)D * D, D, D, D / 128, 0, nullptr, 0}; }
    else if ((t -= BG_WOUT) < NE * BG_MGU) { const int e = t / BG_MGU; t -= e * BG_MGU;
        J = CvtJob{GF(24) + (size_t)e * D * DFF, (bf16_t*)(ws + WS_MGU + (size_t)e * 2 * DFF * D), D, DFF, 2 * DFF / 128, 2, GF(25) + (size_t)e * D * DFF, 1}; }
    else { t -= NE * BG_MGU; const int e = t / BG_MDN; t -= e * BG_MDN;
        J = CvtJob{GF(26) + (size_t)e * DFF * D, (bf16_t*)(ws + WS_MDN + (size_t)e * D * DFF), DFF, D, D / 128, 0, nullptr, 1}; }
    const int nk = J.K / 64; kb = t % nk; nbp = t / nk;
}
__device__ __forceinline__ void bg_convert(const Ctx& F, const Params& p, int t0, int n) {
    int t1 = t0 + n; if (t1 > BG_TOTAL) t1 = BG_TOTAL;
    for (int t = t0; t < t1; t += 2) {
        CvtJob Ja, Jb; int ka, na, kb2, nb2; f32x4 va[8], vb[8];
        bg_item(p, t, Ja, ka, na); cvt_load(Ja, ka, na, F.tid, va);
        const bool two = t + 1 < t1;
        if (two) { bg_item(p, t + 1, Jb, kb2, nb2); cvt_load(Jb, kb2, nb2, F.tid, vb); }
        cvt_store(Ja, ka, na, F.tid, va);
        if (two) cvt_store(Jb, kb2, nb2, F.tid, vb);
    }
}
#undef GF
template <bool ROUTER, bool F8OUT = false>
__device__ __forceinline__ void ph_norm(const Ctx& F, const float* X, const float* Xc  , const float* g, const float* modl, int sh_off, int sc_off, bf16_t* H, int rows,
                                        const float* rw, const float* rb, int* tok_e, float* tok_w, unsigned char* H8 = nullptr  ) {
    const int rstep = F.nb * NWAVES;
    LAS float* lrw = (LAS float*)F.lds;
    if (ROUTER) {
        __syncthreads();
        for (int q = F.tid; q < D * 2; q += NTHR) { const int c = q >> 1, hf = q & 1; const f32x4 w = *(const f32x4*)(rw + (size_t)c * 8 + hf * 4);
            *(LAS f32x4*)(lrw + (((c >> 8) * 4 + (c & 3)) * 64 + ((c & 255) >> 2)) * 8 + hf * 4) = w; }
        __syncthreads();
    }
    f32x4 nx[8];
    { const int row0 = F.bid * NWAVES + F.wave; if (row0 < rows) { const f32x4* xr = (const f32x4*)((Xc && row0 >= NL) ? Xc + (size_t)(row0 - NL) * D : X + (size_t)row0 * D) + F.lane;
#pragma unroll
        for (int j = 0; j < 8; ++j) nx[j] = xr[64 * j]; } }
    for (int row = F.bid * NWAVES + F.wave; row < rows; row += rstep) {
        int lro = 0; asm volatile("" : "+v"(lro));
        f32x4 v[8]; float ss = 0.f;
#pragma unroll
        for (int j = 0; j < 8; ++j) { v[j] = nx[j]; ss += v[j][0] * v[j][0] + v[j][1] * v[j][1] + v[j][2] * v[j][2] + v[j][3] * v[j][3]; }
        if (row + rstep < rows) { const int rn_ = row + rstep; const f32x4* xr = (const f32x4*)((Xc && rn_ >= NL) ? Xc + (size_t)(rn_ - NL) * D : X + (size_t)rn_ * D) + F.lane;
#pragma unroll
            for (int j = 0; j < 8; ++j) nx[j] = xr[64 * j]; }
        ss = wave_sum(ss);
        const float rs = rsqrtf(ss * (1.f / D) + EPS);
        const float* mb = modl + (size_t)batch_of(row) * MOD_W;
        float lg[8];
        if (ROUTER) {
#pragma unroll
            for (int e = 0; e < 8; ++e) lg[e] = 0.f; }
#pragma unroll
        for (int j = 0; j < 8; ++j) { const int c = 4 * F.lane + 256 * j;
            const f32x4 gg = *(const f32x4*)(g + c), sc = *(const f32x4*)(mb + sc_off + c), sh = *(const f32x4*)(mb + sh_off + c);
            f32x4 y;
#pragma unroll
            for (int i = 0; i < 4; ++i) y[i] = v[j][i] * rs * gg[i] * (1.f + sc[i]) + sh[i];
            if (H8) *(unsigned*)(H8 + (size_t)row * (2 * D) + c) = pk_fp8x4(y[0], y[1], y[2], y[3]);
            if (F8OUT) *(unsigned*)((unsigned char*)H + (size_t)row * D + c) = pk_fp8x4(y[0], y[1], y[2], y[3]);
            else { u32x2 w; w.x = pk2(y[0], y[1]); w.y = pk2(y[2], y[3]);
                *(u32x2*)(H + (size_t)row * D + c) = w; }
            if (ROUTER) {
#pragma unroll
                for (int i = 0; i < 4; ++i) { const LAS float* wl = lrw + lro + ((j * 4 + i) * 64 + F.lane) * 8; const f32x4 w0 = *(const LAS f32x4*)wl, w1 = *(const LAS f32x4*)(wl + 4);
#pragma unroll
                    for (int e = 0; e < 4; ++e) { lg[e] += y[i] * w0[e]; lg[4 + e] += y[i] * w1[e]; } } }
        }
        if (ROUTER) {
#pragma unroll
            for (int e = 0; e < 8; ++e) lg[e] = wave_sum(lg[e]) + rb[e];
            if (F.lane == 0) {
                int i0 = 0;
#pragma unroll
                for (int e = 1; e < 8; ++e) if (lg[e] > lg[i0]) i0 = e;
                int i1 = -1;
#pragma unroll
                for (int e = 0; e < 8; ++e) if (e != i0 && (i1 < 0 || lg[e] > lg[i1])) i1 = e;
                const float e1 = expf(lg[i1] - lg[i0]); const float w0 = 1.f / (1.f + e1);
                tok_e[row * 2] = i0; tok_e[row * 2 + 1] = i1; tok_w[row * 2] = w0; tok_w[row * 2 + 1] = e1 * w0;
            } }
    }
}
__device__ __forceinline__ void ph_prep(const Ctx& F, const bf16_t* P, const float* ROPE, bf16_t* QKN, bf16_t* KVGb, const float* ABF, const float* qn_g, const float* kn_g, const float* w_a2, const float* b_a, float* LG) {
    typedef float f32x2 __attribute__((ext_vector_type(2)));
    const f32x2 gq = *(const f32x2*)(qn_g + 2 * F.lane), gk = *(const f32x2*)(kn_g + 2 * F.lane);
    for (int r = F.bid * NWAVES + F.wave; r < NR; r += F.nb * NWAVES) {
        const bf16_t* pr = P + (size_t)r * PW + 2 * F.lane;
        unsigned v[10];
#pragma unroll
        for (int hh = 0; hh < 10; ++hh) v[hh] = *(const unsigned*)(pr + (hh < 8 ? O_GQQ + hh * 128 : O_GQK + (hh - 8) * 128));
        const unsigned vv0 = *(const unsigned*)(pr + O_GQV), vv1 = *(const unsigned*)(pr + O_GQV + 128);
        bf16_t* kvrow = KVGb + ((size_t)(r < NL ? (r >> 11) * 2304 + (r & (S - 1)) : ((r - NL) >> 8) * 2304 + S + ((r - NL) & (LC - 1)))) * 512;
        f32x2 cs2 = (f32x2){1.f, 0.f};
        if (r < NL) cs2 = *(const f32x2*)(ROPE + ((size_t)(r & (S - 1)) * 64 + F.lane) * 2);
#pragma unroll
        for (int hh = 0; hh < 10; ++hh) {
            float x1 = __uint_as_float(v[hh] << 16), x2 = __uint_as_float(v[hh] & 0xffff0000u);
            const float ss = wave_sum(x1 * x1 + x2 * x2);
            const float rs = rsqrtf(ss * (1.f / 128.f) + EPS);
            const f32x2 gg = hh < 8 ? gq : gk;
            x1 = x1 * rs * gg.x; x2 = x2 * rs * gg.y;
            const float o1 = x1 * cs2.x - x2 * cs2.y, o2 = x1 * cs2.y + x2 * cs2.x;
            if (hh < 8) *(unsigned*)(QKN + (size_t)r * 1280 + hh * 128 + 2 * F.lane) = pk2(o1, o2);
            else *(unsigned*)(kvrow + (hh - 8) * 128 + 2 * F.lane) = pk2(o1, o2);
        }
        *(unsigned*)(kvrow + 256 + 2 * F.lane) = vv0; *(unsigned*)(kvrow + 384 + 2 * F.lane) = vv1;
    }
    {
        const int c = F.tid;
        float w0[16], w1[16];
#pragma unroll
        for (int j = 0; j < 16; ++j) { w0[j] = w_a2[j * 512 + c]; w1[j] = w_a2[(16 + j) * 512 + c]; }
        const float b0 = b_a[c], b1 = b_a[512 + c];
        float an = 0.f;
        if (F.bid < NR) an = ABF[(size_t)F.bid * 32 + (F.lane & 31)];
        for (int r = F.bid; r < NR; r += F.nb) {
            const float a = an;
            if (r + F.nb < NR) an = ABF[(size_t)(r + F.nb) * 32 + (F.lane & 31)];
            float z0 = b0, z1 = b1;
#pragma unroll
            for (int j = 0; j < 16; ++j) { z0 += __uint_as_float(__builtin_amdgcn_readlane(__float_as_uint(a), j)) * w0[j]; z1 += __uint_as_float(__builtin_amdgcn_readlane(__float_as_uint(a), 16 + j)) * w1[j]; }
            const float l0 = fminf(z0, 0.f) - 0.6931471805599453f * __builtin_amdgcn_logf(1.f + __builtin_amdgcn_exp2f(-fabsf(z0) * LOG2E));
            const float l1 = fminf(z1, 0.f) - 0.6931471805599453f * __builtin_amdgcn_logf(1.f + __builtin_amdgcn_exp2f(-fabsf(z1) * LOG2E));
            LG[(size_t)r * 512 + c] = l0 * (1.f / 16.f); LG[((size_t)NR + r) * 512 + c] = l1 * (1.f / 16.f);
        }
    }
}
__device__ __forceinline__ void ph_vt(const Ctx& F, const bf16_t* P, bf16_t* VT) {
    LAS bf16_t* T = (LAS bf16_t*)F.lds;
    const int r = F.tid >> 3, ch = F.tid & 7;
#define VT_SRC(it_) ({ const int b_ = (it_) / (36 * 36), ct_ = ((it_) / 36) % 36, tt_ = (it_) % 36; const int c0_ = ct_ * 64, pc_ = c0_ < 1024 ? O_NAV + c0_ : (c0_ < 2048 ? O_GLV + (c0_ - 1024) : O_GQV + (c0_ - 2048)); \
        const int tok0_ = tt_ * 64, row0_ = tok0_ < S ? b_ * S + tok0_ : NL + b_ * LC + (tok0_ - S); (const u32x4*)(P + (size_t)(row0_ + r) * PW + pc_ + ch * 8); })
    u32x4 nx = (u32x4){0u, 0u, 0u, 0u};
    if (F.bid < NB * 36 * 36) nx = *VT_SRC(F.bid);
    for (int it = F.bid; it < NB * 36 * 36; it += F.nb) {
        const int b = it / (36 * 36), ct = (it / 36) % 36, tt = it % 36, c0 = ct * 64, tok0 = tt * 64;
        const u32x4 v = nx;
        if (it + F.nb < NB * 36 * 36) nx = *VT_SRC(it + F.nb);
        __syncthreads();
        *(LAS u32x4*)(T + r * 72 + ch * 8) = v;
        __syncthreads();
        { const int c = F.tid >> 3, tc = F.tid & 7; unsigned w[4];
#pragma unroll
          for (int j = 0; j < 4; ++j) w[j] = (unsigned)T[(8 * tc + 2 * j) * 72 + c] | ((unsigned)T[(8 * tc + 2 * j + 1) * 72 + c] << 16);
          *(u32x4*)(VT + ((size_t)b * 2304 + c0 + c) * 2304 + tok0 + 8 * tc) = (u32x4){w[0], w[1], w[2], w[3]}; }
    }
#undef VT_SRC
    __syncthreads();
}
#define MFMA16(a, b, c) __builtin_amdgcn_mfma_f32_16x16x32_bf16((a), (b), (c), 0, 0, 0)
__device__ __forceinline__ void ph_na(const Ctx& F, const bf16_t* P, const bf16_t* VT, const float* rpb, bf16_t* AO, int u_lo, int u_hi) {
    const int lane = F.lane, fr = lane & 15, g = lane >> 4;
    LAS float* bias_s = (LAS float*)F.lds + F.wave * 640 + 64;
    const int kperm = 8 * (fr >> 2) + (fr & 3);
    const int xu_ = (u_hi > 2048 && F.bid >= F.nb / 2 && F.wave < 2) ? 2048 + (F.bid - F.nb / 2) * 2 + F.wave : u_hi;
    for (int u = u_lo + F.bid * NWAVES + F.wave; u < u_hi; u = (u < 2048 ? xu_ : u_hi)) {
        const bool lat = u < 2048;
        int b, h, r = 0, qrow0;
        if (lat) { b = u >> 9; r = (u >> 4) & 31; h = u & 15; qrow0 = b * S + r * GW; }
        else { const int v = u - 2048; b = v >> 6; h = v & 15; qrow0 = NL + b * LC + ((v >> 4) & 3) * 64; }
        if (lat) { for (int i = lane; i < 465; i += 64) bias_s[i] = rpb[h * 465 + i] * LOG2E; }
        bf16x8 Qf[4][2];
#pragma unroll
        for (int nq = 0; nq < 4; ++nq)
#pragma unroll
            for (int ks = 0; ks < 2; ++ks) Qf[nq][ks] = *(const bf16x8*)(P + (size_t)(qrow0 + 16 * nq + fr) * PW + O_NAQ + h * 64 + 32 * ks + 8 * g);
        f32x4 O[4][4]; float m[4], l[4];
        int dcb[4], dlo[4];
#pragma unroll
        for (int nq = 0; nq < 4; ++nq) { m[nq] = -1e30f; l[nq] = 0.f; const int qcol = 16 * nq + fr, c0 = min(max(qcol - 8, 0), 48); dcb[nq] = 8 * g - qcol + 15; dlo[nq] = 8 * g - c0;
#pragma unroll
            for (int db = 0; db < 4; ++db) O[nq][db] = (f32x4){0.f, 0.f, 0.f, 0.f}; }
        const int r0 = min(max(r - 4, 0), 24);
        const int ntile = lat ? 12 : 4;
        __builtin_amdgcn_s_waitcnt(0); __builtin_amdgcn_wave_barrier();
#define NA_KADDR(s_, t_, ks_) ({ const int ti_ = (s_) >> 1, kb_ = (s_) & 1; const int kr_ = ti_ < 4 ? NL + b * LC + ti_ * 64 : b * S + (r0 + ti_ - 4) * GW; \
            (const bf16x8*)(P + (size_t)(kr_ + 32 * kb_ + kperm + 4 * (t_)) * PW + O_NAK + h * 64 + 32 * (ks_) + 8 * g); })
        const int nstep = 2 * ntile;
#define NA_VADDR(s_, db_) ({ const int ti_ = (s_) >> 1, kb_ = (s_) & 1; const int vt_ = ti_ < 4 ? S + ti_ * 64 : (r0 + ti_ - 4) * GW; \
            (const bf16x8*)(VT + ((size_t)b * 2304 + h * 64 + 16 * (db_) + fr) * 2304 + vt_ + 32 * kb_ + 8 * g); })
        bf16x8 Kn[2][2], Vn[4];
#pragma unroll
        for (int t = 0; t < 2; ++t)
#pragma unroll
            for (int ks = 0; ks < 2; ++ks) Kn[t][ks] = *NA_KADDR(0, t, ks);
#pragma unroll
        for (int db = 0; db < 4; ++db) Vn[db] = *NA_VADDR(0, db);
#pragma unroll 1
        for (int st = 0; st < nstep; ++st) {
            const int ti = st >> 1, kb = st & 1;
            const bool ctile = ti < 4; const int w = ti - 4;
            bf16x8 Kf[2][2];
#pragma unroll
            for (int t = 0; t < 2; ++t)
#pragma unroll
                for (int ks = 0; ks < 2; ++ks) Kf[t][ks] = Kn[t][ks];
            bf16x8 Vf[4];
#pragma unroll
            for (int db = 0; db < 4; ++db) Vf[db] = Vn[db];
            if (st + 1 < nstep) {
#pragma unroll
                for (int t = 0; t < 2; ++t)
#pragma unroll
                    for (int ks = 0; ks < 2; ++ks) Kn[t][ks] = *NA_KADDR(st + 1, t, ks);
#pragma unroll
                for (int db = 0; db < 4; ++db) Vn[db] = *NA_VADDR(st + 1, db);
            }
            const int trow = 31 * (r0 + w - r + 7) + 32 * kb;
#pragma unroll
            for (int nq = 0; nq < 4; ++nq) {
                if (!ctile && ((nq == 0 && kb == 1) || (nq == 3 && kb == 0))) continue;
                f32x4 s0 = (f32x4){0.f, 0.f, 0.f, 0.f}, s1 = (f32x4){0.f, 0.f, 0.f, 0.f};
                s0 = MFMA16(Kf[0][0], Qf[nq][0], s0); s0 = MFMA16(Kf[0][1], Qf[nq][1], s0);
                s1 = MFMA16(Kf[1][0], Qf[nq][0], s1); s1 = MFMA16(Kf[1][1], Qf[nq][1], s1);
                float x[8];
                if (!ctile) {
                    const LAS float* bp = bias_s + (trow + dcb[nq]);
                    float bv[8];
#pragma unroll
                    for (int j = 0; j < 8; ++j) bv[j] = bp[j];
                    const int dl = dlo[nq] + 32 * kb;
#pragma unroll
                    for (int j = 0; j < 8; ++j) { const float sv = j < 4 ? s0[j] : s1[j - 4]; const float t_ = __builtin_fmaf(sv, 0.125f * LOG2E, bv[j]); x[j] = ((unsigned)(dl + j) < 16u) ? t_ : -1e30f; }
                } else {
#pragma unroll
                    for (int i = 0; i < 4; ++i) { x[i] = s0[i] * (0.125f * LOG2E); x[4 + i] = s1[i] * (0.125f * LOG2E); }
                }
                float mx = fmaxf(fmaxf(fmaxf(x[0], x[1]), fmaxf(x[2], x[3])), fmaxf(fmaxf(x[4], x[5]), fmaxf(x[6], x[7])));
                mx = fmaxf(mx, xshfl<16>(mx)); mx = max_x32(mx);
                const float mn = fmaxf(m[nq], mx);
                if (!__all(mn == m[nq])) {
                    const float alpha = __builtin_amdgcn_exp2f(m[nq] - mn);
                    l[nq] *= alpha; m[nq] = mn;
#pragma unroll
                    for (int db = 0; db < 4; ++db) O[nq][db] = O[nq][db] * alpha;
                }
#pragma unroll
                for (int j = 0; j < 8; ++j) x[j] = __builtin_amdgcn_exp2f(x[j] - mn);
                l[nq] += ((x[0] + x[1]) + (x[2] + x[3])) + ((x[4] + x[5]) + (x[6] + x[7]));
                u32x4 pw; pw.x = cvt_pk_bf16(x[0], x[1]); pw.y = cvt_pk_bf16(x[2], x[3]); pw.z = cvt_pk_bf16(x[4], x[5]); pw.w = cvt_pk_bf16(x[6], x[7]);
                const bf16x8 Pq = __builtin_bit_cast(bf16x8, pw);
#pragma unroll
                for (int db = 0; db < 4; ++db) O[nq][db] = MFMA16(Vf[db], Pq, O[nq][db]);
            }
        }
#undef NA_KADDR
#undef NA_VADDR
#pragma unroll
        for (int nq = 0; nq < 4; ++nq) { float lt = l[nq]; lt += xshfl<16>(lt); lt = sum_x32(lt); const float inv = 1.f / lt;
#pragma unroll
            for (int db = 0; db < 4; ++db) { const f32x4 o = O[nq][db] * inv; u32x2 wv; wv.x = cvt_pk_bf16(o[0], o[1]); wv.y = cvt_pk_bf16(o[2], o[3]);
                *(u32x2*)(AO + (size_t)(qrow0 + 16 * nq + fr) * 1024 + h * 64 + 16 * db + 4 * g) = wv; } }
        __builtin_amdgcn_s_waitcnt(0); __builtin_amdgcn_wave_barrier();
    }
}
namespace ga {
constexpr int D_ = 128, NW = 8, QBLK = 32, KVBLK = 64;
constexpr float SCALE = 0.088388347648318440f, THR = 8.f;
constexpr int SDEPTH = 1;
constexpr int LDQ = 1280, LDK = 512, LDO = 1024;
constexpr size_t SHM_V = KVBLK * D_ * 2, SHM_K = KVBLK * D_ * 2, SHM_ATTN = 2 * SHM_V + 2 * SHM_K + NW * 64 * 4;
typedef short s16x4 __attribute__((ext_vector_type(4)));
typedef float f32x16 __attribute__((ext_vector_type(16)));
#define GA_KSWZ(row, colB) ((row) * 256 + ((colB) ^ (((row) & 7) << 4)))
#define GA_SBAR() __builtin_amdgcn_sched_barrier(0)
__device__ __forceinline__ int crow(int r, int hi) { return (r & 3) + 8 * (r >> 2) + 4 * hi; }
__device__ __forceinline__ unsigned cvtpk(float lo, float hi) { return cvt_pk_bf16(lo, hi); }
__device__ __forceinline__ bf16x8 ld8(const bf16_t* p) { return *reinterpret_cast<const bf16x8*>(p); }
__device__ __forceinline__ void partialSM(f32x16& p0, f32x16& p1, float& m_reg, float& mn, float& alpha) {
  constexpr float C = SCALE * 1.4426950408889634f;
  float pmax = p0[0];
#pragma unroll
  for (int r = 1; r < 16; ++r) pmax = fmaxf(pmax, p0[r]);
#pragma unroll
  for (int r = 0; r < 16; ++r) pmax = fmaxf(pmax, p1[r]);
  { auto rr = __builtin_amdgcn_permlane32_swap(__float_as_uint(pmax), __float_as_uint(pmax), false, false);
    pmax = fmaxf(__uint_as_float(rr[0]), __uint_as_float(rr[1])); }
  if (__builtin_expect(__all(pmax - m_reg <= THR / SCALE), 1)) { mn = m_reg; alpha = 1.f; }
  else { mn = fmaxf(m_reg, pmax); alpha = __builtin_amdgcn_exp2f((m_reg - mn) * C); m_reg = mn; }
  float mnC = -mn * C;
#pragma unroll
  for (int r = 0; r < 16; ++r) p0[r] = fmaf(p0[r], C, mnC);
#pragma unroll
  for (int r = 0; r < 16; ++r) p1[r] = fmaf(p1[r], C, mnC);
#pragma unroll
  for (int r = 0; r < 16; ++r) p0[r] = __builtin_amdgcn_exp2f(p0[r]);
}
__device__ __forceinline__ void finishSM(f32x16& p0, f32x16& p1, float alpha, float& l_reg, bf16x8& pa0, bf16x8& pa1, bf16x8& pa2, bf16x8& pa3) {
#pragma unroll
  for (int r = 0; r < 16; ++r) p1[r] = __builtin_amdgcn_exp2f(p1[r]);
  float ps = 0;
#pragma unroll
  for (int r = 0; r < 16; ++r) ps += p0[r];
#pragma unroll
  for (int r = 0; r < 16; ++r) ps += p1[r];
  { auto rr = __builtin_amdgcn_permlane32_swap(__float_as_uint(ps), __float_as_uint(ps), false, false);
    ps = __uint_as_float(rr[0]) + __uint_as_float(rr[1]); }
  l_reg = l_reg * alpha + ps;
#define GA_PK4(P_, BASE, OUT) do { unsigned a0 = cvtpk(P_[BASE + 0], P_[BASE + 1]), a1 = cvtpk(P_[BASE + 2], P_[BASE + 3]);   \
    unsigned b0 = cvtpk(P_[BASE + 4], P_[BASE + 5]), b1 = cvtpk(P_[BASE + 6], P_[BASE + 7]);                              \
    auto r0 = __builtin_amdgcn_permlane32_swap(a0, b0, false, false); auto r1 = __builtin_amdgcn_permlane32_swap(a1, b1, false, false); \
    u32x4 w = {r0[0], r1[0], r0[1], r1[1]}; OUT = __builtin_bit_cast(bf16x8, w); } while (0)
  GA_PK4(p0, 0, pa0); GA_PK4(p0, 8, pa1); GA_PK4(p1, 0, pa2); GA_PK4(p1, 8, pa3);
#undef GA_PK4
}
__device__ __forceinline__ void qkt(f32x16& p0, f32x16& p1, const char* Ks, const bf16x8* qr, int r32, int hi) {
  p0 = f32x16{}; p1 = f32x16{};
#pragma unroll
  for (int d0 = 0; d0 < 8; ++d0) { int cb = (d0 * 16 + hi * 8) * 2;
    bf16x8 b0 = *reinterpret_cast<const bf16x8*>(Ks + GA_KSWZ(r32, cb));
    bf16x8 b1 = *reinterpret_cast<const bf16x8*>(Ks + GA_KSWZ(32 + r32, cb));
    p0 = __builtin_amdgcn_mfma_f32_32x32x16_bf16(b0, qr[d0], p0, 0, 0, 0);
    p1 = __builtin_amdgcn_mfma_f32_32x32x16_bf16(b1, qr[d0], p1, 0, 0, 0); }
}
__device__ __forceinline__ int v_st(int k, int c) { const int kk = (k & ~0xC) | ((k & 4) << 1) | ((k & 8) >> 1); return ((kk >> 3) * 4 + (c >> 5)) * 512 + ((kk & 7) * 32 + (c & 31)) * 2; }
__device__ __forceinline__ int v_rd_base(int lane) { return ((lane & 3) << 3) | (((lane >> 2) & 3) << 6) | (((lane >> 4) & 1) << 5) | (((lane >> 5) & 1) << 8); }
constexpr int v_rd_off(int d0, int ks, int half) { return d0 * 512 + ks * 4096 + half * 2048; }
template <int OFF> __device__ __forceinline__ s16x4 tr_read(int vb) {
  s16x4 r; asm volatile("ds_read_b64_tr_b16 %0, %1 offset:%2" : "=&v"(r) : "v"(vb), "i"(OFF) : "memory"); return r;
}
template <int D0> __device__ __forceinline__ void pv_one(f32x16& od, int vb, bf16x8 pa0, bf16x8 pa1, bf16x8 pa2, bf16x8 pa3) {
  const s16x4 l0 = tr_read<v_rd_off(D0, 0, 0)>(vb), h0 = tr_read<v_rd_off(D0, 0, 1)>(vb), l1 = tr_read<v_rd_off(D0, 1, 0)>(vb), h1 = tr_read<v_rd_off(D0, 1, 1)>(vb);
  const s16x4 l2 = tr_read<v_rd_off(D0, 2, 0)>(vb), h2 = tr_read<v_rd_off(D0, 2, 1)>(vb), l3 = tr_read<v_rd_off(D0, 3, 0)>(vb), h3 = tr_read<v_rd_off(D0, 3, 1)>(vb);
  asm volatile("s_waitcnt lgkmcnt(0)" ::: "memory"); GA_SBAR();
#define GA_PK(L, H) (bf16x8){L[0], L[1], L[2], L[3], H[0], H[1], H[2], H[3]}
  od = __builtin_amdgcn_mfma_f32_32x32x16_bf16(pa0, GA_PK(l0, h0), od, 0, 0, 0);
  od = __builtin_amdgcn_mfma_f32_32x32x16_bf16(pa1, GA_PK(l1, h1), od, 0, 0, 0);
  od = __builtin_amdgcn_mfma_f32_32x32x16_bf16(pa2, GA_PK(l2, h2), od, 0, 0, 0);
  od = __builtin_amdgcn_mfma_f32_32x32x16_bf16(pa3, GA_PK(l3, h3), od, 0, 0, 0);
#undef GA_PK
}
__device__ __forceinline__ void pv_d0(f32x16* o, int vb, bf16x8 pa0, bf16x8 pa1, bf16x8 pa2, bf16x8 pa3) {
  pv_one<0>(o[0], vb, pa0, pa1, pa2, pa3); pv_one<1>(o[1], vb, pa0, pa1, pa2, pa3); pv_one<2>(o[2], vb, pa0, pa1, pa2, pa3); pv_one<3>(o[3], vb, pa0, pa1, pa2, pa3);
}
__device__ __forceinline__ void attn_dense_body(const bf16_t* __restrict__ Qb, const bf16_t* __restrict__ Kh, const bf16_t* __restrict__ Vh, bf16_t* __restrict__ Ob, int seq, char* lds, int tid) {
  const int wid = tid >> 6, lane = tid & 63, r32 = lane & 31, hi = lane >> 5;
  char* V_lds = lds; char* K_lds = lds + 2 * SHM_V;
  float* wsf = (float*)(lds + 2 * SHM_V + 2 * SHM_K) + wid * 64; float* li_l = wsf; float* al_l = wsf + 32;
  float m_reg = -1e30f, l_reg = 0; f32x16 o[4] = {}; bf16x8 qr[8];
  const bf16_t* Qw = Qb + (long)(wid * QBLK + r32) * LDQ + hi * 8;
#pragma unroll
  for (int d0 = 0; d0 < 8; ++d0) qr[d0] = ld8(Qw + d0 * 16);
  const int sr = tid >> 4, sc = (tid & 15) * 8, vst0 = v_st(sr, sc), vst1 = v_st(32 + sr, sc);
  const int vb0 = (int)(uintptr_t)V_lds + v_rd_base(lane);
  struct { bf16x8 vs0, vs1, ks0, ks1; } sr_[SDEPTH];
#define GA_SLOAD(i, k0) do { sr_[i].vs0 = ld8(&Vh[(long)((k0) + sr) * LDK + sc]); sr_[i].vs1 = ld8(&Vh[(long)((k0) + 32 + sr) * LDK + sc]); \
    sr_[i].ks0 = ld8(&Kh[(long)((k0) + sr) * LDK + sc]); sr_[i].ks1 = ld8(&Kh[(long)((k0) + 32 + sr) * LDK + sc]); } while (0)
#define GA_SWRITE(b, i) do { *(bf16x8*)(V_lds + (b) * SHM_V + vst0) = sr_[i].vs0;          \
    *(bf16x8*)(V_lds + (b) * SHM_V + vst1) = sr_[i].vs1; int kc = sc * 2;               \
    *(bf16x8*)(K_lds + (b) * SHM_K + GA_KSWZ(sr, kc)) = sr_[i].ks0;                       \
    *(bf16x8*)(K_lds + (b) * SHM_K + GA_KSWZ(32 + sr, kc)) = sr_[i].ks1; } while (0)
#define GA_SWAIT() do { if (SDEPTH == 2) asm volatile("s_waitcnt vmcnt(4)" ::: "memory"); else asm volatile("s_waitcnt vmcnt(0)" ::: "memory"); } while (0)
#define GA_RESC(a) do { if (__any((a) < 1.f)) { if (hi == 0) al_l[r32] = (a); asm volatile("s_waitcnt lgkmcnt(0)" ::: "memory"); \
    _Pragma("unroll") for (int d = 0; d < 4; ++d) _Pragma("unroll") for (int r = 0; r < 16; ++r) o[d][r] *= al_l[crow(r, hi)]; } } while (0)
  f32x16 pA0, pA1, pB0, pB1; float mnA, mnB, alA, alB; bf16x8 pa0, pa1, pa2, pa3; const int NT = seq / KVBLK;
  constexpr int SE = 0, SO = SDEPTH - 1;
  GA_SLOAD(SE, 0); asm volatile("s_waitcnt vmcnt(0)" ::: "memory"); GA_SWRITE(0, SE); __syncthreads();
  qkt(pA0, pA1, K_lds, qr, r32, hi); partialSM(pA0, pA1, m_reg, mnA, alA);
  GA_SLOAD(SO, KVBLK); if (SDEPTH == 2) { if (2 < NT) GA_SLOAD(SE, 2 * KVBLK); }
  GA_SWAIT(); GA_SWRITE(1, SO); __syncthreads();
  for (int j = 1; j + 1 < NT; j += 2) {
    GA_SBAR(); qkt(pB0, pB1, K_lds + SHM_K, qr, r32, hi);
    finishSM(pA0, pA1, alA, l_reg, pa0, pa1, pa2, pa3); GA_SBAR();
    GA_SLOAD(SO, (j + SDEPTH) * KVBLK); GA_SBAR();
    pv_d0(o, vb0, pa0, pa1, pa2, pa3); partialSM(pB0, pB1, m_reg, mnB, alB);
    __syncthreads(); GA_SWAIT(); GA_SWRITE(0, SE);
    GA_RESC(alB); __syncthreads();
    GA_SBAR(); qkt(pA0, pA1, K_lds, qr, r32, hi);
    finishSM(pB0, pB1, alB, l_reg, pa0, pa1, pa2, pa3); GA_SBAR();
    if (SDEPTH == 1 || j + 3 < NT) GA_SLOAD(SE, (j + 1 + SDEPTH) * KVBLK); GA_SBAR();
    pv_d0(o, vb0 + (int)SHM_V, pa0, pa1, pa2, pa3); partialSM(pA0, pA1, m_reg, mnA, alA);
    __syncthreads(); GA_SWAIT(); GA_SWRITE(1, SO);
    GA_RESC(alA); __syncthreads();
  }
  GA_SBAR(); qkt(pB0, pB1, K_lds + SHM_K, qr, r32, hi);
  finishSM(pA0, pA1, alA, l_reg, pa0, pa1, pa2, pa3); GA_SBAR();
  pv_d0(o, vb0, pa0, pa1, pa2, pa3); partialSM(pB0, pB1, m_reg, mnB, alB);
  __syncthreads(); GA_RESC(alB);
  finishSM(pB0, pB1, alB, l_reg, pa0, pa1, pa2, pa3); GA_SBAR();
  pv_d0(o, vb0 + (int)SHM_V, pa0, pa1, pa2, pa3);
  if (hi == 0) li_l[r32] = l_reg; asm volatile("s_waitcnt lgkmcnt(0)" ::: "memory");
  float rli[16];
#pragma unroll
  for (int r = 0; r < 16; ++r) rli[r] = __builtin_amdgcn_rcpf(li_l[crow(r, hi)]);
  bf16_t* Ow = Ob + (long)(wid * QBLK) * LDO;
#pragma unroll
  for (int r = 0; r < 16; ++r) { int orow = crow(r, hi);
#pragma unroll
    for (int d0 = 0; d0 < 4; ++d0) Ow[(long)orow * LDO + d0 * 32 + r32] = (bf16_t)f2bf(o[d0][r] * rli[r]); }
  asm volatile("s_waitcnt vmcnt(0) lgkmcnt(0)" ::: "memory"); __syncthreads();
#undef GA_SLOAD
#undef GA_SWRITE
#undef GA_SWAIT
#undef GA_RESC
}
}
__device__ __forceinline__ void ph_gqa2(const Ctx& F, const bf16_t* QKN, const bf16_t* KVGb, bf16_t* CO, bool with_ctx, char* lds_generic) {
    const int nunits = 256 + (with_ctx ? 32 : 0);
    for (int u = F.bid; u < nunits; u += F.nb) {
        const bool lat = u < 256;
        int b, hq, qrow0, tok0, seq;
        if (lat) { b = u >> 6; hq = (u >> 3) & 7; qrow0 = b * S + (u & 7) * 256; tok0 = 0; seq = S + LC; }
        else { const int v = u - 256; b = v >> 3; hq = v & 7; qrow0 = NL + b * LC; tok0 = S; seq = LC; }
        const bf16_t* Kh = KVGb + ((size_t)b * 2304 + tok0) * 512 + (hq >> 2) * 128;
        ga::attn_dense_body(QKN + (size_t)qrow0 * 1280 + hq * 128, Kh, Kh + 256, CO + (size_t)qrow0 * 1024 + hq * 128, seq, lds_generic, F.tid);
    }
}
__device__ __forceinline__ void gla_unit_rows(int b, int c, int& row0, int& tok0) { if (c < 4) { row0 = NL + b * LC + 64 * c; tok0 = S + 64 * c; } else { row0 = b * S + 64 * (c - 4); tok0 = 64 * (c - 4); } }
__device__ __forceinline__ void ph_gla_a(const Ctx& F, const bf16_t* P, const bf16_t* VT, const float* LG, bf16_t* OG, bf16_t* QT, bf16_t* KVb, float* DEC) {
    const int lane = F.lane, fr = lane & 15, g = lane >> 4, tid = F.tid, w = F.wave;
    LAS float* Gs = (LAS float*)F.lds;
    LAS unsigned char* Qt = F.lds + 32768;
    LAS unsigned char* Kt = F.lds + 50176;
    LAS unsigned char* KhT = F.lds + 67584;
    LAS unsigned char* Pfr = F.lds + 86016;
    LAS float* Seg = (LAS float*)(F.lds + 94208);
    for (int u = F.bid; u < 1152; u += F.nb) {
        const int c = u % 36, h = (u / 36) & 3, b = (u / 144) & 3, dir = u / 576;
        int row0, tok0; gla_unit_rows(b, c, row0, tok0);
        __syncthreads();
        bf16x8 Vf[2][2];
#pragma unroll
        for (int db = 0; db < 2; ++db)
#pragma unroll
            for (int jb = 0; jb < 2; ++jb) Vf[db][jb] = *(const bf16x8*)(VT + ((size_t)b * 2304 + 1024 + h * 256 + 32 * w + 16 * db + fr) * 2304 + tok0 + 32 * jb + 8 * g);
        {
            const int col = tid & 127, seg = tid >> 7;
            float v[16];
#pragma unroll
            for (int i = 0; i < 16; ++i) v[i] = LG[((size_t)dir * NR + row0 + seg * 16 + i) * 512 + h * 128 + col];
            if (dir == 0) {
#pragma unroll
                for (int i = 1; i < 16; ++i) v[i] += v[i - 1];
                Seg[seg * 128 + col] = v[15];
            } else {
#pragma unroll
                for (int i = 14; i >= 0; --i) v[i] += v[i + 1];
                Seg[seg * 128 + col] = v[0];
            }
            __syncthreads();
            float off = 0.f;
            if (dir == 0) { for (int s2 = 0; s2 < seg; ++s2) off += Seg[s2 * 128 + col]; }
            else { for (int s2 = 3; s2 > seg; --s2) off += Seg[s2 * 128 + col]; }
#pragma unroll
            for (int i = 0; i < 16; ++i) Gs[(seg * 16 + i) * 128 + col] = v[i] + off;
        }
        __syncthreads();
        {
            const int tok = tid >> 3, d0 = (tid & 7) * 16;
            const bf16_t* pr = P + (size_t)(row0 + tok) * PW;
            const u32x4 q0 = *(const u32x4*)(pr + O_GLQ + h * 128 + d0), q1 = *(const u32x4*)(pr + O_GLQ + h * 128 + d0 + 8);
            const u32x4 k0 = *(const u32x4*)(pr + O_GLK + h * 128 + d0), k1 = *(const u32x4*)(pr + O_GLK + h * 128 + d0 + 8);
            const unsigned qw[8] = {q0.x, q0.y, q0.z, q0.w, q1.x, q1.y, q1.z, q1.w}, kw[8] = {k0.x, k0.y, k0.z, k0.w, k1.x, k1.y, k1.z, k1.w};
            const int glast = dir == 0 ? 63 : 0;
            unsigned qo[8], ko[8];
#pragma unroll
            for (int p2 = 0; p2 < 8; ++p2) {
                float qt[2], kt[2], kh[2];
#pragma unroll
                for (int e = 0; e < 2; ++e) { const int dk = d0 + 2 * p2 + e;
                    const float gg = Gs[tok * 128 + dk], GG = Gs[glast * 128 + dk];
                    const float qv = e ? __uint_as_float(qw[p2] & 0xffff0000u) : __uint_as_float(qw[p2] << 16), kv = e ? __uint_as_float(kw[p2] & 0xffff0000u) : __uint_as_float(kw[p2] << 16);
                    qt[e] = qv * 0.08838834764831845f * __builtin_amdgcn_exp2f(gg * LOG2E); kt[e] = kv * __builtin_amdgcn_exp2f(-gg * LOG2E); kh[e] = kv * __builtin_amdgcn_exp2f((GG - gg) * LOG2E);
                    *(LAS bf16_t*)(KhT + dk * 144 + tok * 2) = (bf16_t)f2bf(kh[e]); }
                qo[p2] = cvt_pk_bf16(qt[0], qt[1]); ko[p2] = cvt_pk_bf16(kt[0], kt[1]);
            }
            *(LAS u32x4*)(Qt + tok * 272 + d0 * 2) = (u32x4){qo[0], qo[1], qo[2], qo[3]}; *(LAS u32x4*)(Qt + tok * 272 + d0 * 2 + 16) = (u32x4){qo[4], qo[5], qo[6], qo[7]};
            *(LAS u32x4*)(Kt + tok * 272 + d0 * 2) = (u32x4){ko[0], ko[1], ko[2], ko[3]}; *(LAS u32x4*)(Kt + tok * 272 + d0 * 2 + 16) = (u32x4){ko[4], ko[5], ko[6], ko[7]};
            bf16_t* qg = QT + ((size_t)dir * NR + row0 + tok) * 512 + h * 128 + d0;
            *(u32x4*)qg = (u32x4){qo[0], qo[1], qo[2], qo[3]}; *(u32x4*)(qg + 8) = (u32x4){qo[4], qo[5], qo[6], qo[7]};
            if (tid < 128) DEC[(size_t)u * 128 + tid] = __builtin_amdgcn_exp2f(Gs[glast * 128 + tid] * LOG2E);
        }
        __syncthreads();
        {
            const int ib = w & 3, jb = w >> 2;
            f32x4 s0 = (f32x4){0.f, 0.f, 0.f, 0.f}, s1 = (f32x4){0.f, 0.f, 0.f, 0.f};
            const int jr = 32 * jb + 8 * (fr >> 2) + (fr & 3);
#pragma unroll
            for (int ks = 0; ks < 4; ++ks) {
                const bf16x8 qf = *(const LAS bf16x8*)(Qt + (16 * ib + fr) * 272 + (32 * ks + 8 * g) * 2);
                const bf16x8 k0f = *(const LAS bf16x8*)(Kt + jr * 272 + (32 * ks + 8 * g) * 2), k1f = *(const LAS bf16x8*)(Kt + (jr + 4) * 272 + (32 * ks + 8 * g) * 2);
                s0 = MFMA16(k0f, qf, s0); s1 = MFMA16(k1f, qf, s1);
            }
            const int i = 16 * ib + fr, j0 = 32 * jb + 8 * g;
            float x[8];
#pragma unroll
            for (int e = 0; e < 4; ++e) { x[e] = s0[e]; x[4 + e] = s1[e]; }
#pragma unroll
            for (int e = 0; e < 8; ++e) { const int j = j0 + e; const bool keep = dir == 0 ? (j <= i) : (j >= i); x[e] = keep ? x[e] : 0.f; }
            u32x4 pw; pw.x = cvt_pk_bf16(x[0], x[1]); pw.y = cvt_pk_bf16(x[2], x[3]); pw.z = cvt_pk_bf16(x[4], x[5]); pw.w = cvt_pk_bf16(x[6], x[7]);
            *(LAS u32x4*)(Pfr + (jb * 4 + ib) * 1024 + lane * 16) = pw;
        }
        __syncthreads();
        {
#pragma unroll
            for (int ib = 0; ib < 4; ++ib) {
                const bf16x8 p0 = *(const LAS bf16x8*)(Pfr + (0 * 4 + ib) * 1024 + lane * 16), p1 = *(const LAS bf16x8*)(Pfr + (1 * 4 + ib) * 1024 + lane * 16);
#pragma unroll
                for (int db = 0; db < 2; ++db) {
                    f32x4 o = (f32x4){0.f, 0.f, 0.f, 0.f};
                    o = MFMA16(Vf[db][0], p0, o); o = MFMA16(Vf[db][1], p1, o);
                    { u32x2 ow; ow.x = cvt_pk_bf16(o[0], o[1]); ow.y = cvt_pk_bf16(o[2], o[3]); *(u32x2*)(OG + ((size_t)dir * NR + row0 + 16 * ib + fr) * 1024 + h * 256 + 32 * w + 16 * db + 4 * g) = ow; }
                }
            }
#pragma unroll
            for (int dkb = 0; dkb < 8; ++dkb) {
                const bf16x8 kh0 = *(const LAS bf16x8*)(KhT + (16 * dkb + fr) * 144 + (8 * g) * 2), kh1 = *(const LAS bf16x8*)(KhT + (16 * dkb + fr) * 144 + (32 + 8 * g) * 2);
#pragma unroll
                for (int db = 0; db < 2; ++db) {
                    f32x4 o = (f32x4){0.f, 0.f, 0.f, 0.f};
                    o = MFMA16(kh0, Vf[db][0], o); o = MFMA16(kh1, Vf[db][1], o);
                    u32x2 ow; ow.x = cvt_pk_bf16(o[0], o[1]); ow.y = cvt_pk_bf16(o[2], o[3]);
                    *(u32x2*)(KVb + ((size_t)u * 256 + 32 * w + 16 * db + fr) * 128 + 16 * dkb + 4 * g) = ow;
                }
            }
        }
    }
    __syncthreads();
}
__device__ __forceinline__ void ph_gla_scan(const Ctx& F, const bf16_t* KVb, bf16_t* KVs, const float* DEC) {
    typedef float f32x2 __attribute__((ext_vector_type(2)));
    for (int e = F.bid * NTHR + F.tid; e < 32 * 16384; e += F.nb * NTHR) {
        const int chain = e >> 14, pe = e & 16383, dv = pe >> 6, dk2 = (pe & 63) * 2, dir = chain >> 4;
        unsigned kv[36]; f32x2 dd[36];
#pragma unroll
        for (int n = 0; n < 36; ++n) {
            const int c = dir == 0 ? n : (n < 4 ? 3 - n : 39 - n);
            const size_t u = (size_t)chain * 36 + c;
            kv[n] = *(const unsigned*)(KVb + (u * 256 + dv) * 128 + dk2); dd[n] = *(const f32x2*)(DEC + u * 128 + dk2);
        }
        float s0 = 0.f, s1 = 0.f;
#pragma unroll
        for (int n = 0; n < 36; ++n) {
            const int c = dir == 0 ? n : (n < 4 ? 3 - n : 39 - n);
            const size_t u = (size_t)chain * 36 + c;
            *(unsigned*)(KVs + (u * 256 + dv) * 128 + dk2) = pk2(s0, s1);
            s0 = dd[n].x * s0 + __uint_as_float(kv[n] << 16); s1 = dd[n].y * s1 + __uint_as_float(kv[n] & 0xffff0000u);
        }
    }
}
__device__ __forceinline__ void ph_gla_c(const Ctx& F, const bf16_t* P, const bf16_t* OG, const bf16_t* QT, const bf16_t* KVb, const float* ng, bf16_t* BO, bool with_ctx) {
    const int lane = F.lane, fr = lane & 15, g = lane >> 4, w = F.wave, ib = w & 3, dh = w >> 2;
    const int c_lo = with_ctx ? 0 : 4, nc = 36 - c_lo, nun = NB * nc * 4;
    LAS float* part = (LAS float*)F.lds;
    for (int uu = F.bid; uu < nun; uu += F.nb) {
        const int h = uu & 3, c = c_lo + (uu >> 2) % nc, b = (uu >> 2) / nc;
        int row0, tok0; gla_unit_rows(b, c, row0, tok0);
        const size_t r = (size_t)(row0 + 16 * ib + fr);
        const int dvb = h * 256 + 128 * dh + 4 * g;
        f32x4 acc[8];
#pragma unroll
        for (int db = 0; db < 8; ++db) { const u32x2 o0 = *(const u32x2*)(OG + r * 1024 + dvb + 16 * db), o1 = *(const u32x2*)(OG + ((size_t)NR + r) * 1024 + dvb + 16 * db);
            acc[db] = (f32x4){__uint_as_float(o0.x << 16) + __uint_as_float(o1.x << 16), __uint_as_float(o0.x & 0xffff0000u) + __uint_as_float(o1.x & 0xffff0000u),
                              __uint_as_float(o0.y << 16) + __uint_as_float(o1.y << 16), __uint_as_float(o0.y & 0xffff0000u) + __uint_as_float(o1.y & 0xffff0000u)}; }
#pragma unroll 1
        for (int dir = 0; dir < 2; ++dir) {
            const size_t ud = (size_t)((dir * 4 + b) * 4 + h) * 36 + c;
            bf16x8 Qf[4], Sf[8][4];
#pragma unroll
            for (int ks = 0; ks < 4; ++ks) Qf[ks] = *(const bf16x8*)(QT + ((size_t)dir * NR + r) * 512 + h * 128 + 32 * ks + 8 * g);
#pragma unroll
            for (int db = 0; db < 8; ++db)
#pragma unroll
                for (int ks = 0; ks < 4; ++ks) Sf[db][ks] = *(const bf16x8*)(KVb + (ud * 256 + 128 * dh + 16 * db + fr) * 128 + 32 * ks + 8 * g);
#pragma unroll
            for (int db = 0; db < 8; ++db)
#pragma unroll
                for (int ks = 0; ks < 4; ++ks) acc[db] = MFMA16(Sf[db][ks], Qf[ks], acc[db]);
        }
        float ss = 0.f;
#pragma unroll
        for (int db = 0; db < 8; ++db) ss += acc[db][0] * acc[db][0] + acc[db][1] * acc[db][1] + acc[db][2] * acc[db][2] + acc[db][3] * acc[db][3];
        ss += xshfl<16>(ss); ss = sum_x32(ss);
        __syncthreads();
        if (g == 0) part[(dh * 4 + ib) * 16 + fr] = ss;
        __syncthreads();
        const float rs = rsqrtf((part[ib * 16 + fr] + part[(4 + ib) * 16 + fr]) * (1.f / 256.f) + EPS);
#pragma unroll
        for (int db = 0; db < 8; ++db) { const int dv = 128 * dh + 16 * db + 4 * g;
            const u32x2 og = *(const u32x2*)(P + r * PW + O_GLOG + h * 256 + dv); const f32x4 gg = *(const f32x4*)(ng + dv);
            const float z0 = __uint_as_float(og.x << 16), z1 = __uint_as_float(og.x & 0xffff0000u), z2 = __uint_as_float(og.y << 16), z3 = __uint_as_float(og.y & 0xffff0000u);
            const float o0 = acc[db][0] * rs * gg[0] * z0 * fast_sigmoid(z0), o1 = acc[db][1] * rs * gg[1] * z1 * fast_sigmoid(z1);
            const float o2 = acc[db][2] * rs * gg[2] * z2 * fast_sigmoid(z2), o3 = acc[db][3] * rs * gg[3] * z3 * fast_sigmoid(z3);
            u32x2 wv; wv.x = cvt_pk_bf16(o0, o1); wv.y = cvt_pk_bf16(o2, o3);
            *(u32x2*)(BO + r * 1024 + h * 256 + dv) = wv; }
    }
    __syncthreads();
}
__device__ __forceinline__ void ph_moe_sort(const Ctx& F, const int* tok_e, int* tok_slot, const bf16_t* H, bf16_t* HS, unsigned* cnt_out, float* Y2) {
    LAS int* tot = (LAS int*)F.lds;
    LAS int* pre = tot + 8;
    LAS int* slots = pre + 8;
    __syncthreads();
    if (F.tid < 16) tot[F.tid] = 0;
    __syncthreads();
    {
        int ct[8], cp[8];
#pragma unroll
        for (int e = 0; e < 8; ++e) { ct[e] = 0; cp[e] = 0; }
        for (int i = F.tid; i < NL * 2; i += NTHR) { const int e = tok_e[i]; const bool before = i < F.bid * 64;
#pragma unroll
            for (int j = 0; j < 8; ++j) { ct[j] += (e == j); cp[j] += (e == j && before); } }
#pragma unroll
        for (int e = 0; e < 8; ++e) { const int a = (int)wave_sum((float)ct[e]), b2 = (int)wave_sum((float)cp[e]); if (F.lane == 0) { atomicAdd((int*)&tot[e], a); atomicAdd((int*)&pre[e], b2); } }
    }
    __syncthreads();
    int pstart[8]; { int acc = 0;
#pragma unroll
        for (int e = 0; e < 8; ++e) { pstart[e] = acc; acc += (tot[e] + 255) / 256 * 256; } }
    if (F.tid < 64) {
        const int ai = F.bid * 64 + F.tid; const int me = tok_e[ai];
        int rank = 0, ps_me = 0;
#pragma unroll
        for (int e = 0; e < 8; ++e) { const unsigned long long m = __ballot(me == e); if (me == e) { rank = __popcll(m & ((1ull << F.lane) - 1ull)); ps_me = pstart[e]; } }
        const int slot = ps_me + pre[me] + rank;
        tok_slot[ai] = slot; slots[F.tid] = slot;
    }
    if (F.bid == 0 && F.tid < 8) cnt_out[F.tid] = (unsigned)tot[F.tid];
    __syncthreads();
    for (int a = F.wave; a < 64; a += NWAVES) { const int t = F.bid * 32 + (a >> 1); const u32x4* sp = (const u32x4*)((const unsigned char*)H + (size_t)t * D); u32x4* d = (u32x4*)((unsigned char*)HS + (size_t)slots[a] * D);
#pragma unroll
        for (int j = 0; j < 2; ++j) d[F.lane + 64 * j] = sp[F.lane + 64 * j]; }
    float zf = 0.f; asm volatile("" : "+v"(zf)); const f32x4 z4 = {zf, zf, zf, zf};
    {
        int lo = 0, hi = 0;
#pragma unroll
        for (int e = 0; e < 8; ++e) if ((F.bid & 7) == e) { lo = pstart[e] + tot[e]; hi = pstart[e] + (tot[e] + 255) / 256 * 256; }
        for (int rr = lo + (F.bid >> 3) * NWAVES + F.wave; rr < hi; rr += 32 * NWAVES) { u32x4* d = (u32x4*)((unsigned char*)HS + (size_t)rr * D);
#pragma unroll
            for (int j = 0; j < 2; ++j) d[F.lane + 64 * j] = __builtin_bit_cast(u32x4, z4); } }
    __syncthreads();
}
__device__ __forceinline__ int moe_tail_row0(const unsigned* cnt, int G) {
    int nblk = 0;
#pragma unroll
    for (int e = 0; e < 8; ++e) nblk += ((int)__hip_atomic_load(cnt + e, __ATOMIC_RELAXED, __HIP_MEMORY_SCOPE_AGENT) + 255) / 256;
    nblk = nblk < 72 ? nblk : 72;
    return (nblk * 8 / G) * G / 8 * 256;
}
__device__ __forceinline__ void ph_final(const Ctx& F, const float* XR, const bf16_t* Y2, const float* Y2B, int row_tail0, const int* tok_slot, const float* tok_w, const float* modl, const float* fg, float* out, float delta) {
    const int rstep = F.nb * NWAVES;
    LAS float* lfg = (LAS float*)F.lds;
    LAS float* lg2 = lfg + D;
    __syncthreads();
    for (int q = F.tid; q < 5 * (D / 4); q += NTHR) { const int b = q / (D / 4), c4 = q % (D / 4);
        *(LAS f32x4*)(lfg + b * D + 4 * c4) = b == 0 ? *(const f32x4*)(fg + 4 * c4) : *(const f32x4*)(modl + (size_t)(b - 1) * MOD_W + 5 * D + 4 * c4); }
    __syncthreads();
    f32x4 nx[8]; u32x2 ny0[8], ny1[8]; float nw0 = 0.f, nw1 = 0.f; int ns0 = 0, ns1 = 0;
#define FIN_LOAD(row_) do { const f32x4* xr_ = (const f32x4*)(XR + (size_t)(row_) * D) + F.lane; ns0 = tok_slot[(row_) * 2]; ns1 = tok_slot[(row_) * 2 + 1]; \
        const u32x2* y0_ = (const u32x2*)(Y2 + (size_t)ns0 * D) + F.lane; const u32x2* y1_ = (const u32x2*)(Y2 + (size_t)ns1 * D) + F.lane; \
        nw0 = tok_w[(row_) * 2]; nw1 = tok_w[(row_) * 2 + 1]; \
        _Pragma("unroll") for (int j = 0; j < 8; ++j) { nx[j] = xr_[64 * j]; ny0[j] = y0_[64 * j]; ny1[j] = y1_[64 * j]; } } while (0)
    if (F.bid * NWAVES + F.wave < NL) FIN_LOAD(F.bid * NWAVES + F.wave);
    for (int row = F.bid * NWAVES + F.wave; row < NL; row += rstep) {
        int lro = 0; asm volatile("" : "+v"(lro));
        const LAS float* g2 = lg2 + lro + batch_of(row) * D;
        const int cs0 = __builtin_amdgcn_readfirstlane(ns0), cs1 = __builtin_amdgcn_readfirstlane(ns1); const float cw0 = nw0, cw1 = nw1;
        f32x4 v[8]; float ss = 0.f;
#pragma unroll
        for (int j = 0; j < 8; ++j) { const f32x4 gg = *(const LAS f32x4*)(g2 + 4 * F.lane + 256 * j); const f32x4 a0 = {__uint_as_float(ny0[j].x << 16), __uint_as_float(ny0[j].x & 0xffff0000u), __uint_as_float(ny0[j].y << 16), __uint_as_float(ny0[j].y & 0xffff0000u)};
            const f32x4 a1 = {__uint_as_float(ny1[j].x << 16), __uint_as_float(ny1[j].x & 0xffff0000u), __uint_as_float(ny1[j].y << 16), __uint_as_float(ny1[j].y & 0xffff0000u)};
            v[j] = nx[j] + gg * (nw0 * a0 + nw1 * a1); }
        if (row + rstep < NL) FIN_LOAD(row + rstep);
        const size_t pstride = (size_t)(NSLOT - row_tail0) * D;
        if (cs0 >= row_tail0) {
#pragma unroll 1
            for (int q = 0; q < 3; ++q) { const f32x4* b_ = (const f32x4*)(Y2B + q * pstride + (size_t)(cs0 - row_tail0) * D) + F.lane;
#pragma unroll
                for (int j = 0; j < 8; ++j) { const f32x4 gg = *(const LAS f32x4*)(g2 + 4 * F.lane + 256 * j); v[j] += gg * (cw0 * b_[64 * j]); } } }
        if (cs1 >= row_tail0) {
#pragma unroll 1
            for (int q = 0; q < 3; ++q) { const f32x4* b_ = (const f32x4*)(Y2B + q * pstride + (size_t)(cs1 - row_tail0) * D) + F.lane;
#pragma unroll
                for (int j = 0; j < 8; ++j) { const f32x4 gg = *(const LAS f32x4*)(g2 + 4 * F.lane + 256 * j); v[j] += gg * (cw1 * b_[64 * j]); } } }
#pragma unroll
        for (int j = 0; j < 8; ++j) ss += v[j][0] * v[j][0] + v[j][1] * v[j][1] + v[j][2] * v[j][2] + v[j][3] * v[j][3];
        ss = wave_sum(ss);
        const float rs = rsqrtf(ss * (1.f / D) + EPS);
#pragma unroll
        for (int j = 0; j < 8; ++j) { const f32x4 gg = *(const LAS f32x4*)(lfg + lro + 4 * F.lane + 256 * j); ((f32x4*)(out + (size_t)row * D))[F.lane + 64 * j] = v[j] * rs * gg + delta; }
    }
#undef FIN_LOAD
}

constexpr int PH_PER_LAYER = 12, PH_FINAL = 2 + 2 * PH_PER_LAYER, N_PHASES = PH_FINAL + 1;
__global__ void __launch_bounds__(NTHR, 2) mega(Params p) {
    extern __shared__ __attribute__((aligned(16))) unsigned char lds_raw[];
    LAS unsigned char* lds = (LAS unsigned char*)lds_raw;
    volatile LAS unsigned* MISC = (volatile LAS unsigned*)(lds + MISC_OFF);
    const int wave_s = __builtin_amdgcn_readfirstlane((int)threadIdx.x >> 6);
    Ctx F; F.lds = lds; F.tid = threadIdx.x; F.lane = F.tid & 63; F.wave = __builtin_amdgcn_readfirstlane(F.tid >> 6); F.bid = blockIdx.x; F.nb = gridDim.x;
#define FRESH() do { int t_ = (wave_s << 6) | lane_now(); F.tid = t_; F.lane = t_ & 63; F.wave = __builtin_amdgcn_readfirstlane(t_ >> 6); \
        int b_ = blockIdx.x; asm volatile("" : "+s"(b_)); F.bid = b_; unsigned long long w_ = (unsigned long long)ws; asm volatile("" : "+s"(w_)); ws = (unsigned char*)(GAS unsigned char*)w_; } while (0)
    unsigned char* ws = (unsigned char*)(GAS unsigned char*)p.ws;
    for (int u = F.tid; u < (LDS_BYTES - RING_BYTES) / 4; u += NTHR) ((LAS unsigned*)(lds + RING_BYTES))[u] = 0u;
    __syncthreads();
    XcdBarrier bar; bar.bar = (unsigned*)(ws + WS_CTL) + CW_BAR; bar.x = 0; bar.st = nullptr;
    if (!MK_SPLIT) bar = xcd_barrier_post((unsigned*)(ws + WS_CTL) + CW_BAR, MISC + 8, F.tid);
    const int lo = p.ph_lo, hi = p.ph_hi;
#define GIN(k) ((const float*)(const GAS float*)p.in[k])
    LAS pg8::UnitRec* UTAB = (LAS pg8::UnitRec*)(lds + UTAB_OFF); LAS int* NCELL = (LAS int*)(lds + MISC_OFF + 64);
#ifndef PH_MASK
#define PH_MASK 0xffffffffu
#endif
#define IN(k) (((PH_MASK >> (((k) - 2) % PH_PER_LAYER + 2 < 2 ? (k) : (((k) < 2) ? (k) : (((k) == PH_FINAL) ? 14 : ((k) - 2) % PH_PER_LAYER + 2)))) & 1u) && lo <= (k) && (k) < hi)
#ifndef DBL_J
#define DBL_J (-1)
#define DBL_L 0
#endif
#define BG(c0, q, base) do { FRESH(); if (F.bid >= (c0)) bg_convert(F, p, (base) + (F.bid - (c0)) * (q), (q)); } while (0)
#define REP(j) for (int rep_ = 0; rep_ < ((DBL_J == (j) && layer == DBL_L) ? 2 : 1); ++rep_)
#define REP0(j) for (int rep_ = 0; rep_ < ((DBL_J == 100 + (j)) ? 2 : 1); ++rep_)
#ifdef PAD_STAMP
#define STAMP(id) do { if ((id) == 0 && F.tid == 0) { const unsigned long long t_ = wall_clock64(); MISC[20] = (unsigned)t_; MISC[21] = (unsigned)(t_ >> 32); } \
        if ((id) == PAD_STAMP) { if (F.tid == 0) { const unsigned long long t0_ = ((unsigned long long)MISC[21] << 32) | MISC[20]; \
            while (wall_clock64() - t0_ < (unsigned long long)(PAD_US) * 100ull) __builtin_amdgcn_s_sleep(32); } __syncthreads(); } } while (0)
#else
#define STAMP(id) do { } while (0)
#endif
#define SEAM(k) do { if (IN(k) && IN((k) + 1)) xcd_barrier(bar, (wave_s << 6) | lane_now()); FRESH(); STAMP((k) + 1); } while (0)
#define MODP ((float*)(ws + WS_MODP))
#define MOD ((float*)(ws + WS_MOD))
#define XR ((float*)(ws + WS_XR))
#define H ((bf16_t*)(ws + WS_H))
#define HS ((bf16_t*)(ws + WS_HS))
#define P ((bf16_t*)(ws + WS_P))
#define Y2 ((float*)(ws + WS_P))
#define Y2H ((bf16_t*)(ws + WS_P))
#define Y2B ((float*)(ws + WS_WIN))
#define ABF ((float*)(ws + WS_ABF))
#define LG ((float*)(ws + WS_LG))
#define OG ((bf16_t*)(ws + WS_OG))
#define AO ((bf16_t*)(ws + WS_AO))
#define BO ((bf16_t*)(ws + WS_BO))
#define CO ((bf16_t*)(ws + WS_CO))
#define MG ((bf16_t*)(ws + WS_MG))
#define ACT ((bf16_t*)(ws + WS_ACT))
#define VT ((bf16_t*)(ws + WS_VT))
#define QT ((bf16_t*)(ws + WS_QT))
#define KVB ((bf16_t*)(ws + WS_KV))
#define DEC ((float*)(ws + WS_DEC))
#define QKN ((bf16_t*)(ws + WS_QKN))
#define ROPET ((float*)(ws + WS_ROPE))
#define KVG ((bf16_t*)(ws + WS_KVG))
#define KVS ((bf16_t*)(ws + WS_ACT))
#define tok_e ((int*)(ws + WS_RT))
#define tok_w ((float*)(ws + WS_RT + (size_t)NL * 2 * 4))
#define tok_slot ((int*)(ws + WS_RT + (size_t)NL * 2 * 8))
#define ctl ((unsigned*)(ws + WS_CTL))

    STAMP(0);
    if (IN(0)) REP0(0) { ph_mod_partial(F, GIN(1), GIN(3), GIN(4), MODP); ph_rope_table(F, ROPET); }
    SEAM(0);
    if (IN(1)) REP0(1) { ph_mod_reduce(F, MODP, GIN(5), MOD); ph_convert(F, p); }
    SEAM(1);
    for (int layer = 0; layer < 2; ++layer) {
        const int pb = 2 + layer * PH_PER_LAYER;
        const bool last = layer == 1;
        const float* modl = MOD + (size_t)layer * 5 * MOD_W;
        const int MR = last ? NL : NR;
        if (IN(pb + 0)) REP(0) ph_norm<false>(F, last ? XR : GIN(0), last ? nullptr : GIN(2), GIN(6) + layer * D, modl, 0, D, H, NR, nullptr, nullptr, nullptr, nullptr, (unsigned char*)HS);
        SEAM(pb + 0);
        if (IN(pb + 1)) REP(1) {
            {
                pg8::InprojSplitOrder So{(const char*)H, (const char*)((bf16_t*)(ws + WS_WIN) + (size_t)layer * NIN * D), last ? 32 : 36, last ? 4 : 0, last ? 232 : 248, F.bid, 0, (size_t)256 * D * 2};
                pg8::EpiInproj<0> E{P, ABF, 1.f};
                { const int nu = pg8::fill_table(So, UTAB, NCELL, F.tid); const pg8::TableOrder T{UTAB, nu}; pg8::gemm_phase(lds, D, D, T, E, F.tid); }
            }
            FRESH();
            {
                pg8::InprojSplitOrder So{(const char*)HS, (const char*)((bf16_t*)(ws + WS_WIN) + (size_t)layer * NIN * D), last ? 32 : 36, 0, last ? 232 : 248, F.bid, 1, (size_t)256 * D * 2};
                pg8::EpiInproj<1> E{P, ABF, 0.03125f};
                { const int nu = pg8::fill_table(So, UTAB, NCELL, F.tid); const pg8::TableOrder T{UTAB, nu}; pg8::gemm_phase<true>(lds, D, 2 * D, T, E, F.tid); }
            }
            if (!last) BG(248, BGQ_INP0, 0);
            else { BG(232, (17768 - BG_INP1) / 24, BG_INP1);
                   BG(232, (BG_TOTAL - (17768 + 208 * BGQ_UP0) + 23) / 24, 17768 + 208 * BGQ_UP0); }
        }
        SEAM(pb + 1);
        if (IN(pb + 2)) REP(2) { ph_vt(F, P, VT); FRESH(); }
        if (IN(pb + 2)) REP(22) ph_prep(F, P, ROPET, QKN, KVG, ABF, GIN(13) + layer * 128, GIN(14) + layer * 128, GIN(10) + (size_t)layer * 2 * 16 * 512, GIN(11) + layer * 2 * 512, LG);
        SEAM(pb + 2);
        if (IN(pb + 3)) REP(3) {
#ifndef ATTN_SEL
#define ATTN_SEL 7
#endif
            if ((F.bid >> 3) & 1) { ph_gla_a(F, P, VT, LG, OG, QT, KVB, DEC); FRESH(); }
            if (ATTN_SEL & 1) REP(31) { ph_gqa2(F, QKN, KVG, CO, !last, (char*)lds_raw); FRESH(); }
            if (ATTN_SEL & 2) REP(32) { ph_na(F, P, VT, GIN(9) + (size_t)layer * 16 * 15 * 31, AO, 0, last ? 2048 : 2304); FRESH(); }
            if (!((F.bid >> 3) & 1)) { ph_gla_a(F, P, VT, LG, OG, QT, KVB, DEC); FRESH(); }
        }
        SEAM(pb + 3);
        if (IN(pb + 4)) REP(4) ph_gla_scan(F, KVB, KVS, DEC);
        SEAM(pb + 4);
        if (IN(pb + 5)) REP(5) { ph_gla_c(F, P, OG, QT, KVS, GIN(12) + layer * 256, BO, !last); }
        SEAM(pb + 5);
        if (IN(pb + 6)) REP(6) {
            const bf16_t* wp = (const bf16_t*)(ws + WS_WP) + (size_t)layer * 3 * D * 1024;
            pg8::MergeOrder So{(const char*)AO, (size_t)(WS_BO - WS_AO), (const char*)wp, (size_t)D * 1024 * 2, MR / 256, last ? F.nb : 144, F.bid};
            static_assert(WS_CO - WS_BO == WS_BO - WS_AO, "branch outputs equally spaced");
            pg8::EpiMerge E{P, MG};
            { const int nu = pg8::fill_table(So, UTAB, NCELL, F.tid); const pg8::TableOrder T{UTAB, nu}; pg8::gemm_phase(lds, 1024, 1024, T, E, F.tid); }
            if (!last) BG(144, BGQ_MERGE, 8 * BGQ_INP0);
        }
        SEAM(pb + 6);
        if (IN(pb + 7)) {
            pg8::PlainOrder So{(const char*)MG, (const char*)((bf16_t*)(ws + WS_WOUT) + (size_t)layer * D * D), MR / 256, 8, last ? F.nb : 144, F.bid, (size_t)256 * D * 2};
            pg8::EpiResid E{XR, modl, 2 * D, last ? nullptr : GIN(0), last ? nullptr : GIN(2), 1.f};
            { const int nu = pg8::fill_table(So, UTAB, NCELL, F.tid); const pg8::TableOrder T{UTAB, nu}; pg8::gemm_phase(lds, D, D, T, E, F.tid); }
            if (!last) BG(144, BGQ_OUT, 8 * BGQ_INP0 + 112 * BGQ_MERGE);
        }
        SEAM(pb + 7);
        if (IN(pb + 8)) REP(8) {
            if (!last) ph_norm<false>(F, XR, nullptr, GIN(7) + layer * D, modl, 3 * D, 4 * D, H, MR, nullptr, nullptr, nullptr, nullptr);
            else ph_norm<true, true>(F, XR, nullptr, GIN(7) + layer * D, modl, 3 * D, 4 * D, H, MR, GIN(22), GIN(23), tok_e, tok_w);
        }
        SEAM(pb + 8);
        if (IN(pb + 9)) REP(9) { if (last) { ph_moe_sort(F, tok_e, tok_slot, H, HS, ctl + CW_CNT, Y2); } }
        if (last) SEAM(pb + 9);
        if (!last) {
            if (IN(pb + 10)) REP(10) {
                pg8::PlainOrder So{(const char*)H, (const char*)(ws + WS_DGU), MR / 256, 44, F.nb, F.bid, (size_t)256 * D * 2};
                pg8::EpiSwiglu8 E{(unsigned char*)ACT, 1.f};
                { const int nu = pg8::fill_table(So, UTAB, NCELL, F.tid); const pg8::TableOrder T{UTAB, nu}; pg8::gemm_phase(lds, D, D, T, E, F.tid); }
                BG(48, BGQ_UP0, 17768);
            }
            SEAM(pb + 10);
            if (IN(pb + 11)) {
                pg8::PlainOrder So{(const char*)ACT, (const char*)(ws + WS_DDN), MR / 256, 8, DDN_G, F.bid, (size_t)256 * DFF};
                pg8::EpiResid E{XR, modl, 5 * D, nullptr, nullptr, 0.03125f};
                { const int nu = pg8::fill_table(So, UTAB, NCELL, F.tid); const pg8::TableOrder T{UTAB, nu}; pg8::gemm_phase<true>(lds, DFF, DFF, T, E, F.tid); }
                BG(144, (BG_INP1 - (8 * BGQ_INP0 + 112 * (BGQ_MERGE + BGQ_OUT)) + 111) / 112, 8 * BGQ_INP0 + 112 * (BGQ_MERGE + BGQ_OUT));
            }
            SEAM(pb + 11);
        } else {
            if (IN(pb + 10)) REP(10) {
                pg8::MoeOrder So{(const char*)HS, (const char*)(ws + WS_MGU), 44, F.nb, F.bid, (size_t)256 * D, (size_t)2 * DFF * D, ctl + CW_CNT, 0};
                pg8::EpiSwiglu8 E{(unsigned char*)ACT, 0.03125f};
                { const int nu = pg8::fill_table(So, UTAB, NCELL, F.tid); const pg8::TableOrder T{UTAB, nu}; pg8::gemm_phase<true>(lds, D, D, T, E, F.tid); }
            }
            SEAM(pb + 10);
            if (IN(pb + 11)) REP(11) {
                { pg8::MoeOrder So{(const char*)ACT, (const char*)(ws + WS_MDN), 8, F.nb, F.bid, (size_t)256 * DFF, (size_t)D * DFF, ctl + CW_CNT, 1};
                  pg8::EpiStoreBF16 E{Y2H, 0.03125f};
                  { const int nu = pg8::fill_table(So, UTAB, NCELL, F.tid); const pg8::TableOrder T{UTAB, nu}; pg8::gemm_phase<true>(lds, DFF, DFF, T, E, F.tid); } }
                FRESH();
                { pg8::MoeTailOrder So{(const char*)ACT, (const char*)(ws + WS_MDN), F.nb, F.bid, (size_t)256 * DFF, (size_t)D * DFF, ctl + CW_CNT};
                  pg8::EpiTailF32 E{Y2H, Y2B, moe_tail_row0(ctl + CW_CNT, F.nb), 0.03125f};
                  { const int nu = pg8::fill_table(So, UTAB, NCELL, F.tid); const pg8::TableOrder T{UTAB, nu}; pg8::gemm_phase<true, true>(lds, 2816, DFF, T, E, F.tid); } }
            }
            SEAM(pb + 11);
        }
    }
    float probe_delta = 0.f;
    if (IN(PH_FINAL)) REP0(26) ph_final(F, XR, Y2H, Y2B, moe_tail_row0(ctl + CW_CNT, F.nb), tok_slot, tok_w, MOD + (size_t)5 * MOD_W, GIN(27), (float*)(GAS float*)p.out, probe_delta);
#undef IN
#undef SEAM
#undef MODP
#undef MOD
#undef XR
#undef H
#undef HS
#undef P
#undef Y2
#undef ABF
#undef LG
#undef OG
#undef AO
#undef BO
#undef CO
#undef MG
#undef ACT
#undef VT
#undef QT
#undef KVB
#undef DEC
#undef QKN
#undef ROPET
#undef KVG
#undef KVS
#undef tok_e
#undef tok_w
#undef tok_slot
#undef ctl
}

extern "C" void kernel_launch(void* const* d_in, const int* in_sizes, int n_in, void* d_out, int out_size, void* d_ws, size_t ws_size, hipStream_t stream) {
    static int grid = 0;
    if (grid == 0) {
        if (n_in != 28 || ws_size < WS_END) { fprintf(stderr, "kernel_launch: need 28 inputs and %zu bytes of workspace (got %d, %zu)\n", (size_t)WS_END, n_in, ws_size); grid = -1; return; }
        int dev = 0, cus = 0, per_cu = 0;
        if (hipGetDevice(&dev) != hipSuccess || hipDeviceGetAttribute(&cus, hipDeviceAttributeMultiprocessorCount, dev) != hipSuccess) { grid = -1; return; }
        if (hipFuncSetAttribute((const void*)mega, hipFuncAttributeMaxDynamicSharedMemorySize, LDS_BYTES) != hipSuccess) { fprintf(stderr, "kernel_launch: hipFuncSetAttribute failed\n"); grid = -1; return; }
        if (hipOccupancyMaxActiveBlocksPerMultiprocessor(&per_cu, (const void*)mega, NTHR, LDS_BYTES) != hipSuccess || per_cu < 1) { fprintf(stderr, "kernel_launch: occupancy query says %d\n", per_cu); }
        (void)hipGetLastError();
        if (cus < 256) { fprintf(stderr, "kernel_launch: needs 256 CUs (got %d)\n", cus); grid = -1; return; }
        grid = 256;
    }
    if (grid < 0) return;
    (void)hipMemsetAsync((char*)d_ws + WS_CTL, 0, CTL_BYTES, stream);
    Params p{};
    for (int i = 0; i < 28; ++i) p.in[i] = (const float*)d_in[i];
    p.out = (float*)d_out; p.ws = (unsigned char*)d_ws;
#if MK_SPLIT
    for (int k = 0; k < N_PHASES; ++k) { p.ph_lo = k; p.ph_hi = k + 1; hipLaunchKernelGGL(mega, dim3(grid), dim3(NTHR), LDS_BYTES, stream, p); }
#else
    p.ph_lo = 0; p.ph_hi = N_PHASES;
    hipLaunchKernelGGL(mega, dim3(grid), dim3(NTHR), LDS_BYTES, stream, p);
#endif
}
```
